# Optimizing an MI355X kernel written in HIP

```python
import math
import jax, jax.numpy as jnp
from jax import lax
import numpy as np

D_MODEL = 1024
BATCH = 32
SEQ = 2048
DEPTH = 4

N_MIXERS = 2
SB_HEADS = 16
SB_HEAD_DIM = D_MODEL // SB_HEADS
Q_BLOCK = 128
GMLP_WIDTH = 2 * D_MODEL
GMLP_GROUPS = 8
GMLP_CHUNK = 128
D_FF = ((8 * D_MODEL // 3 + 127) // 128) * 128
CONV_WIDTH = 3
LN_EPS = 1e-5
DEEPNORM_ALPHA = (2 * DEPTH) ** 0.25
DEEPNORM_BETA = (8 * DEPTH) ** -0.25
N_ATTN_LAYERS = (DEPTH + 1) // 2
N_GMLP_LAYERS = DEPTH // 2

kernel_name = "sb_attn_gmlp_convffn_deepnorm_hybrid"


def layer_norm(h, g, b):
    hf = h.astype(jnp.float32)
    mu = jnp.mean(hf, axis=-1, keepdims=True)
    var = jnp.mean(jnp.square(hf - mu), axis=-1, keepdims=True)
    y = (hf - mu) * lax.rsqrt(var + LN_EPS)
    return (y * g.astype(jnp.float32) + b.astype(jnp.float32)).astype(h.dtype)


def stick_breaking_attention(h, w_in, w_out):
    B, S, _ = h.shape
    qkv = (h @ w_in).reshape(B, S, 3, SB_HEADS, SB_HEAD_DIM)
    q = jnp.transpose(qkv[:, :, 0], (0, 2, 1, 3))
    k = jnp.transpose(qkv[:, :, 1], (0, 2, 1, 3))
    v = jnp.transpose(qkv[:, :, 2], (0, 2, 1, 3))
    scale = SB_HEAD_DIM ** -0.5
    outs = []
    for blk in range(S // Q_BLOCK):
        q0 = blk * Q_BLOCK
        k_end = q0 + Q_BLOCK
        qb = q[:, :, q0:k_end]
        kb = k[:, :, :k_end]
        vb = v[:, :, :k_end]
        z = jnp.einsum('bhqd,bhkd->bhqk', qb, kb).astype(jnp.float32) * scale
        t_idx = q0 + jnp.arange(Q_BLOCK)[:, None]
        s_idx = jnp.arange(k_end)[None, :]
        causal = s_idx < t_idx
        log_beta = jax.nn.log_sigmoid(z)
        log_one_minus = jnp.where(causal, jax.nn.log_sigmoid(-z), 0.0)
        suffix = lax.cumsum(log_one_minus, axis=3, reverse=True) - log_one_minus
        a = jnp.where(causal, jnp.exp(log_beta + suffix), 0.0)
        outs.append(jnp.einsum('bhqk,bhkd->bhqd', a.astype(vb.dtype), vb))
    o = jnp.concatenate(outs, axis=2)
    o = jnp.transpose(o, (0, 2, 1, 3)).reshape(B, S, D_MODEL)
    return o @ w_out


def chunked_spatial_gating(h, w_in, ln_g, ln_b, w_s, b_s, w_out):
    B, S, _ = h.shape
    zz = jax.nn.gelu(h @ w_in)
    u, v = zz[..., :GMLP_WIDTH], zz[..., GMLP_WIDTH:]
    v = layer_norm(v, ln_g, ln_b)
    v = v.reshape(B, S // GMLP_CHUNK, GMLP_CHUNK, GMLP_GROUPS, GMLP_WIDTH // GMLP_GROUPS)
    tri = jnp.tril(jnp.ones((GMLP_CHUNK, GMLP_CHUNK), dtype=bool))
    w_causal = jnp.where(tri[None], w_s, 0.0).astype(v.dtype)
    s = jnp.einsum('gts,bnsgc->bntgc', w_causal, v)
    s = s + jnp.transpose(b_s, (1, 0))[None, None, :, :, None].astype(s.dtype)
    s = s.reshape(B, S, GMLP_WIDTH)
    return (u * s) @ w_out


def causal_depthwise_conv(a, w, b):
    S = a.shape[1]
    pad = CONV_WIDTH - 1
    ap = jnp.pad(a, ((0, 0), (pad, 0), (0, 0)))
    y = b
    for tap in range(CONV_WIDTH):
        y = y + w[tap] * ap[:, tap:tap + S]
    return y


def conv_gated_ffn(h, w_up, conv_w, conv_b, w_down):
    a = h @ w_up
    a = causal_depthwise_conv(a, conv_w, conv_b)
    gate, val = a[..., :D_FF], a[..., D_FF:]
    return (jax.nn.silu(gate) * val) @ w_down


def setup_inputs(seed: int = 0) -> dict:
    key = jax.random.key(seed)
    ks = jax.random.split(key, 20)
    f32 = jnp.float32
    D, E, G, C, F = D_MODEL, GMLP_WIDTH, GMLP_GROUPS, GMLP_CHUNK, D_FF
    nrm = lambda k, shape, std: jax.random.normal(k, shape, f32) * std
    x = nrm(ks[0], (BATCH, SEQ, D), 1.0)
    attn_qk = nrm(ks[1], (N_ATTN_LAYERS, D, 2 * D), D ** -0.5)
    attn_v = nrm(ks[2], (N_ATTN_LAYERS, D, D), D ** -0.5 * DEEPNORM_BETA)
    attn_w_in = jnp.concatenate([attn_qk, attn_v], axis=-1)
    attn_w_out = nrm(ks[3], (N_ATTN_LAYERS, D, D), D ** -0.5 * DEEPNORM_BETA)
    gmlp_w_in = nrm(ks[4], (N_GMLP_LAYERS, D, 2 * E), D ** -0.5)
    gmlp_ln_g = 1.0 + nrm(ks[5], (N_GMLP_LAYERS, E), 0.02)
    gmlp_ln_b = nrm(ks[6], (N_GMLP_LAYERS, E), 0.02)
    gmlp_w_s = nrm(ks[7], (N_GMLP_LAYERS, G, C, C), C ** -0.5)
    gmlp_b_s = 1.0 + nrm(ks[8], (N_GMLP_LAYERS, G, C), 0.02)
    gmlp_w_out = nrm(ks[9], (N_GMLP_LAYERS, E, D), E ** -0.5 * DEEPNORM_BETA)
    ffn_w_up = nrm(ks[10], (DEPTH, D, 2 * F), D ** -0.5)
    ffn_conv_w = nrm(ks[11], (DEPTH, CONV_WIDTH, 2 * F), CONV_WIDTH ** -0.5)
    ffn_conv_b = nrm(ks[12], (DEPTH, 2 * F), 0.01)
    ffn_w_down = nrm(ks[13], (DEPTH, F, D), F ** -0.5 * DEEPNORM_BETA)
    ln_mix_g = 1.0 + nrm(ks[14], (DEPTH, D), 0.02)
    ln_mix_b = nrm(ks[15], (DEPTH, D), 0.02)
    ln_ffn_g = 1.0 + nrm(ks[16], (DEPTH, D), 0.02)
    ln_ffn_b = nrm(ks[17], (DEPTH, D), 0.02)
    return {"x": x, "attn_w_in": attn_w_in, "attn_w_out": attn_w_out,
            "gmlp_w_in": gmlp_w_in, "gmlp_ln_g": gmlp_ln_g, "gmlp_ln_b": gmlp_ln_b,
            "gmlp_w_s": gmlp_w_s, "gmlp_b_s": gmlp_b_s, "gmlp_w_out": gmlp_w_out,
            "ffn_w_up": ffn_w_up, "ffn_conv_w": ffn_conv_w, "ffn_conv_b": ffn_conv_b,
            "ffn_w_down": ffn_w_down, "ln_mix_g": ln_mix_g, "ln_mix_b": ln_mix_b,
            "ln_ffn_g": ln_ffn_g, "ln_ffn_b": ln_ffn_b}


def reference(x, attn_w_in, attn_w_out, gmlp_w_in, gmlp_ln_g, gmlp_ln_b, gmlp_w_s, gmlp_b_s,
              gmlp_w_out, ffn_w_up, ffn_conv_w, ffn_conv_b, ffn_w_down,
              ln_mix_g, ln_mix_b, ln_ffn_g, ln_ffn_b):
    h = x
    for i in range(DEPTH):
        j = i // N_MIXERS
        if i % N_MIXERS == 0:
            m = stick_breaking_attention(h, attn_w_in[j], attn_w_out[j])
        else:
            m = chunked_spatial_gating(h, gmlp_w_in[j], gmlp_ln_g[j], gmlp_ln_b[j],
                                       gmlp_w_s[j], gmlp_b_s[j], gmlp_w_out[j])
        h = layer_norm(DEEPNORM_ALPHA * h + m, ln_mix_g[i], ln_mix_b[i])
        f = conv_gated_ffn(h, ffn_w_up[i], ffn_conv_w[i], ffn_conv_b[i], ffn_w_down[i])
        h = layer_norm(DEEPNORM_ALPHA * h + f, ln_ffn_g[i], ln_ffn_b[i])
    return h
```

```cpp
#include <hip/hip_runtime.h>
#include <hip/hip_cooperative_groups.h>
#include <cstdio>
#include <cstdint>
namespace cg = cooperative_groups;
__device__ __forceinline__ int opaque_tid() { int t = threadIdx.x; asm volatile("" : "+v"(t)); return t; }
namespace pg8 {
#define PG8_LAS __attribute__((address_space(3)))
typedef unsigned short bf16_t;
typedef short bf16x8 __attribute__((ext_vector_type(8)));
typedef float f32x4 __attribute__((ext_vector_type(4)));
typedef unsigned u32x4 __attribute__((ext_vector_type(4)));
constexpr int BM = 256, BK = 64, HALF = 128, HTB = HALF * BK * 2  , STAGE_BYTES = 8 * HTB, NXCD = 8, WGM = 8;

__host__ __device__ __forceinline__ int lds_byte(int r, int c) { const int st = (r >> 4) * 2 + (c >> 5), rr = r & 15, cc = c & 31, ob = rr * 64 + cc * 2; return st * 1024 + (ob ^ (((ob >> 9) & 1) << 5)); }
__host__ __device__ __forceinline__ void stage_rc(int b, int& R, int& C) { const int st = b / 1024, sb = b % 1024, swz = sb ^ (((sb >> 9) & 1) << 5); R = (st >> 1) * 16 + swz / 64; C = (st & 1) * 32 + (swz % 64) / 2; }
__host__ __device__ __forceinline__ int perm32(int rho) { const int n = rho >> 4, i = rho & 15; return 8 * (i >> 2) + 4 * n + (i & 3); }

struct Unit { int pm, pn; };
struct Gemm { const bf16_t* A; const bf16_t* Bt; int M, N, K; };

struct StaticOrder {
    int nM, nN, nwg, G, c, rev = 0;
    __host__ __device__ void init(int M, int N, int G_, int c_) { nM = M / BM; nN = N / BM; nwg = nM * nN; G = G_; c = c_; }
    __host__ __device__ bool next(int i, Unit& u) const {
        if ((long)i * G + c >= nwg) return false;
        const long L = (long)(rev ? (nwg / G - 1 - i) : i) * G + c;
        int wgid = (int)L; { const int q = nwg / NXCD, r = nwg % NXCD, xcd = wgid % NXCD, off = wgid / NXCD; wgid = (xcd < r ? xcd * (q + 1) : r * (q + 1) + (xcd - r) * q) + off; }
        const int nig = WGM * nN, gid = wgid / nig, fm = gid * WGM, gsz = (nM - fm) < WGM ? (nM - fm) : WGM;
        u.pm = fm + ((wgid % nig) % gsz); u.pn = (wgid % nig) / gsz; return true;
    }
    __device__ __forceinline__ void a_ready(const Unit&) const {}
    __device__ __forceinline__ void done(const Unit&) const {}
};
__device__ __forceinline__ unsigned cvt_pk_bf16(float lo, float hi) { unsigned r; asm volatile("v_cvt_pk_bf16_f32 %0, %1, %2" : "=v"(r) : "v"(lo), "v"(hi)); return r; }
typedef float f32x2 __attribute__((ext_vector_type(2)));
typedef unsigned u32x2e __attribute__((ext_vector_type(2)));
__device__ __forceinline__ float gelu_tanh(float x) {
    const float t = x * (-2.302208198f + (-0.1029432397f) * x * x);
    return x * __builtin_amdgcn_rcpf(1.0f + __builtin_amdgcn_exp2f(t));
}
struct EpiBf16 {
    static constexpr bool PERM = true, AFTER_DRAIN = false;
    bf16_t* O; int ldc; int act; int split_cols; size_t split_stride; float scale0;
    __device__ __forceinline__ void operator()(const f32x4 (&acc)[2][2][4][2], const Unit& u, int wr, int wc, int fr, int fq) const {
        const int row0 = u.pm * BM + wr * 64 + fr; int colt = u.pn * BM; bf16_t* base = O;
        float sc = 1.f; if (split_cols) { const int t = colt / split_cols; base += (size_t)t * split_stride; colt -= t * split_cols; if (t == 0) sc = scale0; }
        const int col0 = colt + wc * 32 + 8 * fq;
#pragma unroll
        for (int ai = 0; ai < 2; ++ai)
#pragma unroll
            for (int m = 0; m < 4; ++m) { bf16_t* rowp = base + (size_t)(row0 + ai * HALF + m * 16) * ldc + col0;
#pragma unroll
                for (int bj = 0; bj < 2; ++bj) { f32x4 v0 = acc[ai][bj][m][0], v1 = acc[ai][bj][m][1];
                    if (act) { v0 = (f32x4){gelu_tanh(v0[0]), gelu_tanh(v0[1]), gelu_tanh(v0[2]), gelu_tanh(v0[3])};
                               v1 = (f32x4){gelu_tanh(v1[0]), gelu_tanh(v1[1]), gelu_tanh(v1[2]), gelu_tanh(v1[3])}; }
                    v0 = v0 * sc; v1 = v1 * sc; u32x4 w; w.x = cvt_pk_bf16(v0[0], v0[1]); w.y = cvt_pk_bf16(v0[2], v0[3]); w.z = cvt_pk_bf16(v1[0], v1[1]); w.w = cvt_pk_bf16(v1[2], v1[3]);
                    *(u32x4*)(rowp + bj * HALF) = w; } }
    }
};
struct EpiRes {
    static constexpr bool PERM = false, AFTER_DRAIN = false;
    const float* base; float* out; int ldc; float alpha;
    __device__ __forceinline__ void operator()(const f32x4 (&acc)[2][2][4][2], const Unit& u, int wr, int wc, int fr, int fq) const {
        const int col0 = u.pn * BM + wc * 32 + 4 * fq;
#pragma unroll
        for (int ai = 0; ai < 2; ++ai)
#pragma unroll
            for (int m = 0; m < 4; ++m) { const size_t off = (size_t)(u.pm * BM + ai * HALF + wr * 64 + m * 16 + fr) * ldc + col0;
#pragma unroll
                for (int bj = 0; bj < 2; ++bj)
#pragma unroll
                    for (int n = 0; n < 2; ++n) { const f32x4 bs = *(const f32x4*)(base + off + bj * HALF + n * 16);
                        *(f32x4*)(out + off + bj * HALF + n * 16) = bs * alpha + acc[ai][bj][m][n]; }
                asm volatile("" ::: "memory"); }
    }
};

template <int CTRL> __device__ __forceinline__ float dpp_mov(float old, float src) {
    return __builtin_bit_cast(float, __builtin_amdgcn_update_dpp(__builtin_bit_cast(int, old), __builtin_bit_cast(int, src), CTRL, 0xf, 0xf, false));
}
struct SeqOrder {
    int G, c;
    __device__ bool next(int i, Unit& u) const { if (i >= 22) return false; int it, step;
        if (i < 16) { it = c + G * (i >> 3); step = i & 7; } else { const int v = 6 * c + (i - 16); it = 512 + (v >> 3); step = v & 7; }
        u.pn = it >> 5; u.pm = 8 * (it & 31) + step; return true; }
    __device__ __forceinline__ void a_ready(const Unit&) const {}
    __device__ __forceinline__ void done(const Unit&) const {}
};
struct EpiConv {
    static constexpr bool PERM = true, AFTER_DRAIN = false;
    bf16_t* O; const float* cw; const float* cb; PG8_LAS unsigned char* hl; int ldo, ncol2, nfeat; float* ht;
    __device__ __forceinline__ void operator()(const f32x4 (&acc)[2][2][4][2], const Unit& u, int wr, int wc, int fr, int fq) const {
        const int lcol = wc * 32 + 8 * fq;
        { const int t = opaque_tid();
          if (t < 256) { const int p = t >> 5, ch = t & 31, pp = p & 3; const float* src = (pp < 3 ? cw + pp * ncol2 : cb) + (p >> 2) * nfeat + 128 * u.pn + 4 * ch;
              *(PG8_LAS f32x4*)(hl + 10240 + (p * 128 + 4 * ch) * 4) = *(const f32x4*)src; } }
        float* const htu = ht + (size_t)(u.pm * 22 + u.pn) * 1024;
        if (fr >= 14) {
#pragma unroll
            for (int ai = 0; ai < 2; ++ai) { const int k = 2 * ai + wr;
                if (k < 3) { PG8_LAS unsigned char* hp = hl + k * 2048 + (fr - 14) * 1024 + lcol * 4;
#pragma unroll
                    for (int bj = 0; bj < 2; ++bj)
#pragma unroll
                        for (int n = 0; n < 2; ++n) *(PG8_LAS f32x4*)(hp + bj * 512 + n * 16) = acc[ai][bj][3][n]; }
                else {
#pragma unroll
                    for (int bj = 0; bj < 2; ++bj)
#pragma unroll
                        for (int n = 0; n < 2; ++n) *(f32x4*)(htu + (2 + fr - 14) * 256 + bj * 128 + lcol + 4 * n) = acc[ai][bj][3][n]; } }
        }
        if (wr == 0 && fr < 2) {
#pragma unroll
            for (int bj = 0; bj < 2; ++bj)
#pragma unroll
                for (int n = 0; n < 2; ++n) *(f32x4*)(htu + fr * 256 + bj * 128 + lcol + 4 * n) = acc[0][bj][0][n];
        }
        asm volatile("s_waitcnt lgkmcnt(0)" ::: "memory"); __builtin_amdgcn_s_barrier(); asm volatile("" ::: "memory");
#pragma unroll
        for (int n = 0; n < 2; ++n) {
            const int f = 128 * u.pn + lcol + 4 * n;
            PG8_LAS const float* const wl = (PG8_LAS const float*)(hl + 10240) + lcol + 4 * n;
            const f32x4 wg0 = *(PG8_LAS const f32x4*)(wl), wg1 = *(PG8_LAS const f32x4*)(wl + 128), wg2 = *(PG8_LAS const f32x4*)(wl + 256), bg = *(PG8_LAS const f32x4*)(wl + 384);
            const f32x4 wv0 = *(PG8_LAS const f32x4*)(wl + 512), wv1 = *(PG8_LAS const f32x4*)(wl + 640), wv2 = *(PG8_LAS const f32x4*)(wl + 768), bv = *(PG8_LAS const f32x4*)(wl + 896);
#pragma unroll
            for (int ai = 0; ai < 2; ++ai) {
                const int k = 2 * ai + wr;
                const int rslot = k > 0 ? k - 1 : 0;
                PG8_LAS const unsigned char* hp = hl + rslot * 2048 + (lcol + 4 * n) * 4;
                f32x4 hg2 = *(PG8_LAS const f32x4*)hp, hv2 = *(PG8_LAS const f32x4*)(hp + 512), hg1 = *(PG8_LAS const f32x4*)(hp + 1024), hv1 = *(PG8_LAS const f32x4*)(hp + 1536);
                if (k == 0) { hg2 = (f32x4){0.f, 0.f, 0.f, 0.f}; hv2 = hg2; hg1 = hg2; hv1 = hg2; }
#pragma unroll
                for (int m = 0; m < 4; ++m) {
                    float r[4];
#pragma unroll
                    for (int e = 0; e < 4; ++e) {
                        const float xg = acc[ai][0][m][n][e], xv = acc[ai][1][m][n][e];
                        float o1g, o2g, o1v, o2v;
                        if (m == 0) { o1g = hg1[e]; o2g = fr == 0 ? hg2[e] : hg1[e]; o1v = hv1[e]; o2v = fr == 0 ? hv2[e] : hv1[e]; }
                        else { const float pgv = acc[ai][0][m > 0 ? m - 1 : 0][n][e], pvv = acc[ai][1][m > 0 ? m - 1 : 0][n][e];
                            o1g = dpp_mov<0x121>(pgv, pgv); o2g = dpp_mov<0x122>(pgv, pgv); o1v = dpp_mov<0x121>(pvv, pvv); o2v = dpp_mov<0x122>(pvv, pvv); }
                        const float p1g = dpp_mov<0x111>(o1g, xg), p2g = dpp_mov<0x112>(o2g, xg), p1v = dpp_mov<0x111>(o1v, xv), p2v = dpp_mov<0x112>(o2v, xv);
                        const float yg = bg[e] + wg2[e] * xg + wg1[e] * p1g + wg0[e] * p2g;
                        const float yv = bv[e] + wv2[e] * xv + wv1[e] * p1v + wv0[e] * p2v;
                        r[e] = yg * __builtin_amdgcn_rcpf(1.0f + __builtin_amdgcn_exp2f(-1.4426950408889634f * yg)) * yv;
                    }
                    u32x2e w; w.x = cvt_pk_bf16(r[0], r[1]); w.y = cvt_pk_bf16(r[2], r[3]);
                    *(u32x2e*)(O + (size_t)(u.pm * BM + ai * HALF + wr * 64 + m * 16 + fr) * ldo + f) = w;
                }
            }
        }
    }
};

struct EpiResLn {
    static constexpr bool PERM = false, AFTER_DRAIN = false;
    const float* base; float* out; const float* pms; const float* pg; const float* pb; float* st; float* ms; const float* cg; const float* cbeta; bf16_t* hb; unsigned* gcnt; unsigned tgt0; int last; PG8_LAS unsigned char* xl; int rev;
    static constexpr int ldc = 1024; static constexpr float alpha = 1.681792830507429f, eps = 1e-5f;
    __device__ __forceinline__ void operator()(f32x4 (&acc)[2][2][4][2], const Unit& u, int wr, int wc, int fr, int fq) const {
        asm volatile("" : "+v"(fr), "+v"(fq));
        typedef float f32x2s __attribute__((ext_vector_type(2)));
        PG8_LAS float* const sl = (PG8_LAS float*)xl; PG8_LAS float* const gl = (PG8_LAS float*)(xl + 8192);
        const int col0 = u.pn * BM + wc * 32 + 4 * fq, lc0 = wc * 32 + 4 * fq;
        { const int t = opaque_tid();
          if (t < 256) { const int which = t >> 6, c4 = 4 * (t & 63); f32x4 v = (which & 1) ? (f32x4){0.f, 0.f, 0.f, 0.f} : (f32x4){1.f, 1.f, 1.f, 1.f};
              if (which >= 2) v = *(const f32x4*)((which == 2 ? cg : cbeta) + u.pn * BM + c4);
              else if (pms) v = *(const f32x4*)((which ? pb : pg) + u.pn * BM + c4);
              *(PG8_LAS f32x4*)(gl + which * 256 + c4) = v; } }
        float mu[8], rs[8];
#pragma unroll
        for (int i = 0; i < 8; ++i) { mu[i] = 0.f; rs[i] = 1.f;
            if (pms) { const f32x2s v = *(const f32x2s*)(pms + ((size_t)u.pm * BM + (i >> 2) * HALF + wr * 64 + (i & 3) * 16 + fr) * 2); mu[i] = v.x; rs[i] = v.y; } }
        f32x4 nb[4];
        { const size_t off = ((size_t)u.pm * BM + wr * 64 + fr) * ldc + col0;
#pragma unroll
          for (int q = 0; q < 4; ++q) nb[q] = *(const f32x4*)(base + off + (q >> 1) * HALF + (q & 1) * 16); }
        asm volatile("s_waitcnt lgkmcnt(0)" ::: "memory"); __builtin_amdgcn_s_barrier(); asm volatile("" ::: "memory");
#pragma unroll
        for (int i = 0; i < 8; ++i) { const int ai = i >> 2, m = i & 3; const int lrow = ai * HALF + wr * 64 + m * 16 + fr; const size_t off = ((size_t)u.pm * BM + lrow) * ldc + col0;
            f32x4 cur[4];
#pragma unroll
            for (int q = 0; q < 4; ++q) cur[q] = nb[q];
            if (i < 7) { const int lr2 = ((i + 1) >> 2) * HALF + wr * 64 + ((i + 1) & 3) * 16 + fr; const size_t off2 = ((size_t)u.pm * BM + lr2) * ldc + col0;
#pragma unroll
                for (int q = 0; q < 4; ++q) nb[q] = *(const f32x4*)(base + off2 + (q >> 1) * HALF + (q & 1) * 16); }
            asm volatile("" ::: "memory");
            float rsum = 0.f, rq = 0.f;
#pragma unroll
            for (int q = 0; q < 4; ++q) { const int bj = q >> 1, n = q & 1;
                const f32x4 g4 = *(PG8_LAS const f32x4*)(gl + lc0 + bj * HALF + n * 16), b4 = *(PG8_LAS const f32x4*)(gl + 256 + lc0 + bj * HALF + n * 16);
                const f32x4 h = (cur[q] - mu[i]) * rs[i] * g4 + b4;
                const f32x4 y = h * alpha + acc[ai][bj][m][n];
                acc[ai][bj][m][n] = y;
                if (!last) *(f32x4*)(out + off + bj * HALF + n * 16) = y;
                rsum += (y[0] + y[1]) + (y[2] + y[3]); rq += (y[0] * y[0] + y[1] * y[1]) + (y[2] * y[2] + y[3] * y[3]); }
            rsum += __shfl_xor(rsum, 16); rsum += __shfl_xor(rsum, 32); rq += __shfl_xor(rq, 16); rq += __shfl_xor(rq, 32);
            if (fq == 0) { sl[(lrow * 4 + wc) * 2] = rsum; sl[(lrow * 4 + wc) * 2 + 1] = rq; }
            asm volatile("" ::: "memory"); }
        asm volatile("s_waitcnt lgkmcnt(0)" ::: "memory"); __builtin_amdgcn_s_barrier(); asm volatile("" ::: "memory");
        const int t = opaque_tid();
        if (t < 256) { const f32x4 a = *(PG8_LAS const f32x4*)(sl + t * 8), b = *(PG8_LAS const f32x4*)(sl + t * 8 + 4);
            const float ssum = (a[0] + a[2]) + (b[0] + b[2]), ssq = (a[1] + a[3]) + (b[1] + b[3]);
            __hip_atomic_store((unsigned long long*)(st + ((size_t)u.pm * BM + t) * 8 + u.pn * 2), ((unsigned long long)__float_as_uint(ssq) << 32) | __float_as_uint(ssum), __ATOMIC_RELAXED, __HIP_MEMORY_SCOPE_AGENT); }
        asm volatile("s_waitcnt vmcnt(0) lgkmcnt(0)" ::: "memory"); __builtin_amdgcn_s_barrier(); asm volatile("" ::: "memory");
        if (t == 0) {
            unsigned* const ctr = gcnt + 64 * (blockIdx.x & 7); const unsigned target = tgt0 + 32u * (unsigned)((rev ? 3 - ((u.pm >> 3) & 3) : ((u.pm >> 3) & 3)) + 1);
            __hip_atomic_fetch_add(ctr, 1u, __ATOMIC_RELAXED, __HIP_MEMORY_SCOPE_AGENT);
            while (__hip_atomic_load(ctr, __ATOMIC_RELAXED, __HIP_MEMORY_SCOPE_AGENT) < target) __builtin_amdgcn_s_sleep(1);
        }
        __builtin_amdgcn_s_barrier(); asm volatile("" ::: "memory");
        if (t < 256) { const size_t row = (size_t)u.pm * BM + t;
            float s = 0.f, q = 0.f;
#pragma unroll
            for (int k4 = 0; k4 < 4; ++k4) { const unsigned long long w = __hip_atomic_load((const unsigned long long*)(st + row * 8 + 2 * k4), __ATOMIC_RELAXED, __HIP_MEMORY_SCOPE_AGENT);
                s += __uint_as_float((unsigned)w); q += __uint_as_float((unsigned)(w >> 32)); }
            const float mean = s * (1.f / 1024.f), rstd = 1.f / sqrtf(q * (1.f / 1024.f) - mean * mean + eps);
            *(PG8_LAS f32x2s*)(sl + 2 * t) = (f32x2s){mean, rstd};
            if (u.pn == 0) *(f32x2s*)(ms + row * 2) = (f32x2s){mean, rstd}; }
        asm volatile("s_waitcnt lgkmcnt(0)" ::: "memory"); __builtin_amdgcn_s_barrier(); asm volatile("" ::: "memory");
#pragma unroll
        for (int i = 0; i < 8; ++i) { const int ai = i >> 2, m = i & 3; const int lrow = ai * HALF + wr * 64 + m * 16 + fr; const size_t off = ((size_t)u.pm * BM + lrow) * ldc + col0;
            const f32x2s mr = *(PG8_LAS const f32x2s*)(sl + 2 * lrow);
#pragma unroll
            for (int q = 0; q < 4; ++q) { const int bj = q >> 1, n = q & 1;
                const f32x4 g4 = *(PG8_LAS const f32x4*)(gl + 512 + lc0 + bj * HALF + n * 16), b4 = *(PG8_LAS const f32x4*)(gl + 768 + lc0 + bj * HALF + n * 16);
                const f32x4 o = (acc[ai][bj][m][n] - mr.x) * mr.y * g4 + b4;
                if (last) *(f32x4*)(out + off + bj * HALF + n * 16) = o;
                else { u32x2e w; w.x = cvt_pk_bf16(o[0], o[1]); w.y = cvt_pk_bf16(o[2], o[3]); *(u32x2e*)(hb + off + bj * HALF + n * 16) = w; } }
            asm volatile("" ::: "memory"); }
    }
};

template <class Epi, class Sched, bool ALIGN_EPI = false, bool SP2 = false>
__device__ __forceinline__ void gemm_phase(PG8_LAS unsigned char* lds, const Gemm g, const Sched& S, const Epi& E) {
    const int tid = opaque_tid(), wid = __builtin_amdgcn_readfirstlane(tid >> 6), lane = tid & 63, wr = wid >> 2, wc = wid & 3, fr = lane & 15, fq = lane >> 4;
    const int K = g.K, nt = K / BK;
    unsigned voffA[2], voffB[2];
#pragma unroll
    for (int i = 0; i < 2; ++i) { int R, C; stage_rc(tid * 16 + i * 8192, R, C); const int Rb = Epi::PERM ? ((R & ~31) + perm32(R & 31)) : R;
        voffA[i] = (unsigned)(R * K + C) * 2u; voffB[i] = (unsigned)(Rb * K + C) * 2u; }
    const size_t kstep = (size_t)(BK * 2);
    const size_t hstep = (size_t)HALF * K * 2;
    const size_t tstep = 2 * hstep;
    const unsigned ldsw = (unsigned)wid * 1024u;
    const int aoff = lds_byte(wr * 64 + fr, fq * 8), boff = lds_byte(wc * 32 + fr, fq * 8);
#define PG8_SA(b, h) (((b) * 2 + (h)) * HTB)
#define PG8_SB(b, h) ((4 + (b) * 2 + (h)) * HTB)
#define PG8_STAGE(bufoff, gbase, voff) do { _Pragma("unroll") for (int _i = 0; _i < 2; ++_i) \
        __builtin_amdgcn_global_load_lds((const unsigned*)((const char*)(gbase) + (voff)[_i]), (PG8_LAS unsigned*)(lds + (bufoff) + ldsw + _i * 8192), 16, 0, 0); } while (0)
#define PG8_LDA(dst, b, h) do { _Pragma("unroll") for (int m = 0; m < 4; ++m) _Pragma("unroll") for (int k = 0; k < 2; ++k) dst[m][k] = *(const PG8_LAS bf16x8*)(lds + PG8_SA(b, h) + aoff + m * 2048 + k * 1024); } while (0)
#define PG8_LDB(dst, b, h) do { _Pragma("unroll") for (int n = 0; n < 2; ++n) _Pragma("unroll") for (int k = 0; k < 2; ++k) dst[n][k] = *(const PG8_LAS bf16x8*)(lds + PG8_SB(b, h) + boff + n * 2048 + k * 1024); } while (0)
#define PG8_MMA(ai, bj, At, Bt) do { __builtin_amdgcn_s_setprio(1); _Pragma("unroll") for (int m = 0; m < 4; ++m) _Pragma("unroll") for (int n = 0; n < 2; ++n) _Pragma("unroll") for (int k = 0; k < 2; ++k) \
        acc[ai][bj][m][n] = __builtin_amdgcn_mfma_f32_16x16x32_bf16(Bt[n][k], At[m][k], acc[ai][bj][m][n], 0, 0, 0); __builtin_amdgcn_s_setprio(0); } while (0)
#define PG8_WAIT_V(n) asm volatile("s_waitcnt vmcnt(" #n ")" ::: "memory")
#define PG8_WAIT_L(n) asm volatile("s_waitcnt lgkmcnt(" #n ")" ::: "memory")
#define PG8_BAR __builtin_amdgcn_s_barrier()
#define PG8_SCHED __builtin_amdgcn_sched_barrier(0)
    Unit cur, nxt; int ui = 0;
    if (!S.next(0, cur)) return;
    f32x4 acc[2][2][4][2];
#pragma unroll
    for (int a = 0; a < 2; ++a)
#pragma unroll
        for (int b = 0; b < 2; ++b)
#pragma unroll
            for (int m = 0; m < 4; ++m)
#pragma unroll
                for (int n = 0; n < 2; ++n) acc[a][b][m][n] = (f32x4){0.f, 0.f, 0.f, 0.f};
    bf16x8 At[4][2], B0[2][2], B1[2][2];
    const char* cA = (const char*)g.A + (size_t)cur.pm * tstep; const char* cB = (const char*)g.Bt + (size_t)cur.pn * tstep;
    S.a_ready(cur);
    if constexpr (SP2) {
        PG8_STAGE(PG8_SB(0, 0), cB, voffB); PG8_STAGE(PG8_SB(0, 1), cB + hstep, voffB); PG8_STAGE(PG8_SA(0, 0), cA, voffA); PG8_STAGE(PG8_SA(0, 1), cA + hstep, voffA);
        if (wr == 1) PG8_BAR;
        PG8_WAIT_V(2); PG8_BAR;
        PG8_STAGE(PG8_SB(1, 0), cB + kstep, voffB); PG8_STAGE(PG8_SA(1, 0), cA + kstep, voffA); PG8_STAGE(PG8_SB(1, 1), cB + hstep + kstep, voffB);
        PG8_WAIT_V(6); PG8_BAR;
    } else {
        PG8_STAGE(PG8_SB(0, 0), cB, voffB); PG8_STAGE(PG8_SA(0, 0), cA, voffA); PG8_STAGE(PG8_SB(0, 1), cB + hstep, voffB); PG8_STAGE(PG8_SA(0, 1), cA + hstep, voffA);
        if (wr == 1) PG8_BAR;
        PG8_WAIT_V(4); PG8_BAR;
        PG8_STAGE(PG8_SB(1, 0), cB + kstep, voffB); PG8_STAGE(PG8_SA(1, 0), cA + kstep, voffA); PG8_STAGE(PG8_SB(1, 1), cB + hstep + kstep, voffB);
        PG8_WAIT_V(6); PG8_BAR;
    }
    for (;;) {
        const bool has_next = S.next(ui + 1, nxt);
        const char* nA = has_next ? (const char*)g.A + (size_t)nxt.pm * tstep : cA; const char* nB = has_next ? (const char*)g.Bt + (size_t)nxt.pn * tstep : cB;
        for (int t = 0; t < nt; t += 2) {
            const bool last = (t == nt - 2);
            const char* a1 = cA + (size_t)(t + 1) * kstep;
            const char* a2 = last ? nA : cA + (size_t)(t + 2) * kstep; const char* b2 = last ? nB : cB + (size_t)(t + 2) * kstep;
            const char* a3 = a2 + kstep; const char* b3 = b2 + kstep;
            if (last && has_next) S.a_ready(nxt);
            if constexpr (SP2) {
            PG8_LDB(B0, 0, 0); PG8_LDB(B1, 0, 1); PG8_SCHED; PG8_LDA(At, 0, 0); PG8_STAGE(PG8_SA(1, 1), a1 + hstep, voffA);
            PG8_WAIT_V(8); PG8_WAIT_L(0); PG8_BAR; PG8_MMA(0, 0, At, B0); PG8_MMA(0, 1, At, B1); PG8_BAR; PG8_SCHED;
            PG8_LDA(At, 0, 1); PG8_STAGE(PG8_SB(0, 0), b2, voffB); PG8_STAGE(PG8_SB(0, 1), b2 + hstep, voffB); PG8_STAGE(PG8_SA(0, 0), a2, voffA);
            PG8_WAIT_V(8); PG8_WAIT_L(0); PG8_BAR; PG8_MMA(1, 0, At, B0); PG8_MMA(1, 1, At, B1); PG8_BAR; PG8_SCHED;
            PG8_LDB(B0, 1, 0); PG8_LDB(B1, 1, 1); PG8_SCHED; PG8_LDA(At, 1, 0); PG8_STAGE(PG8_SA(0, 1), a2 + hstep, voffA);
            PG8_WAIT_V(8); PG8_WAIT_L(0); PG8_BAR; PG8_MMA(0, 0, At, B0); PG8_MMA(0, 1, At, B1); PG8_BAR; PG8_SCHED;
            PG8_LDA(At, 1, 1); PG8_STAGE(PG8_SB(1, 0), b3, voffB); PG8_STAGE(PG8_SB(1, 1), b3 + hstep, voffB); PG8_STAGE(PG8_SA(1, 0), a3, voffA);
            PG8_WAIT_V(8); PG8_WAIT_L(0); PG8_BAR; PG8_MMA(1, 0, At, B0); PG8_MMA(1, 1, At, B1); PG8_BAR; PG8_SCHED;
            } else {
            PG8_LDB(B0, 0, 0); PG8_SCHED; PG8_LDA(At, 0, 0); PG8_STAGE(PG8_SA(1, 1), a1 + hstep, voffA);
            PG8_WAIT_L(8); PG8_BAR; PG8_WAIT_L(0); PG8_MMA(0, 0, At, B0); PG8_BAR; PG8_SCHED;
            PG8_LDB(B1, 0, 1); PG8_STAGE(PG8_SB(0, 0), b2, voffB);
            PG8_BAR; PG8_WAIT_L(0); PG8_MMA(0, 1, At, B1); PG8_BAR;
            PG8_LDA(At, 0, 1); PG8_STAGE(PG8_SA(0, 0), a2, voffA);
            PG8_BAR; PG8_WAIT_L(0); PG8_MMA(1, 0, At, B0); PG8_BAR; PG8_SCHED;
            PG8_STAGE(PG8_SB(0, 1), b2 + hstep, voffB);
            PG8_WAIT_V(6); PG8_BAR; PG8_MMA(1, 1, At, B1); PG8_BAR;
            PG8_LDB(B0, 1, 0); PG8_SCHED; PG8_LDA(At, 1, 0); PG8_STAGE(PG8_SA(0, 1), a2 + hstep, voffA);
            PG8_WAIT_L(8); PG8_BAR; PG8_WAIT_L(0); PG8_MMA(0, 0, At, B0); PG8_BAR; PG8_SCHED;
            PG8_LDB(B1, 1, 1); PG8_STAGE(PG8_SB(1, 0), b3, voffB);
            PG8_BAR; PG8_WAIT_L(0); PG8_MMA(0, 1, At, B1); PG8_BAR;
            PG8_LDA(At, 1, 1); PG8_STAGE(PG8_SA(1, 0), a3, voffA);
            PG8_BAR; PG8_WAIT_L(0); PG8_MMA(1, 0, At, B0); PG8_BAR; PG8_SCHED;
            PG8_STAGE(PG8_SB(1, 1), b3 + hstep, voffB);
            PG8_WAIT_V(6); PG8_BAR; PG8_MMA(1, 1, At, B1); PG8_BAR;
            }
        }
        if constexpr (ALIGN_EPI) { if (wr == 0) PG8_BAR; }
        if constexpr (!Epi::AFTER_DRAIN) { E(acc, cur, wr, wc, fr, fq); S.done(cur); }
        if (!has_next) break;
#pragma unroll
        for (int a = 0; a < 2; ++a)
#pragma unroll
            for (int b = 0; b < 2; ++b)
#pragma unroll
                for (int m = 0; m < 4; ++m)
#pragma unroll
                    for (int n = 0; n < 2; ++n) acc[a][b][m][n] = (f32x4){0.f, 0.f, 0.f, 0.f};
        cur = nxt; cA = nA; cB = nB; ++ui;
        if constexpr (ALIGN_EPI) { if (wr == 1) PG8_BAR; }
    }
    PG8_WAIT_V(0);
    if constexpr (!ALIGN_EPI) { if (wr == 0) PG8_BAR; }
    PG8_BAR;
    if constexpr (Epi::AFTER_DRAIN) { E.fused(acc, cur, wr, wc, fr, fq, lds, wid, lane); S.done(cur); }
#undef PG8_SA
#undef PG8_SB
#undef PG8_STAGE
#undef PG8_LDA
#undef PG8_LDB
#undef PG8_MMA
#undef PG8_WAIT_V
#undef PG8_WAIT_L
#undef PG8_BAR
#undef PG8_SCHED
}
}

constexpr int NB = 32, SEQ = 2048, DM = 1024, NTOK = NB * SEQ;
constexpr int NH = 16, HD = 64, GW = 2048, GG = 8, GC = 128, FF = 2816, FF2 = 5632, DEPTH = 4;
constexpr float LN_EPS = 1e-5f;
constexpr float DN_ALPHA = 1.681792830507429f;
constexpr int HALF_TOK = NTOK / 2;

constexpr size_t MiB = 1u << 20;
constexpr size_t WS_ATTN_IN = 0, WS_ATTN_OUT = 12 * MiB, WS_GMLP_IN = 16 * MiB, WS_GMLP_OUT = 32 * MiB, WS_FFN_UP = 40 * MiB, WS_FFN_DOWN = 84 * MiB, WS_WS = 106 * MiB;
constexpr size_t WS_MS = 110 * MiB;
constexpr size_t WS_CTL = 107 * MiB;
constexpr size_t WS_ST = 108 * MiB;
constexpr size_t WS_HB = 112 * MiB;
constexpr size_t WS_R = 240 * MiB;
constexpr size_t WS_Q = WS_R, WS_K = WS_R + 128 * MiB, WS_V = WS_R + 256 * MiB, WS_O = WS_R + 384 * MiB;
constexpr size_t WS_ZZ = WS_R, WS_GT = WS_R + 512 * MiB;
constexpr size_t WS_HT = WS_R + 400 * MiB;
constexpr size_t WS_G = WS_R;
constexpr size_t WS_END = 1008 * MiB;

constexpr int LDS_BYTES = 147456;

#define LAS __attribute__((address_space(3)))
typedef unsigned short bf16;
typedef unsigned u32x4 __attribute__((ext_vector_type(4)));
typedef unsigned u32x2 __attribute__((ext_vector_type(2)));
typedef float f32x4 __attribute__((ext_vector_type(4)));
typedef float f32x16 __attribute__((ext_vector_type(16)));
typedef short bf16x8 __attribute__((ext_vector_type(8)));
typedef short s16x4 __attribute__((ext_vector_type(4)));

__device__ __forceinline__ unsigned pk2(float lo, float hi) { return pg8::cvt_pk_bf16(lo, hi); }
__device__ __forceinline__ float bflo(unsigned w) { return __uint_as_float(w << 16); }
__device__ __forceinline__ float bfhi(unsigned w) { return __uint_as_float(w & 0xffff0000u); }
__device__ __forceinline__ float wave_sum(float v) {
#pragma unroll
    for (int o = 1; o < 64; o <<= 1) v += __shfl_xor(v, o);
    return v;
}
__device__ __forceinline__ s16x4 vtr(LAS const unsigned char* p) { return __builtin_bit_cast(s16x4, __builtin_amdgcn_ds_read_tr16_b64_v4i16((LAS s16x4*)p)); }

__device__ __forceinline__ void transpose_item(const float* W, int K, int N, bf16* WT, int perm, LAS float* scr, int item, int lane) {
    const int nblk = N / 32, kb = item / nblk, nb = item % nblk, k0 = 64 * kb, n0 = 32 * nb;
    int r0 = n0;
    if (perm) { const int bj = n0 / FF, f0 = n0 - bj * FF; r0 = (f0 >> 7) * 256 + bj * 128 + (f0 & 127); }
#pragma unroll 8
    for (int i = 0; i < 32; ++i) { const int kk = 2 * i + (lane >> 5); scr[kk * 33 + (lane & 31)] = W[(size_t)(k0 + kk) * N + n0 + (lane & 31)]; }
    asm volatile("s_waitcnt lgkmcnt(0)" ::: "memory");
    const int c = lane & 7;
#pragma unroll
    for (int j = 0; j < 4; ++j) { const int n = (lane >> 3) + 8 * j; const LAS float* s = scr + (8 * c) * 33 + n;
        u32x4 o; o.x = pk2(s[0 * 33], s[1 * 33]); o.y = pk2(s[2 * 33], s[3 * 33]); o.z = pk2(s[4 * 33], s[5 * 33]); o.w = pk2(s[6 * 33], s[7 * 33]);
        *(u32x4*)(WT + (size_t)(r0 + n) * K + k0 + 8 * c) = o; }
    asm volatile("s_waitcnt lgkmcnt(0)" ::: "memory");
}

struct Args { const float* in[17]; float* out; unsigned char* ws; };

__device__ __forceinline__ void ln_apply(const float* Y, float* Yo, bf16* HB, const float* st, float* ms, const float* gam, const float* bet, int gw, int ngw, int lane) {
    f32x4 g4[4], b4[4];
#pragma unroll
    for (int j = 0; j < 4; ++j) { g4[j] = ((const f32x4*)gam)[lane + 64 * j]; b4[j] = ((const f32x4*)bet)[lane + 64 * j]; }
    for (int m = gw; m < NTOK; m += ngw) {
        const f32x4* yr = (const f32x4*)(Y + (size_t)m * DM) + lane;
        f32x4 v[4];
#pragma unroll
        for (int j = 0; j < 4; ++j) v[j] = yr[64 * j];
        const f32x4 a = *(const f32x4*)(st + (size_t)m * 8), b = *(const f32x4*)(st + (size_t)m * 8 + 4);
        const float s = (a[0] + a[2]) + (b[0] + b[2]), q = (a[1] + a[3]) + (b[1] + b[3]);
        const float mean = s * (1.f / DM), rstd = 1.f / sqrtf(q * (1.f / DM) - mean * mean + LN_EPS);
        if (lane == 0) { ms[(size_t)m * 2] = mean; ms[(size_t)m * 2 + 1] = rstd; }
        u32x2* o8 = (u32x2*)(HB + (size_t)m * DM) + lane;
#pragma unroll
        for (int j = 0; j < 4; ++j) { const f32x4 o = (v[j] - mean) * rstd * g4[j] + b4[j]; if (Yo) ((f32x4*)(Yo + (size_t)m * DM) + lane)[64 * j] = o; u32x2 w; w.x = pk2(o.x, o.y); w.y = pk2(o.z, o.w); o8[64 * j] = w; }
    }
}

__device__ __forceinline__ void ffn_fix_phase(const float* HT, bf16* Gb, const float* cw, const float* cb, int cu, int G, int tid) {
    const int sub = tid >> 6, r = (tid >> 5) & 1, f = (tid & 31) * 4;
    for (int up = cu * 8 + sub; up < 224 * 22; up += G * 8) {
        const int pn = up % 22, pq = up / 22, pm = pq + pq / 7 + 1;
        const float* hc = HT + (size_t)(pm * 22 + pn) * 1024; const float* hp = HT + (size_t)((pm - 1) * 22 + pn) * 1024;
        f32x4 y[2];
#pragma unroll
        for (int hh = 0; hh < 2; ++hh) { const int c = hh * 128 + f; const int F = hh * FF + 128 * pn + f;
            const f32x4 h0 = *(const f32x4*)(hc + c), h1 = *(const f32x4*)(hc + 256 + c), t0 = *(const f32x4*)(hp + 512 + c), t1 = *(const f32x4*)(hp + 768 + c);
            const f32x4 x0 = r ? h1 : h0, xm1 = r ? h0 : t1, xm2 = r ? t1 : t0;
            y[hh] = *(const f32x4*)(cb + F) + *(const f32x4*)(cw + F) * xm2 + *(const f32x4*)(cw + FF2 + F) * xm1 + *(const f32x4*)(cw + 2 * FF2 + F) * x0; }
        float v[4];
#pragma unroll
        for (int e = 0; e < 4; ++e) v[e] = y[0][e] * __builtin_amdgcn_rcpf(1.0f + __builtin_amdgcn_exp2f(-1.4426950408889634f * y[0][e])) * y[1][e];
        u32x2 w; w.x = pk2(v[0], v[1]); w.y = pk2(v[2], v[3]);
        *(u32x2*)(Gb + (size_t)(pm * 256 + r) * FF + 128 * pn + f) = w;
    }
}

__device__ __forceinline__ void attn_phase(LAS unsigned char* lds, const bf16* Q, const bf16* K, const bf16* V, bf16* O, int cu, int G) {
    const int tid = opaque_tid(), lane = tid & 63, wid = __builtin_amdgcn_readfirstlane(tid >> 6), q32 = lane & 31, hi = lane >> 5, li = lane & 15;
    LAS unsigned char* Ks = lds + wid * 10752;
    LAS unsigned char* Vs = Ks + 4608;
    const int lkey = lane >> 3, lch = lane & 7;
    const float LOG2E = 1.4426950408889634f;
    for (int k = 0; k < 16; ++k) {
        const int idx = cu * 8 + wid + 2048 * (k & 3), b = 4 * (idx & 7) + 3 - (k >> 2), h = (idx >> 3) & 15, qb = idx >> 7;
        const size_t rowbase = (size_t)b * SEQ;
        const int q0w = qb * 32;
        bf16x8 qf[4];
        { const bf16* qp = Q + (rowbase + q0w + q32) * DM + h * HD + hi * 8;
#pragma unroll
          for (int ks = 0; ks < 4; ++ks) qf[ks] = *(const bf16x8*)(qp + ks * 16); }
        f32x16 o0, o1;
#pragma unroll
        for (int r = 0; r < 16; ++r) { o0[r] = 0.f; o1[r] = 0.f; }
        float R = 0.f;
        const bf16* kp = K + (rowbase + lkey) * DM + h * HD + lch * 8;
        const bf16* vp = V + (rowbase + lkey) * DM + h * HD + lch * 8;
        u32x4 kr[4], vr[4];
#pragma unroll
        for (int jj = 0; jj < 4; ++jj) { kr[jj] = *(const u32x4*)(kp + (size_t)(q0w + 8 * jj) * DM); vr[jj] = *(const u32x4*)(vp + (size_t)(q0w + 8 * jj) * DM); }
        for (int key0 = q0w; key0 >= 0; key0 -= 32) {
#pragma unroll
            for (int jj = 0; jj < 4; ++jj) { *(LAS u32x4*)(Ks + (lkey + 8 * jj) * 144 + lch * 16) = kr[jj]; *(LAS u32x4*)(Vs + (lkey + 8 * jj) * 192 + lch * 16) = vr[jj]; }
            asm volatile("s_waitcnt lgkmcnt(0)" ::: "memory");
            if (key0 >= 32) {
#pragma unroll
                for (int jj = 0; jj < 4; ++jj) { kr[jj] = *(const u32x4*)(kp + (size_t)(key0 - 32 + 8 * jj) * DM); vr[jj] = *(const u32x4*)(vp + (size_t)(key0 - 32 + 8 * jj) * DM); } }
            const bool diag = (key0 == q0w);
            f32x16 s;
#pragma unroll
            for (int r = 0; r < 16; ++r) s[r] = 0.f;
#pragma unroll
            for (int ks = 0; ks < 4; ++ks) { const bf16x8 kf = *(LAS const bf16x8*)(Ks + q32 * 144 + (16 * ks + 8 * hi) * 2);
                s = __builtin_amdgcn_mfma_f32_32x32x16_bf16(kf, qf[ks], s, 0, 0, 0); }
            float zs[16], l1[16];
#pragma unroll
            for (int r = 0; r < 16; ++r) { const float z = s[r] * LOG2E; const float e = __builtin_amdgcn_exp2f(-__builtin_fabsf(z)); const float t = __builtin_amdgcn_logf(1.0f + e);
                float l = -(__builtin_fmaxf(z, 0.f) + t);
                if (diag) { const int kl = 8 * (r >> 2) + 4 * hi + (r & 3); if (kl >= q32) l = 0.f; }
                zs[r] = z; l1[r] = l; }
            float G0[4], G1[4];
#pragma unroll
            for (int j = 0; j < 4; ++j) { const float gs = (l1[4 * j] + l1[4 * j + 1]) + (l1[4 * j + 2] + l1[4 * j + 3]);
                auto rr = __builtin_amdgcn_permlane32_swap(__float_as_uint(gs), __float_as_uint(gs), false, false); G0[j] = __uint_as_float(rr[0]); G1[j] = __uint_as_float(rr[1]); }
            float p[16]; float run = R;
#pragma unroll
            for (int j = 3; j >= 0; --j) { float sfx = run + (hi == 0 ? G1[j] : 0.f);
#pragma unroll
                for (int e = 3; e >= 0; --e) { const int r = 4 * j + e; float val = __builtin_amdgcn_exp2f(l1[r] + zs[r] + sfx);
                    if (diag) { const int kl = 8 * j + 4 * hi + e; if (kl >= q32) val = 0.f; }
                    p[r] = val; sfx += l1[r]; }
                run += G0[j] + G1[j]; }
            R = run;
#pragma unroll
            for (int ks2 = 0; ks2 < 2; ++ks2) {
                u32x4 pw; pw.x = pk2(p[8 * ks2], p[8 * ks2 + 1]); pw.y = pk2(p[8 * ks2 + 2], p[8 * ks2 + 3]); pw.z = pk2(p[8 * ks2 + 4], p[8 * ks2 + 5]); pw.w = pk2(p[8 * ks2 + 6], p[8 * ks2 + 7]);
                const bf16x8 pb = __builtin_bit_cast(bf16x8, pw);
#pragma unroll
                for (int dh = 0; dh < 2; ++dh) {
                    LAS const unsigned char* va = Vs + (16 * ks2 + 4 * hi + (li >> 2)) * 192 + (32 * dh + 16 * ((lane >> 4) & 1) + 4 * (li & 3)) * 2;
                    const s16x4 lo = vtr(va), hi4 = vtr(va + 8 * 192);
                    const bf16x8 vf = (bf16x8){lo[0], lo[1], lo[2], lo[3], hi4[0], hi4[1], hi4[2], hi4[3]};
                    if (dh == 0) o0 = __builtin_amdgcn_mfma_f32_32x32x16_bf16(vf, pb, o0, 0, 0, 0);
                    else         o1 = __builtin_amdgcn_mfma_f32_32x32x16_bf16(vf, pb, o1, 0, 0, 0);
                }
            }
            asm volatile("s_waitcnt lgkmcnt(0)" ::: "memory");
            if (__all(R < -150.0f)) break;
        }
        bf16* op = O + (rowbase + q0w + q32) * DM + h * HD + 4 * hi;
#pragma unroll
        for (int j = 0; j < 4; ++j) { u32x2 w0, w1; w0.x = pk2(o0[4 * j], o0[4 * j + 1]); w0.y = pk2(o0[4 * j + 2], o0[4 * j + 3]); w1.x = pk2(o1[4 * j], o1[4 * j + 1]); w1.y = pk2(o1[4 * j + 2], o1[4 * j + 3]);
            *(u32x2*)(op + 8 * j) = w0; *(u32x2*)(op + 32 + 8 * j) = w1; }
    }
    __syncthreads();
}

__device__ __forceinline__ void spatial_phase(LAS unsigned char* lds, const bf16* ZZ, bf16* GT, const bf16* Wc, const float* bs, const float* gam, const float* bet, int cu, int G) {
    const int tid = opaque_tid(), lane = tid & 63, wid = __builtin_amdgcn_readfirstlane(tid >> 6), fr = lane & 15, kg = lane >> 4;
    LAS float* st = (LAS float*)(lds + 69632);
    const int wr = wid >> 2, wc = wid & 3;
    for (int k = 0; k < 2; ++k) {
        const int chunk = 64 * (cu & 7) + 16 * (3 - (2 * k + (cu >> 7))) + ((cu >> 3) & 15);
        const size_t row0 = (size_t)chunk * GC;
        __syncthreads();
        for (int i0 = 0; i0 < 16; i0 += 4) {
            u32x4 w[4][4]; float s[4], mean[4], s2[4];
#pragma unroll
            for (int rr = 0; rr < 4; ++rr) { const bf16* vr = ZZ + (row0 + 16 * wid + i0 + rr) * 4096 + GW;
#pragma unroll
                for (int j = 0; j < 4; ++j) w[rr][j] = *(const u32x4*)(vr + (lane + 64 * j) * 8); }
#pragma unroll
            for (int rr = 0; rr < 4; ++rr) { float a = 0.f;
#pragma unroll
                for (int j = 0; j < 4; ++j)
#pragma unroll
                    for (int e = 0; e < 4; ++e) a += bflo(w[rr][j][e]) + bfhi(w[rr][j][e]);
                s[rr] = a; }
#pragma unroll
            for (int rr = 0; rr < 4; ++rr) mean[rr] = wave_sum(s[rr]) * (1.f / GW);
#pragma unroll
            for (int rr = 0; rr < 4; ++rr) { float a = 0.f;
#pragma unroll
                for (int j = 0; j < 4; ++j)
#pragma unroll
                    for (int e = 0; e < 4; ++e) { const float d0 = bflo(w[rr][j][e]) - mean[rr], d1 = bfhi(w[rr][j][e]) - mean[rr]; a += d0 * d0 + d1 * d1; }
                s2[rr] = a; }
#pragma unroll
            for (int rr = 0; rr < 4; ++rr) { const float rstd = 1.f / sqrtf(wave_sum(s2[rr]) * (1.f / GW) + LN_EPS); const int r = 16 * wid + i0 + rr;
                if (lane == 0) { st[2 * r] = mean[rr]; st[2 * r + 1] = rstd; } }
        }
        const int c8 = tid & 31, srow = tid >> 5;
        LAS unsigned char* const wl = lds + 72704;
        const int wt = tid >> 2, wq = tid & 3;
        u32x4 nv[8], nw[4];
#pragma unroll
        for (int it = 0; it < 8; ++it) nv[it] = *(const u32x4*)(ZZ + (row0 + it * 16 + srow) * 4096 + GW + c8 * 8);
#pragma unroll
        for (int q = 0; q < 4; ++q) nw[q] = *(const u32x4*)(Wc + (size_t)wt * GC + wq * 32 + q * 8);
        for (int g = 0; g < GG; ++g) {
            __syncthreads();
            { const float* gp = gam + g * 256 + c8 * 8; const float* bp = bet + g * 256 + c8 * 8;
              const f32x4 ga = *(const f32x4*)gp, gb = *(const f32x4*)(gp + 4), ba = *(const f32x4*)bp, bb = *(const f32x4*)(bp + 4);
#pragma unroll
              for (int q = 0; q < 4; ++q) *(LAS u32x4*)(wl + wt * 272 + wq * 64 + q * 16) = nw[q];
#pragma unroll
              for (int it = 0; it < 8; ++it) { const int s = it * 16 + srow;
                  const u32x4 w = nv[it];
                  const float mean = st[2 * s], rstd = st[2 * s + 1];
                  u32x4 o;
                  o.x = pk2((bflo(w.x) - mean) * rstd * ga.x + ba.x, (bfhi(w.x) - mean) * rstd * ga.y + ba.y);
                  o.y = pk2((bflo(w.y) - mean) * rstd * ga.z + ba.z, (bfhi(w.y) - mean) * rstd * ga.w + ba.w);
                  o.z = pk2((bflo(w.z) - mean) * rstd * gb.x + bb.x, (bfhi(w.z) - mean) * rstd * gb.y + bb.y);
                  o.w = pk2((bflo(w.w) - mean) * rstd * gb.z + bb.z, (bfhi(w.w) - mean) * rstd * gb.w + bb.w);
                  *(LAS u32x4*)(lds + s * 544 + c8 * 16) = o; } }
            __syncthreads();
            if (g + 1 < GG) {
#pragma unroll
                for (int it = 0; it < 8; ++it) nv[it] = *(const u32x4*)(ZZ + (row0 + it * 16 + srow) * 4096 + GW + (g + 1) * 256 + c8 * 8);
#pragma unroll
                for (int q = 0; q < 4; ++q) nw[q] = *(const u32x4*)(Wc + (size_t)(g + 1) * GC * GC + (size_t)wt * GC + wq * 32 + q * 8); }
            u32x2 uu[4][4];
#pragma unroll
            for (int tb = 0; tb < 4; ++tb)
#pragma unroll
                for (int cb = 0; cb < 4; ++cb) uu[tb][cb] = *(const u32x2*)(ZZ + (row0 + 64 * wr + 16 * tb + fr) * 4096 + g * 256 + 64 * wc + 16 * cb + 4 * kg);
            f32x4 acc[4][4];
#pragma unroll
            for (int a = 0; a < 4; ++a)
#pragma unroll
                for (int b2 = 0; b2 < 4; ++b2) acc[a][b2] = (f32x4){0.f, 0.f, 0.f, 0.f};
#pragma unroll
            for (int ks = 0; ks < 4; ++ks) {
                if (32 * ks <= 64 * wr + 63) {
                    bf16x8 X[4], Y[4];
#pragma unroll
                    for (int tb = 0; tb < 4; ++tb) { LAS const unsigned char* wp = wl + (64 * wr + 16 * tb + fr) * 272 + (32 * ks + 4 * kg) * 2;
                        const u32x2 a = *(LAS const u32x2*)wp, b2 = *(LAS const u32x2*)(wp + 32); const u32x4 w = (u32x4){a.x, a.y, b2.x, b2.y}; Y[tb] = __builtin_bit_cast(bf16x8, w); }
#pragma unroll
                    for (int cb = 0; cb < 4; ++cb) { LAS const unsigned char* xa = lds + (32 * ks + 4 * kg + (fr >> 2)) * 544 + (64 * wc + 16 * cb + 4 * (fr & 3)) * 2;
                        const s16x4 lo = vtr(xa), hi4 = vtr(xa + 16 * 544);
                        X[cb] = (bf16x8){lo[0], lo[1], lo[2], lo[3], hi4[0], hi4[1], hi4[2], hi4[3]}; }
#pragma unroll
                    for (int tb = 0; tb < 4; ++tb)
#pragma unroll
                        for (int cb = 0; cb < 4; ++cb) acc[tb][cb] = __builtin_amdgcn_mfma_f32_16x16x32_bf16(X[cb], Y[tb], acc[tb][cb], 0, 0, 0);
                }
            }
#pragma unroll
            for (int tb = 0; tb < 4; ++tb) { const int t = 64 * wr + 16 * tb + fr; const float bsv = bs[g * GC + t];
#pragma unroll
                for (int cb = 0; cb < 4; ++cb) { const int c = g * 256 + 64 * wc + 16 * cb + 4 * kg;
                    const u32x2 u = uu[tb][cb];
                    u32x2 o; o.x = pk2(bflo(u.x) * (acc[tb][cb][0] + bsv), bfhi(u.x) * (acc[tb][cb][1] + bsv)); o.y = pk2(bflo(u.y) * (acc[tb][cb][2] + bsv), bfhi(u.y) * (acc[tb][cb][3] + bsv));
                    *(u32x2*)(GT + (row0 + t) * GW + c) = o; } }
        }
    }
}

#ifndef PROBE
#define PROBE 0
#endif
#ifndef G2_REV
#define G2_REV 1
#endif
__device__ __forceinline__ void gbar(unsigned* ctr, unsigned target) {
    asm volatile("s_waitcnt vmcnt(0)" ::: "memory");
    __syncthreads();
    if (threadIdx.x == 0) {
        __builtin_amdgcn_fence(__ATOMIC_RELEASE, "agent");
        asm volatile("s_waitcnt vmcnt(0)" ::: "memory");
        __hip_atomic_fetch_add(ctr, 1u, __ATOMIC_RELAXED, __HIP_MEMORY_SCOPE_AGENT);
        while (__hip_atomic_load(ctr, __ATOMIC_RELAXED, __HIP_MEMORY_SCOPE_AGENT) < target) __builtin_amdgcn_s_sleep(1);
        __builtin_amdgcn_fence(__ATOMIC_ACQUIRE, "agent");
        asm volatile("s_waitcnt vmcnt(0)" ::: "memory");
    }
    __syncthreads();
}
#define GSYNC() do { bar_target += (unsigned)G; gbar(bar_ctr, bar_target); if (PROBE == 7) { bar_target += (unsigned)G; gbar(bar_ctr, bar_target); } } while (0)
__global__ void __launch_bounds__(512, 2) fwd_kernel(Args args) {
    extern __shared__ __attribute__((aligned(16))) unsigned char lds_raw[];
    cg::grid_group grid = cg::this_grid();
    LAS unsigned char* lds = (LAS unsigned char*)lds_raw;
    const int G = gridDim.x, cu = blockIdx.x, ngw = G * 8;
    unsigned char* ws = args.ws;
    const float* x = args.in[0];
    float* out = args.out;
    bf16* HB = (bf16*)(ws + WS_HB);
    unsigned* bar_ctr = (unsigned*)(ws + WS_CTL); unsigned bar_target = 0u;
    if (cu == 0 && threadIdx.x < 8) __hip_atomic_store((unsigned*)(ws + WS_CTL + 8192) + 64 * threadIdx.x, 0u, __ATOMIC_RELAXED, __HIP_MEMORY_SCOPE_AGENT);
    if (cu == 0 && threadIdx.x == 0) __hip_atomic_store(bar_ctr, 0u, __ATOMIC_RELAXED, __HIP_MEMORY_SCOPE_AGENT);

    for (int rep = 0; rep < (PROBE == 8 ? 2 : 1); ++rep) {
        const int tid = opaque_tid(), lane = tid & 63, wave = __builtin_amdgcn_readfirstlane(tid >> 6), gw = cu * 8 + wave;
        LAS float* scr = (LAS float*)(lds + wave * 16384);
        for (int mat = 0; mat < 16; ++mat) {
            const float* W; bf16* WT; int K, N, perm = 0;
            if (mat < 2)       { W = args.in[1] + (size_t)mat * DM * 3072;        WT = (bf16*)(ws + WS_ATTN_IN) + (size_t)mat * 3072 * DM;        K = DM; N = 3072; }
            else if (mat < 4)  { W = args.in[2] + (size_t)(mat - 2) * DM * DM;    WT = (bf16*)(ws + WS_ATTN_OUT) + (size_t)(mat - 2) * DM * DM;   K = DM; N = DM; }
            else if (mat < 6)  { W = args.in[3] + (size_t)(mat - 4) * DM * 4096;  WT = (bf16*)(ws + WS_GMLP_IN) + (size_t)(mat - 4) * 4096 * DM;  K = DM; N = 4096; }
            else if (mat < 8)  { W = args.in[8] + (size_t)(mat - 6) * GW * DM;    WT = (bf16*)(ws + WS_GMLP_OUT) + (size_t)(mat - 6) * DM * GW;   K = GW; N = DM; }
            else if (mat < 12) { W = args.in[9] + (size_t)(mat - 8) * DM * FF2;   WT = (bf16*)(ws + WS_FFN_UP) + (size_t)(mat - 8) * FF2 * DM;    K = DM; N = FF2; perm = 1; }
            else               { W = args.in[12] + (size_t)(mat - 12) * FF * DM;  WT = (bf16*)(ws + WS_FFN_DOWN) + (size_t)(mat - 12) * DM * FF;  K = FF; N = DM; }
            const int nitems = (K / 64) * (N / 32);
            for (int it = gw; it < nitems; it += ngw) transpose_item(W, K, N, WT, perm, scr, it, lane);
        }
        { const float* wsrc = args.in[6]; bf16* wd = (bf16*)(ws + WS_WS);
          for (int i = cu * 512 + tid; i < 2 * GG * GC * GC; i += G * 512) { const int s = i & 127, t = (i >> 7) & 127; const float v = (s <= t) ? wsrc[i] : 0.f; wd[i] = (bf16)(pk2(v, v) & 0xffffu); } }
        for (int m = gw; m < NTOK; m += ngw) {
            const f32x4* xr = (const f32x4*)(x + (size_t)m * DM) + lane; u32x2* o8 = (u32x2*)(HB + (size_t)m * DM) + lane;
#pragma unroll
            for (int j = 0; j < 4; ++j) { const f32x4 v = xr[64 * j]; u32x2 w; w.x = pk2(v.x, v.y); w.y = pk2(v.z, v.w); o8[64 * j] = w; }
        }
    }
    grid.sync();

    for (int layer = 0; layer < DEPTH; ++layer) {
        const int j = layer >> 1, mixer = layer & 1;
        for (int step = 0; step < 2; ++step) {
            if (step == 0) {
                pg8::Gemm g; pg8::EpiBf16 E;
                if (mixer == 0) { g = pg8::Gemm{HB, (const bf16*)(ws + WS_ATTN_IN) + (size_t)j * 3072 * DM, NTOK, 3072, DM};
                    E = pg8::EpiBf16{(bf16*)(ws + WS_Q), DM, 0, DM, (size_t)NTOK * DM, 0.125f}; }
                else { g = pg8::Gemm{HB, (const bf16*)(ws + WS_GMLP_IN) + (size_t)j * 4096 * DM, NTOK, 4096, DM};
                    E = pg8::EpiBf16{(bf16*)(ws + WS_ZZ), 4096, 1, 0, 0, 1.f}; }
                pg8::StaticOrder S; S.init(g.M, g.N, G, cu);
                for (int rep = 0; rep < (PROBE == 1 ? 2 : 1); ++rep)
                pg8::gemm_phase<pg8::EpiBf16, pg8::StaticOrder, true, true>(lds, g, S, E);
            } else {
                pg8::Gemm g{HB, (const bf16*)(ws + WS_FFN_UP) + (size_t)layer * FF2 * DM, NTOK, FF2, DM};
                pg8::EpiConv E{(bf16*)(ws + WS_G), args.in[10] + (size_t)layer * 3 * FF2, args.in[11] + (size_t)layer * FF2, lds + 131072, FF, FF2, FF, (float*)(ws + WS_HT)};
                pg8::StaticOrder S; S.init(g.M, g.N, G, cu);
                for (int rep = 0; rep < (PROBE == 4 ? 2 : 1); ++rep)
                pg8::gemm_phase<pg8::EpiConv, pg8::StaticOrder, true, true>(lds, g, S, E);
                GSYNC();
                ffn_fix_phase((const float*)(ws + WS_HT), (bf16*)(ws + WS_G), args.in[10] + (size_t)layer * 3 * FF2, args.in[11] + (size_t)layer * FF2, cu, G, opaque_tid());
            }
            GSYNC();
            if (step == 0) {
                for (int rep = 0; rep < (((PROBE == 2 && mixer == 0) || (PROBE == 3 && mixer == 1)) ? 2 : 1); ++rep)
                if (mixer == 0) attn_phase(lds, (const bf16*)(ws + WS_Q), (const bf16*)(ws + WS_K), (const bf16*)(ws + WS_V), (bf16*)(ws + WS_O), cu, G);
                else spatial_phase(lds, (const bf16*)(ws + WS_ZZ), (bf16*)(ws + WS_GT), (const bf16*)(ws + WS_WS) + (size_t)j * GG * GC * GC, args.in[7] + j * GG * GC, args.in[4] + j * GW, args.in[5] + j * GW, cu, G);
                GSYNC();
            }
            const int lnidx = 2 * layer + step;
            {
                pg8::Gemm g;
                if (step == 0 && mixer == 0) g = pg8::Gemm{(const bf16*)(ws + WS_O), (const bf16*)(ws + WS_ATTN_OUT) + (size_t)j * DM * DM, NTOK, DM, DM};
                else if (step == 0) g = pg8::Gemm{(const bf16*)(ws + WS_GT), (const bf16*)(ws + WS_GMLP_OUT) + (size_t)j * DM * GW, NTOK, DM, GW};
                else g = pg8::Gemm{(const bf16*)(ws + WS_G), (const bf16*)(ws + WS_FFN_DOWN) + (size_t)layer * DM * FF, NTOK, DM, FF};
                const int pl = (lnidx - 1) >> 1;
                const float* pgam = lnidx == 0 ? nullptr : (((lnidx - 1) & 1) ? args.in[15] : args.in[13]) + pl * DM;
                const float* pbet = lnidx == 0 ? nullptr : (((lnidx - 1) & 1) ? args.in[16] : args.in[14]) + pl * DM;
                const float* cgam = (step == 0 ? args.in[13] : args.in[15]) + layer * DM;
                const float* cbet = (step == 0 ? args.in[14] : args.in[16]) + layer * DM;
                pg8::EpiResLn E{lnidx == 0 ? x : out, out, lnidx == 0 ? nullptr : (const float*)(ws + WS_MS) + (size_t)((lnidx & 1) ^ 1) * NTOK * 2, pgam, pbet, (float*)(ws + WS_ST),
                                (float*)(ws + WS_MS) + (size_t)(lnidx & 1) * NTOK * 2, cgam, cbet, HB, (unsigned*)(ws + WS_CTL + 8192), 128u * (unsigned)lnidx, lnidx == 2 * DEPTH - 1 ? 1 : 0, lds + 131072, G2_REV};
                pg8::StaticOrder S; S.rev = G2_REV; S.init(g.M, g.N, G, cu);
                if (PROBE == 9) { pg8::EpiBf16 E0{(bf16*)(ws + WS_R + (step == 1 ? 512 * MiB : 0)), DM, 0, 0, 0, 1.f};
                    pg8::gemm_phase<pg8::EpiBf16, pg8::StaticOrder, true, true>(lds, g, S, E0); }
                pg8::gemm_phase<pg8::EpiResLn, pg8::StaticOrder, true, true>(lds, g, S, E);
            }
            if (lnidx != 2 * DEPTH - 1) GSYNC();
        }
    }
}

extern "C" void kernel_launch(void* const* d_in, const int* in_sizes, int n_in, void* d_out, int out_size, void* d_ws, size_t ws_size, hipStream_t stream) {
    static int grid = 0;
    if (grid == 0) {
        if (n_in != 17 || out_size != NTOK * DM || ws_size < WS_END) { fprintf(stderr, "kernel_launch: unexpected shapes (n_in %d, out %d, ws %zu)\n", n_in, out_size, ws_size); grid = -1; return; }
        int dev = 0, cus = 0, per_cu = 0;
        hipGetDevice(&dev);
        hipDeviceGetAttribute(&cus, hipDeviceAttributeMultiprocessorCount, dev);
        if (hipFuncSetAttribute((const void*)fwd_kernel, hipFuncAttributeMaxDynamicSharedMemorySize, LDS_BYTES) != hipSuccess) { fprintf(stderr, "kernel_launch: hipFuncSetAttribute failed\n"); grid = -1; return; }
        if (hipOccupancyMaxActiveBlocksPerMultiprocessor(&per_cu, (const void*)fwd_kernel, 512, LDS_BYTES) != hipSuccess || per_cu < 1) { fprintf(stderr, "kernel_launch: occupancy query says %d\n", per_cu); per_cu = 1; }
        (void)hipGetLastError();
        grid = cus * per_cu;
        fprintf(stderr, "kernel_launch: grid %d (cus %d x %d)\n", grid, cus, per_cu);
        if (grid != 256) { fprintf(stderr, "kernel_launch: the fused LayerNorm epilogue's group barrier is laid out for a 256-workgroup grid; nothing launched\n"); grid = -1; return; }
    }
    if (grid < 0) return;
    Args a{};
    for (int i = 0; i < 17; ++i) a.in[i] = (const float*)d_in[i];
    a.out = (float*)d_out; a.ws = (unsigned char*)d_ws;
    void* kargs[] = {&a};
    hipError_t e = hipLaunchCooperativeKernel((const void*)fwd_kernel, dim3(grid), dim3(512), kargs, LDS_BYTES, stream);
    if (e != hipSuccess) fprintf(stderr, "cooperative launch failed: %s (grid %d)\n", hipGetErrorString(e), grid);
}
```

```cpp
#include <hip/hip_runtime.h>
#include <hip/hip_cooperative_groups.h>
#include <cstdio>
#include <cstdint>
namespace cg = cooperative_groups;
__device__ __forceinline__ int opaque_tid() { int t = threadIdx.x; asm volatile("" : "+v"(t)); return t; }
namespace pg8 {
#define PG8_LAS __attribute__((address_space(3)))
typedef unsigned short bf16_t;
typedef short bf16x8 __attribute__((ext_vector_type(8)));
typedef float f32x4 __attribute__((ext_vector_type(4)));
typedef unsigned u32x4 __attribute__((ext_vector_type(4)));
constexpr int BM = 256, BK = 64, HALF = 128, HTB = HALF * BK * 2  , STAGE_BYTES = 8 * HTB, NXCD = 8, WGM = 8;

__host__ __device__ __forceinline__ int lds_byte(int r, int c) { const int st = (r >> 4) * 2 + (c >> 5), rr = r & 15, cc = c & 31, ob = rr * 64 + cc * 2; return st * 1024 + (ob ^ (((ob >> 9) & 1) << 5)); }
__host__ __device__ __forceinline__ void stage_rc(int b, int& R, int& C) { const int st = b / 1024, sb = b % 1024, swz = sb ^ (((sb >> 9) & 1) << 5); R = (st >> 1) * 16 + swz / 64; C = (st & 1) * 32 + (swz % 64) / 2; }
__host__ __device__ __forceinline__ int perm32(int rho) { const int n = rho >> 4, i = rho & 15; return 8 * (i >> 2) + 4 * n + (i & 3); }

struct Unit { int pm, pn; };
struct Gemm { const bf16_t* A; const bf16_t* Bt; int M, N, K; };

struct StaticOrder {
    int nM, nN, nwg, G, c, rev = 0;
    __host__ __device__ void init(int M, int N, int G_, int c_) { nM = M / BM; nN = N / BM; nwg = nM * nN; G = G_; c = c_; }
    __host__ __device__ bool next(int i, Unit& u) const {
        if ((long)i * G + c >= nwg) return false;
        const long L = (long)(rev ? (nwg / G - 1 - i) : i) * G + c;
        int wgid = (int)L; { const int q = nwg / NXCD, r = nwg % NXCD, xcd = wgid % NXCD, off = wgid / NXCD; wgid = (xcd < r ? xcd * (q + 1) : r * (q + 1) + (xcd - r) * q) + off; }
        const int nig = WGM * nN, gid = wgid / nig, fm = gid * WGM, gsz = (nM - fm) < WGM ? (nM - fm) : WGM;
        u.pm = fm + ((wgid % nig) % gsz); u.pn = (wgid % nig) / gsz; return true;
    }
    __device__ __forceinline__ void a_ready(const Unit&) const {}
    __device__ __forceinline__ void done(const Unit&) const {}
};
__device__ __forceinline__ unsigned cvt_pk_bf16(float lo, float hi) { unsigned r; asm volatile("v_cvt_pk_bf16_f32 %0, %1, %2" : "=v"(r) : "v"(lo), "v"(hi)); return r; }
typedef float f32x2 __attribute__((ext_vector_type(2)));
typedef unsigned u32x2e __attribute__((ext_vector_type(2)));
__device__ __forceinline__ float gelu_tanh(float x) {
    const float t = x * (-2.302208198f + (-0.1029432397f) * x * x);
    return x * __builtin_amdgcn_rcpf(1.0f + __builtin_amdgcn_exp2f(t));
}
struct EpiBf16 {
    static constexpr bool PERM = true, AFTER_DRAIN = false;
    bf16_t* O; int ldc; int act; int split_cols; size_t split_stride; float scale0;
    __device__ __forceinline__ void operator()(const f32x4 (&acc)[2][2][4][2], const Unit& u, int wr, int wc, int fr, int fq) const {
        const int row0 = u.pm * BM + wr * 64 + fr; int colt = u.pn * BM; bf16_t* base = O;
        float sc = 1.f; if (split_cols) { const int t = colt / split_cols; base += (size_t)t * split_stride; colt -= t * split_cols; if (t == 0) sc = scale0; }
        const int col0 = colt + wc * 32 + 8 * fq;
#pragma unroll
        for (int ai = 0; ai < 2; ++ai)
#pragma unroll
            for (int m = 0; m < 4; ++m) { bf16_t* rowp = base + (size_t)(row0 + ai * HALF + m * 16) * ldc + col0;
#pragma unroll
                for (int bj = 0; bj < 2; ++bj) { f32x4 v0 = acc[ai][bj][m][0], v1 = acc[ai][bj][m][1];
                    if (act) { v0 = (f32x4){gelu_tanh(v0[0]), gelu_tanh(v0[1]), gelu_tanh(v0[2]), gelu_tanh(v0[3])};
                               v1 = (f32x4){gelu_tanh(v1[0]), gelu_tanh(v1[1]), gelu_tanh(v1[2]), gelu_tanh(v1[3])}; }
                    v0 = v0 * sc; v1 = v1 * sc; u32x4 w; w.x = cvt_pk_bf16(v0[0], v0[1]); w.y = cvt_pk_bf16(v0[2], v0[3]); w.z = cvt_pk_bf16(v1[0], v1[1]); w.w = cvt_pk_bf16(v1[2], v1[3]);
                    *(u32x4*)(rowp + bj * HALF) = w; } }
    }
};
struct EpiRes {
    static constexpr bool PERM = false, AFTER_DRAIN = false;
    const float* base; float* out; int ldc; float alpha;
    __device__ __forceinline__ void operator()(const f32x4 (&acc)[2][2][4][2], const Unit& u, int wr, int wc, int fr, int fq) const {
        const int col0 = u.pn * BM + wc * 32 + 4 * fq;
#pragma unroll
        for (int ai = 0; ai < 2; ++ai)
#pragma unroll
            for (int m = 0; m < 4; ++m) { const size_t off = (size_t)(u.pm * BM + ai * HALF + wr * 64 + m * 16 + fr) * ldc + col0;
#pragma unroll
                for (int bj = 0; bj < 2; ++bj)
#pragma unroll
                    for (int n = 0; n < 2; ++n) { const f32x4 bs = *(const f32x4*)(base + off + bj * HALF + n * 16);
                        *(f32x4*)(out + off + bj * HALF + n * 16) = bs * alpha + acc[ai][bj][m][n]; }
                asm volatile("" ::: "memory"); }
    }
};

template <int CTRL> __device__ __forceinline__ float dpp_mov(float old, float src) {
    return __builtin_bit_cast(float, __builtin_amdgcn_update_dpp(__builtin_bit_cast(int, old), __builtin_bit_cast(int, src), CTRL, 0xf, 0xf, false));
}
struct SeqOrder {
    int G, c;
    __device__ bool next(int i, Unit& u) const { if (i >= 22) return false; int it, step;
        if (i < 16) { it = c + G * (i >> 3); step = i & 7; } else { const int v = 6 * c + (i - 16); it = 512 + (v >> 3); step = v & 7; }
        u.pn = it >> 5; u.pm = 8 * (it & 31) + step; return true; }
    __device__ __forceinline__ void a_ready(const Unit&) const {}
    __device__ __forceinline__ void done(const Unit&) const {}
};
struct EpiConv {
    static constexpr bool PERM = true, AFTER_DRAIN = false;
    bf16_t* O; const float* cw; const float* cb; PG8_LAS unsigned char* hl; int ldo, ncol2, nfeat; float* ht;
    __device__ __forceinline__ void operator()(const f32x4 (&acc)[2][2][4][2], const Unit& u, int wr, int wc, int fr, int fq) const {
        const int lcol = wc * 32 + 8 * fq;
        { const int t = opaque_tid();
          if (t < 256) { const int p = t >> 5, ch = t & 31, pp = p & 3; const float* src = (pp < 3 ? cw + pp * ncol2 : cb) + (p >> 2) * nfeat + 128 * u.pn + 4 * ch;
              *(PG8_LAS f32x4*)(hl + 10240 + (p * 128 + 4 * ch) * 4) = *(const f32x4*)src; } }
        float* const htu = ht + (size_t)(u.pm * 22 + u.pn) * 1024;
        if (fr >= 14) {
#pragma unroll
            for (int ai = 0; ai < 2; ++ai) { const int k = 2 * ai + wr;
                if (k < 3) { PG8_LAS unsigned char* hp = hl + k * 2048 + (fr - 14) * 1024 + lcol * 4;
#pragma unroll
                    for (int bj = 0; bj < 2; ++bj)
#pragma unroll
                        for (int n = 0; n < 2; ++n) *(PG8_LAS f32x4*)(hp + bj * 512 + n * 16) = acc[ai][bj][3][n]; }
                else {
#pragma unroll
                    for (int bj = 0; bj < 2; ++bj)
#pragma unroll
                        for (int n = 0; n < 2; ++n) *(f32x4*)(htu + (2 + fr - 14) * 256 + bj * 128 + lcol + 4 * n) = acc[ai][bj][3][n]; } }
        }
        if (wr == 0 && fr < 2) {
#pragma unroll
            for (int bj = 0; bj < 2; ++bj)
#pragma unroll
                for (int n = 0; n < 2; ++n) *(f32x4*)(htu + fr * 256 + bj * 128 + lcol + 4 * n) = acc[0][bj][0][n];
        }
        asm volatile("s_waitcnt lgkmcnt(0)" ::: "memory"); __builtin_amdgcn_s_barrier(); asm volatile("" ::: "memory");
#pragma unroll
        for (int n = 0; n < 2; ++n) {
            const int f = 128 * u.pn + lcol + 4 * n;
            PG8_LAS const float* const wl = (PG8_LAS const float*)(hl + 10240) + lcol + 4 * n;
            const f32x4 wg0 = *(PG8_LAS const f32x4*)(wl), wg1 = *(PG8_LAS const f32x4*)(wl + 128), wg2 = *(PG8_LAS const f32x4*)(wl + 256), bg = *(PG8_LAS const f32x4*)(wl + 384);
            const f32x4 wv0 = *(PG8_LAS const f32x4*)(wl + 512), wv1 = *(PG8_LAS const f32x4*)(wl + 640), wv2 = *(PG8_LAS const f32x4*)(wl + 768), bv = *(PG8_LAS const f32x4*)(wl + 896);
#pragma unroll
            for (int ai = 0; ai < 2; ++ai) {
                const int k = 2 * ai + wr;
                const int rslot = k > 0 ? k - 1 : 0;
                PG8_LAS const unsigned char* hp = hl + rslot * 2048 + (lcol + 4 * n) * 4;
                f32x4 hg2 = *(PG8_LAS const f32x4*)hp, hv2 = *(PG8_LAS const f32x4*)(hp + 512), hg1 = *(PG8_LAS const f32x4*)(hp + 1024), hv1 = *(PG8_LAS const f32x4*)(hp + 1536);
                if (k == 0) { hg2 = (f32x4){0.f, 0.f, 0.f, 0.f}; hv2 = hg2; hg1 = hg2; hv1 = hg2; }
#pragma unroll
                for (int m = 0; m < 4; ++m) {
                    float r[4];
#pragma unroll
                    for (int e = 0; e < 4; ++e) {
                        const float xg = acc[ai][0][m][n][e], xv = acc[ai][1][m][n][e];
                        float o1g, o2g, o1v, o2v;
                        if (m == 0) { o1g = hg1[e]; o2g = fr == 0 ? hg2[e] : hg1[e]; o1v = hv1[e]; o2v = fr == 0 ? hv2[e] : hv1[e]; }
                        else { const float pgv = acc[ai][0][m > 0 ? m - 1 : 0][n][e], pvv = acc[ai][1][m > 0 ? m - 1 : 0][n][e];
                            o1g = dpp_mov<0x121>(pgv, pgv); o2g = dpp_mov<0x122>(pgv, pgv); o1v = dpp_mov<0x121>(pvv, pvv); o2v = dpp_mov<0x122>(pvv, pvv); }
                        const float p1g = dpp_mov<0x111>(o1g, xg), p2g = dpp_mov<0x112>(o2g, xg), p1v = dpp_mov<0x111>(o1v, xv), p2v = dpp_mov<0x112>(o2v, xv);
                        const float yg = bg[e] + wg2[e] * xg + wg1[e] * p1g + wg0[e] * p2g;
                        const float yv = bv[e] + wv2[e] * xv + wv1[e] * p1v + wv0[e] * p2v;
                        r[e] = yg * __builtin_amdgcn_rcpf(1.0f + __builtin_amdgcn_exp2f(-1.4426950408889634f * yg)) * yv;
                    }
                    u32x2e w; w.x = cvt_pk_bf16(r[0], r[1]); w.y = cvt_pk_bf16(r[2], r[3]);
                    *(u32x2e*)(O + (size_t)(u.pm * BM + ai * HALF + wr * 64 + m * 16 + fr) * ldo + f) = w;
                }
            }
        }
    }
};

struct EpiResLn {
    static constexpr bool PERM = false, AFTER_DRAIN = false;
    const float* base; float* out; const float* pms; const float* pg; const float* pb; float* st; float* ms; const float* cg; const float* cbeta; bf16_t* hb; unsigned* gcnt; unsigned tgt0; int last; PG8_LAS unsigned char* xl; int rev;
    static constexpr int ldc = 1024; static constexpr float alpha = 1.681792830507429f, eps = 1e-5f;
    __device__ __forceinline__ void operator()(f32x4 (&acc)[2][2][4][2], const Unit& u, int wr, int wc, int fr, int fq) const {
        asm volatile("" : "+v"(fr), "+v"(fq));
        typedef float f32x2s __attribute__((ext_vector_type(2)));
        PG8_LAS float* const sl = (PG8_LAS float*)xl; PG8_LAS float* const gl = (PG8_LAS float*)(xl + 8192);
        const int col0 = u.pn * BM + wc * 32 + 4 * fq, lc0 = wc * 32 + 4 * fq;
        { const int t = opaque_tid();
          if (t < 256) { const int which = t >> 6, c4 = 4 * (t & 63); f32x4 v = (which & 1) ? (f32x4){0.f, 0.f, 0.f, 0.f} : (f32x4){1.f, 1.f, 1.f, 1.f};
              if (which >= 2) v = *(const f32x4*)((which == 2 ? cg : cbeta) + u.pn * BM + c4);
              else if (pms) v = *(const f32x4*)((which ? pb : pg) + u.pn * BM + c4);
              *(PG8_LAS f32x4*)(gl + which * 256 + c4) = v; } }
        float mu[8], rs[8];
#pragma unroll
        for (int i = 0; i < 8; ++i) { mu[i] = 0.f; rs[i] = 1.f;
            if (pms) { const f32x2s v = *(const f32x2s*)(pms + ((size_t)u.pm * BM + (i >> 2) * HALF + wr * 64 + (i & 3) * 16 + fr) * 2); mu[i] = v.x; rs[i] = v.y; } }
        f32x4 nb[4];
        { const size_t off = ((size_t)u.pm * BM + wr * 64 + fr) * ldc + col0;
#pragma unroll
          for (int q = 0; q < 4; ++q) nb[q] = *(const f32x4*)(base + off + (q >> 1) * HALF + (q & 1) * 16); }
        asm volatile("s_waitcnt lgkmcnt(0)" ::: "memory"); __builtin_amdgcn_s_barrier(); asm volatile("" ::: "memory");
#pragma unroll
        for (int i = 0; i < 8; ++i) { const int ai = i >> 2, m = i & 3; const int lrow = ai * HALF + wr * 64 + m * 16 + fr; const size_t off = ((size_t)u.pm * BM + lrow) * ldc + col0;
            f32x4 cur[4];
#pragma unroll
            for (int q = 0; q < 4; ++q) cur[q] = nb[q];
            if (i < 7) { const int lr2 = ((i + 1) >> 2) * HALF + wr * 64 + ((i + 1) & 3) * 16 + fr; const size_t off2 = ((size_t)u.pm * BM + lr2) * ldc + col0;
#pragma unroll
                for (int q = 0; q < 4; ++q) nb[q] = *(const f32x4*)(base + off2 + (q >> 1) * HALF + (q & 1) * 16); }
            asm volatile("" ::: "memory");
            float rsum = 0.f, rq = 0.f;
#pragma unroll
            for (int q = 0; q < 4; ++q) { const int bj = q >> 1, n = q & 1;
                const f32x4 g4 = *(PG8_LAS const f32x4*)(gl + lc0 + bj * HALF + n * 16), b4 = *(PG8_LAS const f32x4*)(gl + 256 + lc0 + bj * HALF + n * 16);
                const f32x4 h = (cur[q] - mu[i]) * rs[i] * g4 + b4;
                const f32x4 y = h * alpha + acc[ai][bj][m][n];
                acc[ai][bj][m][n] = y;
                if (!last) *(f32x4*)(out + off + bj * HALF + n * 16) = y;
                rsum += (y[0] + y[1]) + (y[2] + y[3]); rq += (y[0] * y[0] + y[1] * y[1]) + (y[2] * y[2] + y[3] * y[3]); }
            rsum += __shfl_xor(rsum, 16); rsum += __shfl_xor(rsum, 32); rq += __shfl_xor(rq, 16); rq += __shfl_xor(rq, 32);
            if (fq == 0) { sl[(lrow * 4 + wc) * 2] = rsum; sl[(lrow * 4 + wc) * 2 + 1] = rq; }
            asm volatile("" ::: "memory"); }
        asm volatile("s_waitcnt lgkmcnt(0)" ::: "memory"); __builtin_amdgcn_s_barrier(); asm volatile("" ::: "memory");
        const int t = opaque_tid();
        if (t < 256) { const f32x4 a = *(PG8_LAS const f32x4*)(sl + t * 8), b = *(PG8_LAS const f32x4*)(sl + t * 8 + 4);
            const float ssum = (a[0] + a[2]) + (b[0] + b[2]), ssq = (a[1] + a[3]) + (b[1] + b[3]);
            __hip_atomic_store((unsigned long long*)(st + ((size_t)u.pm * BM + t) * 8 + u.pn * 2), ((unsigned long long)__float_as_uint(ssq) << 32) | __float_as_uint(ssum), __ATOMIC_RELAXED, __HIP_MEMORY_SCOPE_AGENT); }
        asm volatile("s_waitcnt vmcnt(0) lgkmcnt(0)" ::: "memory"); __builtin_amdgcn_s_barrier(); asm volatile("" ::: "memory");
        if (t == 0) {
            unsigned* const ctr = gcnt + 64 * (blockIdx.x & 7); const unsigned target = tgt0 + 32u * (unsigned)((rev ? 3 - ((u.pm >> 3) & 3) : ((u.pm >> 3) & 3)) + 1);
            __hip_atomic_fetch_add(ctr, 1u, __ATOMIC_RELAXED, __HIP_MEMORY_SCOPE_AGENT);
            while (__hip_atomic_load(ctr, __ATOMIC_RELAXED, __HIP_MEMORY_SCOPE_AGENT) < target) __builtin_amdgcn_s_sleep(1);
        }
        __builtin_amdgcn_s_barrier(); asm volatile("" ::: "memory");
        if (t < 256) { const size_t row = (size_t)u.pm * BM + t;
            float s = 0.f, q = 0.f;
#pragma unroll
            for (int k4 = 0; k4 < 4; ++k4) { const unsigned long long w = __hip_atomic_load((const unsigned long long*)(st + row * 8 + 2 * k4), __ATOMIC_RELAXED, __HIP_MEMORY_SCOPE_AGENT);
                s += __uint_as_float((unsigned)w); q += __uint_as_float((unsigned)(w >> 32)); }
            const float mean = s * (1.f / 1024.f), rstd = 1.f / sqrtf(q * (1.f / 1024.f) - mean * mean + eps);
            *(PG8_LAS f32x2s*)(sl + 2 * t) = (f32x2s){mean, rstd};
            if (u.pn == 0) *(f32x2s*)(ms + row * 2) = (f32x2s){mean, rstd}; }
        asm volatile("s_waitcnt lgkmcnt(0)" ::: "memory"); __builtin_amdgcn_s_barrier(); asm volatile("" ::: "memory");
#pragma unroll
        for (int i = 0; i < 8; ++i) { const int ai = i >> 2, m = i & 3; const int lrow = ai * HALF + wr * 64 + m * 16 + fr; const size_t off = ((size_t)u.pm * BM + lrow) * ldc + col0;
            const f32x2s mr = *(PG8_LAS const f32x2s*)(sl + 2 * lrow);
#pragma unroll
            for (int q = 0; q < 4; ++q) { const int bj = q >> 1, n = q & 1;
                const f32x4 g4 = *(PG8_LAS const f32x4*)(gl + 512 + lc0 + bj * HALF + n * 16), b4 = *(PG8_LAS const f32x4*)(gl + 768 + lc0 + bj * HALF + n * 16);
                const f32x4 o = (acc[ai][bj][m][n] - mr.x) * mr.y * g4 + b4;
                if (last) *(f32x4*)(out + off + bj * HALF + n * 16) = o;
                else { u32x2e w; w.x = cvt_pk_bf16(o[0], o[1]); w.y = cvt_pk_bf16(o[2], o[3]); *(u32x2e*)(hb + off + bj * HALF + n * 16) = w; } }
            asm volatile("" ::: "memory"); }
    }
};

template <class Epi, class Sched, bool ALIGN_EPI = false, bool SP2 = false>
__device__ __forceinline__ void gemm_phase(PG8_LAS unsigned char* lds, const Gemm g, const Sched& S, const Epi& E) {
    const int tid = opaque_tid(), wid = __builtin_amdgcn_readfirstlane(tid >> 6), lane = tid & 63, wr = wid >> 2, wc = wid & 3, fr = lane & 15, fq = lane >> 4;
    const int K = g.K, nt = K / BK;
    unsigned voffA[2], voffB[2];
#pragma unroll
    for (int i = 0; i < 2; ++i) { int R, C; stage_rc(tid * 16 + i * 8192, R, C); const int Rb = Epi::PERM ? ((R & ~31) + perm32(R & 31)) : R;
        voffA[i] = (unsigned)(R * K + C) * 2u; voffB[i] = (unsigned)(Rb * K + C) * 2u; }
    const size_t kstep = (size_t)(BK * 2);
    const size_t hstep = (size_t)HALF * K * 2;
    const size_t tstep = 2 * hstep;
    const unsigned ldsw = (unsigned)wid * 1024u;
    const int aoff = lds_byte(wr * 64 + fr, fq * 8), boff = lds_byte(wc * 32 + fr, fq * 8);
#define PG8_SA(b, h) (((b) * 2 + (h)) * HTB)
#define PG8_SB(b, h) ((4 + (b) * 2 + (h)) * HTB)
#define PG8_STAGE(bufoff, gbase, voff) do { _Pragma("unroll") for (int _i = 0; _i < 2; ++_i) \
        __builtin_amdgcn_global_load_lds((const unsigned*)((const char*)(gbase) + (voff)[_i]), (PG8_LAS unsigned*)(lds + (bufoff) + ldsw + _i * 8192), 16, 0, 0); } while (0)
#define PG8_LDA(dst, b, h) do { _Pragma("unroll") for (int m = 0; m < 4; ++m) _Pragma("unroll") for (int k = 0; k < 2; ++k) dst[m][k] = *(const PG8_LAS bf16x8*)(lds + PG8_SA(b, h) + aoff + m * 2048 + k * 1024); } while (0)
#define PG8_LDB(dst, b, h) do { _Pragma("unroll") for (int n = 0; n < 2; ++n) _Pragma("unroll") for (int k = 0; k < 2; ++k) dst[n][k] = *(const PG8_LAS bf16x8*)(lds + PG8_SB(b, h) + boff + n * 2048 + k * 1024); } while (0)
#define PG8_MMA(ai, bj, At, Bt) do { __builtin_amdgcn_s_setprio(1); _Pragma("unroll") for (int m = 0; m < 4; ++m) _Pragma("unroll") for (int n = 0; n < 2; ++n) _Pragma("unroll") for (int k = 0; k < 2; ++k) \
        acc[ai][bj][m][n] = __builtin_amdgcn_mfma_f32_16x16x32_bf16(Bt[n][k], At[m][k], acc[ai][bj][m][n], 0, 0, 0); __builtin_amdgcn_s_setprio(0); } while (0)
#define PG8_WAIT_V(n) asm volatile("s_waitcnt vmcnt(" #n ")" ::: "memory")
#define PG8_WAIT_L(n) asm volatile("s_waitcnt lgkmcnt(" #n ")" ::: "memory")
#define PG8_BAR __builtin_amdgcn_s_barrier()
#define PG8_SCHED __builtin_amdgcn_sched_barrier(0)
    Unit cur, nxt; int ui = 0;
    if (!S.next(0, cur)) return;
    f32x4 acc[2][2][4][2];
#pragma unroll
    for (int a = 0; a < 2; ++a)
#pragma unroll
        for (int b = 0; b < 2; ++b)
#pragma unroll
            for (int m = 0; m < 4; ++m)
#pragma unroll
                for (int n = 0; n < 2; ++n) acc[a][b][m][n] = (f32x4){0.f, 0.f, 0.f, 0.f};
    bf16x8 At[4][2], B0[2][2], B1[2][2];
    const char* cA = (const char*)g.A + (size_t)cur.pm * tstep; const char* cB = (const char*)g.Bt + (size_t)cur.pn * tstep;
    S.a_ready(cur);
    if constexpr (SP2) {
        PG8_STAGE(PG8_SB(0, 0), cB, voffB); PG8_STAGE(PG8_SB(0, 1), cB + hstep, voffB); PG8_STAGE(PG8_SA(0, 0), cA, voffA); PG8_STAGE(PG8_SA(0, 1), cA + hstep, voffA);
        if (wr == 1) PG8_BAR;
        PG8_WAIT_V(2); PG8_BAR;
        PG8_STAGE(PG8_SB(1, 0), cB + kstep, voffB); PG8_STAGE(PG8_SA(1, 0), cA + kstep, voffA); PG8_STAGE(PG8_SB(1, 1), cB + hstep + kstep, voffB);
        PG8_WAIT_V(6); PG8_BAR;
    } else {
        PG8_STAGE(PG8_SB(0, 0), cB, voffB); PG8_STAGE(PG8_SA(0, 0), cA, voffA); PG8_STAGE(PG8_SB(0, 1), cB + hstep, voffB); PG8_STAGE(PG8_SA(0, 1), cA + hstep, voffA);
        if (wr == 1) PG8_BAR;
        PG8_WAIT_V(4); PG8_BAR;
        PG8_STAGE(PG8_SB(1, 0), cB + kstep, voffB); PG8_STAGE(PG8_SA(1, 0), cA + kstep, voffA); PG8_STAGE(PG8_SB(1, 1), cB + hstep + kstep, voffB);
        PG8_WAIT_V(6); PG8_BAR;
    }
    for (;;) {
        const bool has_next = S.next(ui + 1, nxt);
        const char* nA = has_next ? (const char*)g.A + (size_t)nxt.pm * tstep : cA; const char* nB = has_next ? (const char*)g.Bt + (size_t)nxt.pn * tstep : cB;
        for (int t = 0; t < nt; t += 2) {
            const bool last = (t == nt - 2);
            const char* a1 = cA + (size_t)(t + 1) * kstep;
            const char* a2 = last ? nA : cA + (size_t)(t + 2) * kstep; const char* b2 = last ? nB : cB + (size_t)(t + 2) * kstep;
            const char* a3 = a2 + kstep; const char* b3 = b2 + kstep;
            if (last && has_next) S.a_ready(nxt);
            if constexpr (SP2) {
            PG8_LDB(B0, 0, 0); PG8_LDB(B1, 0, 1); PG8_SCHED; PG8_LDA(At, 0, 0); PG8_STAGE(PG8_SA(1, 1), a1 + hstep, voffA);
            PG8_WAIT_V(8); PG8_WAIT_L(0); PG8_BAR; PG8_MMA(0, 0, At, B0); PG8_MMA(0, 1, At, B1); PG8_BAR; PG8_SCHED;
            PG8_LDA(At, 0, 1); PG8_STAGE(PG8_SB(0, 0), b2, voffB); PG8_STAGE(PG8_SB(0, 1), b2 + hstep, voffB); PG8_STAGE(PG8_SA(0, 0), a2, voffA);
            PG8_WAIT_V(8); PG8_WAIT_L(0); PG8_BAR; PG8_MMA(1, 0, At, B0); PG8_MMA(1, 1, At, B1); PG8_BAR; PG8_SCHED;
            PG8_LDB(B0, 1, 0); PG8_LDB(B1, 1, 1); PG8_SCHED; PG8_LDA(At, 1, 0); PG8_STAGE(PG8_SA(0, 1), a2 + hstep, voffA);
            PG8_WAIT_V(8); PG8_WAIT_L(0); PG8_BAR; PG8_MMA(0, 0, At, B0); PG8_MMA(0, 1, At, B1); PG8_BAR; PG8_SCHED;
            PG8_LDA(At, 1, 1); PG8_STAGE(PG8_SB(1, 0), b3, voffB); PG8_STAGE(PG8_SB(1, 1), b3 + hstep, voffB); PG8_STAGE(PG8_SA(1, 0), a3, voffA);
            PG8_WAIT_V(8); PG8_WAIT_L(0); PG8_BAR; PG8_MMA(1, 0, At, B0); PG8_MMA(1, 1, At, B1); PG8_BAR; PG8_SCHED;
            } else {
            PG8_LDB(B0, 0, 0); PG8_SCHED; PG8_LDA(At, 0, 0); PG8_STAGE(PG8_SA(1, 1), a1 + hstep, voffA);
            PG8_WAIT_L(8); PG8_BAR; PG8_WAIT_L(0); PG8_MMA(0, 0, At, B0); PG8_BAR; PG8_SCHED;
            PG8_LDB(B1, 0, 1); PG8_STAGE(PG8_SB(0, 0), b2, voffB);
            PG8_BAR; PG8_WAIT_L(0); PG8_MMA(0, 1, At, B1); PG8_BAR;
            PG8_LDA(At, 0, 1); PG8_STAGE(PG8_SA(0, 0), a2, voffA);
            PG8_BAR; PG8_WAIT_L(0); PG8_MMA(1, 0, At, B0); PG8_BAR; PG8_SCHED;
            PG8_STAGE(PG8_SB(0, 1), b2 + hstep, voffB);
            PG8_WAIT_V(6); PG8_BAR; PG8_MMA(1, 1, At, B1); PG8_BAR;
            PG8_LDB(B0, 1, 0); PG8_SCHED; PG8_LDA(At, 1, 0); PG8_STAGE(PG8_SA(0, 1), a2 + hstep, voffA);
            PG8_WAIT_L(8); PG8_BAR; PG8_WAIT_L(0); PG8_MMA(0, 0, At, B0); PG8_BAR; PG8_SCHED;
            PG8_LDB(B1, 1, 1); PG8_STAGE(PG8_SB(1, 0), b3, voffB);
            PG8_BAR; PG8_WAIT_L(0); PG8_MMA(0, 1, At, B1); PG8_BAR;
            PG8_LDA(At, 1, 1); PG8_STAGE(PG8_SA(1, 0), a3, voffA);
            PG8_BAR; PG8_WAIT_L(0); PG8_MMA(1, 0, At, B0); PG8_BAR; PG8_SCHED;
            PG8_STAGE(PG8_SB(1, 1), b3 + hstep, voffB);
            PG8_WAIT_V(6); PG8_BAR; PG8_MMA(1, 1, At, B1); PG8_BAR;
            }
        }
        if constexpr (ALIGN_EPI) { if (wr == 0) PG8_BAR; }
        if constexpr (!Epi::AFTER_DRAIN) { E(acc, cur, wr, wc, fr, fq); S.done(cur); }
        if (!has_next) break;
#pragma unroll
        for (int a = 0; a < 2; ++a)
#pragma unroll
            for (int b = 0; b < 2; ++b)
#pragma unroll
                for (int m = 0; m < 4; ++m)
#pragma unroll
                    for (int n = 0; n < 2; ++n) acc[a][b][m][n] = (f32x4){0.f, 0.f, 0.f, 0.f};
        cur = nxt; cA = nA; cB = nB; ++ui;
        if constexpr (ALIGN_EPI) { if (wr == 1) PG8_BAR; }
    }
    PG8_WAIT_V(0);
    if constexpr (!ALIGN_EPI) { if (wr == 0) PG8_BAR; }
    PG8_BAR;
    if constexpr (Epi::AFTER_DRAIN) { E.fused(acc, cur, wr, wc, fr, fq, lds, wid, lane); S.done(cur); }
#undef PG8_SA
#undef PG8_SB
#undef PG8_STAGE
#undef PG8_LDA
#undef PG8_LDB
#undef PG8_MMA
#undef PG8_WAIT_V
#undef PG8_WAIT_L
#undef PG8_BAR
#undef PG8_SCHED
}
}

constexpr int NB = 32, SEQ = 2048, DM = 1024, NTOK = NB * SEQ;
constexpr int NH = 16, HD = 64, GW = 2048, GG = 8, GC = 128, FF = 2816, FF2 = 5632, DEPTH = 4;
constexpr float LN_EPS = 1e-5f;
constexpr float DN_ALPHA = 1.681792830507429f;
constexpr int HALF_TOK = NTOK / 2;

constexpr size_t MiB = 1u << 20;
constexpr size_t WS_ATTN_IN = 0, WS_ATTN_OUT = 12 * MiB, WS_GMLP_IN = 16 * MiB, WS_GMLP_OUT = 32 * MiB, WS_FFN_UP = 40 * MiB, WS_FFN_DOWN = 84 * MiB, WS_WS = 106 * MiB;
constexpr size_t WS_MS = 110 * MiB;
constexpr size_t WS_CTL = 107 * MiB;
constexpr size_t WS_ST = 108 * MiB;
constexpr size_t WS_HB = 112 * MiB;
constexpr size_t WS_R = 240 * MiB;
constexpr size_t WS_Q = WS_R, WS_K = WS_R + 128 * MiB, WS_V = WS_R + 256 * MiB, WS_O = WS_R + 384 * MiB;
constexpr size_t WS_ZZ = WS_R, WS_GT = WS_R + 512 * MiB;
constexpr size_t WS_HT = WS_R + 400 * MiB;
constexpr size_t WS_G = WS_R;
constexpr size_t WS_END = 1008 * MiB;

constexpr int LDS_BYTES = 147456;

#define LAS __attribute__((address_space(3)))
typedef unsigned short bf16;
typedef unsigned u32x4 __attribute__((ext_vector_type(4)));
typedef unsigned u32x2 __attribute__((ext_vector_type(2)));
typedef float f32x4 __attribute__((ext_vector_type(4)));
typedef float f32x16 __attribute__((ext_vector_type(16)));
typedef short bf16x8 __attribute__((ext_vector_type(8)));
typedef short s16x4 __attribute__((ext_vector_type(4)));

__device__ __forceinline__ unsigned pk2(float lo, float hi) { return pg8::cvt_pk_bf16(lo, hi); }
__device__ __forceinline__ float bflo(unsigned w) { return __uint_as_float(w << 16); }
__device__ __forceinline__ float bfhi(unsigned w) { return __uint_as_float(w & 0xffff0000u); }
__device__ __forceinline__ float wave_sum(float v) {
#pragma unroll
    for (int o = 1; o < 64; o <<= 1) v += __shfl_xor(v, o);
    return v;
}
__device__ __forceinline__ s16x4 vtr(LAS const unsigned char* p) { return __builtin_bit_cast(s16x4, __builtin_amdgcn_ds_read_tr16_b64_v4i16((LAS s16x4*)p)); }

__device__ __forceinline__ void transpose_item(const float* W, int K, int N, bf16* WT, int perm, LAS float* scr, int item, int lane) {
    const int nblk = N / 32, kb = item / nblk, nb = item % nblk, k0 = 64 * kb, n0 = 32 * nb;
    int r0 = n0;
    if (perm) { const int bj = n0 / FF, f0 = n0 - bj * FF; r0 = (f0 >> 7) * 256 + bj * 128 + (f0 & 127); }
#pragma unroll 8
    for (int i = 0; i < 32; ++i) { const int kk = 2 * i + (lane >> 5); scr[kk * 33 + (lane & 31)] = W[(size_t)(k0 + kk) * N + n0 + (lane & 31)]; }
    asm volatile("s_waitcnt lgkmcnt(0)" ::: "memory");
    const int c = lane & 7;
#pragma unroll
    for (int j = 0; j < 4; ++j) { const int n = (lane >> 3) + 8 * j; const LAS float* s = scr + (8 * c) * 33 + n;
        u32x4 o; o.x = pk2(s[0 * 33], s[1 * 33]); o.y = pk2(s[2 * 33], s[3 * 33]); o.z = pk2(s[4 * 33], s[5 * 33]); o.w = pk2(s[6 * 33], s[7 * 33]);
        *(u32x4*)(WT + (size_t)(r0 + n) * K + k0 + 8 * c) = o; }
    asm volatile("s_waitcnt lgkmcnt(0)" ::: "memory");
}

struct Args { const float* in[17]; float* out; unsigned char* ws; };

__device__ __forceinline__ void ln_apply(const float* Y, float* Yo, bf16* HB, const float* st, float* ms, const float* gam, const float* bet, int gw, int ngw, int lane) {
    f32x4 g4[4], b4[4];
#pragma unroll
    for (int j = 0; j < 4; ++j) { g4[j] = ((const f32x4*)gam)[lane + 64 * j]; b4[j] = ((const f32x4*)bet)[lane + 64 * j]; }
    for (int m = gw; m < NTOK; m += ngw) {
        const f32x4* yr = (const f32x4*)(Y + (size_t)m * DM) + lane;
        f32x4 v[4];
#pragma unroll
        for (int j = 0; j < 4; ++j) v[j] = yr[64 * j];
        const f32x4 a = *(const f32x4*)(st + (size_t)m * 8), b = *(const f32x4*)(st + (size_t)m * 8 + 4);
        const float s = (a[0] + a[2]) + (b[0] + b[2]), q = (a[1] + a[3]) + (b[1] + b[3]);
        const float mean = s * (1.f / DM), rstd = 1.f / sqrtf(q * (1.f / DM) - mean * mean + LN_EPS);
        if (lane == 0) { ms[(size_t)m * 2] = mean; ms[(size_t)m * 2 + 1] = rstd; }
        u32x2* o8 = (u32x2*)(HB + (size_t)m * DM) + lane;
#pragma unroll
        for (int j = 0; j < 4; ++j) { const f32x4 o = (v[j] - mean) * rstd * g4[j] + b4[j]; if (Yo) ((f32x4*)(Yo + (size_t)m * DM) + lane)[64 * j] = o; u32x2 w; w.x = pk2(o.x, o.y); w.y = pk2(o.z, o.w); o8[64 * j] = w; }
    }
}

__device__ __forceinline__ void ffn_fix_phase(const float* HT, bf16* Gb, const float* cw, const float* cb, int cu, int G, int tid) {
    const int sub = tid >> 6, r = (tid >> 5) & 1, f = (tid & 31) * 4;
    for (int up = cu * 8 + sub; up < 224 * 22; up += G * 8) {
        const int pn = up % 22, pq = up / 22, pm = pq + pq / 7 + 1;
        const float* hc = HT + (size_t)(pm * 22 + pn) * 1024; const float* hp = HT + (size_t)((pm - 1) * 22 + pn) * 1024;
        f32x4 y[2];
#pragma unroll
        for (int hh = 0; hh < 2; ++hh) { const int c = hh * 128 + f; const int F = hh * FF + 128 * pn + f;
            const f32x4 h0 = *(const f32x4*)(hc + c), h1 = *(const f32x4*)(hc + 256 + c), t0 = *(const f32x4*)(hp + 512 + c), t1 = *(const f32x4*)(hp + 768 + c);
            const f32x4 x0 = r ? h1 : h0, xm1 = r ? h0 : t1, xm2 = r ? t1 : t0;
            y[hh] = *(const f32x4*)(cb + F) + *(const f32x4*)(cw + F) * xm2 + *(const f32x4*)(cw + FF2 + F) * xm1 + *(const f32x4*)(cw + 2 * FF2 + F) * x0; }
        float v[4];
#pragma unroll
        for (int e = 0; e < 4; ++e) v[e] = y[0][e] * __builtin_amdgcn_rcpf(1.0f + __builtin_amdgcn_exp2f(-1.4426950408889634f * y[0][e])) * y[1][e];
        u32x2 w; w.x = pk2(v[0], v[1]); w.y = pk2(v[2], v[3]);
        *(u32x2*)(Gb + (size_t)(pm * 256 + r) * FF + 128 * pn + f) = w;
    }
}

__device__ __forceinline__ void attn_phase(LAS unsigned char* lds, const bf16* Q, const bf16* K, const bf16* V, bf16* O, int cu, int G, int rev) {
    const int tid = opaque_tid(), lane = tid & 63, wid = __builtin_amdgcn_readfirstlane(tid >> 6), q32 = lane & 31, hi = lane >> 5, li = lane & 15;
    LAS unsigned char* Ks = lds + wid * 10752;
    LAS unsigned char* Vs = Ks + 4608;
    const int lkey = lane >> 3, lch = lane & 7;
    const float LOG2E = 1.4426950408889634f;
    for (int k = 0; k < 16; ++k) {
        const int idx = cu * 8 + wid + 2048 * (k & 3), b = 4 * (idx & 7) + (rev ? 3 - (k >> 2) : (k >> 2)), h = (idx >> 3) & 15, qb = idx >> 7;
        const size_t rowbase = (size_t)b * SEQ;
        const int q0w = qb * 32;
        bf16x8 qf[4];
        { const bf16* qp = Q + (rowbase + q0w + q32) * DM + h * HD + hi * 8;
#pragma unroll
          for (int ks = 0; ks < 4; ++ks) qf[ks] = *(const bf16x8*)(qp + ks * 16); }
        f32x16 o0, o1;
#pragma unroll
        for (int r = 0; r < 16; ++r) { o0[r] = 0.f; o1[r] = 0.f; }
        float R = 0.f;
        const bf16* kp = K + (rowbase + lkey) * DM + h * HD + lch * 8;
        const bf16* vp = V + (rowbase + lkey) * DM + h * HD + lch * 8;
        u32x4 kr[4], vr[4];
#pragma unroll
        for (int jj = 0; jj < 4; ++jj) { kr[jj] = *(const u32x4*)(kp + (size_t)(q0w + 8 * jj) * DM); vr[jj] = *(const u32x4*)(vp + (size_t)(q0w + 8 * jj) * DM); }
        for (int key0 = q0w; key0 >= 0; key0 -= 32) {
#pragma unroll
            for (int jj = 0; jj < 4; ++jj) { *(LAS u32x4*)(Ks + (lkey + 8 * jj) * 144 + lch * 16) = kr[jj]; *(LAS u32x4*)(Vs + (lkey + 8 * jj) * 192 + lch * 16) = vr[jj]; }
            asm volatile("s_waitcnt lgkmcnt(0)" ::: "memory");
            if (key0 >= 32) {
#pragma unroll
                for (int jj = 0; jj < 4; ++jj) { kr[jj] = *(const u32x4*)(kp + (size_t)(key0 - 32 + 8 * jj) * DM); vr[jj] = *(const u32x4*)(vp + (size_t)(key0 - 32 + 8 * jj) * DM); } }
            const bool diag = (key0 == q0w);
            f32x16 s;
#pragma unroll
            for (int r = 0; r < 16; ++r) s[r] = 0.f;
#pragma unroll
            for (int ks = 0; ks < 4; ++ks) { const bf16x8 kf = *(LAS const bf16x8*)(Ks + q32 * 144 + (16 * ks + 8 * hi) * 2);
                s = __builtin_amdgcn_mfma_f32_32x32x16_bf16(kf, qf[ks], s, 0, 0, 0); }
            float zs[16], l1[16];
#pragma unroll
            for (int r = 0; r < 16; ++r) { const float z = s[r] * LOG2E; const float e = __builtin_amdgcn_exp2f(-__builtin_fabsf(z)); const float t = __builtin_amdgcn_logf(1.0f + e);
                float l = -(__builtin_fmaxf(z, 0.f) + t);
                if (diag) { const int kl = 8 * (r >> 2) + 4 * hi + (r & 3); if (kl >= q32) l = 0.f; }
                zs[r] = z; l1[r] = l; }
            float G0[4], G1[4];
#pragma unroll
            for (int j = 0; j < 4; ++j) { const float gs = (l1[4 * j] + l1[4 * j + 1]) + (l1[4 * j + 2] + l1[4 * j + 3]);
                auto rr = __builtin_amdgcn_permlane32_swap(__float_as_uint(gs), __float_as_uint(gs), false, false); G0[j] = __uint_as_float(rr[0]); G1[j] = __uint_as_float(rr[1]); }
            float p[16]; float run = R;
#pragma unroll
            for (int j = 3; j >= 0; --j) { float sfx = run + (hi == 0 ? G1[j] : 0.f);
#pragma unroll
                for (int e = 3; e >= 0; --e) { const int r = 4 * j + e; float val = __builtin_amdgcn_exp2f(l1[r] + zs[r] + sfx);
                    if (diag) { const int kl = 8 * j + 4 * hi + e; if (kl >= q32) val = 0.f; }
                    p[r] = val; sfx += l1[r]; }
                run += G0[j] + G1[j]; }
            R = run;
#pragma unroll
            for (int ks2 = 0; ks2 < 2; ++ks2) {
                u32x4 pw; pw.x = pk2(p[8 * ks2], p[8 * ks2 + 1]); pw.y = pk2(p[8 * ks2 + 2], p[8 * ks2 + 3]); pw.z = pk2(p[8 * ks2 + 4], p[8 * ks2 + 5]); pw.w = pk2(p[8 * ks2 + 6], p[8 * ks2 + 7]);
                const bf16x8 pb = __builtin_bit_cast(bf16x8, pw);
#pragma unroll
                for (int dh = 0; dh < 2; ++dh) {
                    LAS const unsigned char* va = Vs + (16 * ks2 + 4 * hi + (li >> 2)) * 192 + (32 * dh + 16 * ((lane >> 4) & 1) + 4 * (li & 3)) * 2;
                    const s16x4 lo = vtr(va), hi4 = vtr(va + 8 * 192);
                    const bf16x8 vf = (bf16x8){lo[0], lo[1], lo[2], lo[3], hi4[0], hi4[1], hi4[2], hi4[3]};
                    if (dh == 0) o0 = __builtin_amdgcn_mfma_f32_32x32x16_bf16(vf, pb, o0, 0, 0, 0);
                    else         o1 = __builtin_amdgcn_mfma_f32_32x32x16_bf16(vf, pb, o1, 0, 0, 0);
                }
            }
            asm volatile("s_waitcnt lgkmcnt(0)" ::: "memory");
            if (__all(R < -150.0f)) break;
        }
        bf16* op = O + (rowbase + q0w + q32) * DM + h * HD + 4 * hi;
#pragma unroll
        for (int j = 0; j < 4; ++j) { u32x2 w0, w1; w0.x = pk2(o0[4 * j], o0[4 * j + 1]); w0.y = pk2(o0[4 * j + 2], o0[4 * j + 3]); w1.x = pk2(o1[4 * j], o1[4 * j + 1]); w1.y = pk2(o1[4 * j + 2], o1[4 * j + 3]);
            *(u32x2*)(op + 8 * j) = w0; *(u32x2*)(op + 32 + 8 * j) = w1; }
    }
    __syncthreads();
}

__device__ __forceinline__ void spatial_phase(LAS unsigned char* lds, const bf16* ZZ, bf16* GT, const bf16* Wc, const float* bs, const float* gam, const float* bet, int cu, int G, int rev) {
    const int tid = opaque_tid(), lane = tid & 63, wid = __builtin_amdgcn_readfirstlane(tid >> 6), fr = lane & 15, kg = lane >> 4;
    LAS float* st = (LAS float*)(lds + 69632);
    const int wr = wid >> 2, wc = wid & 3;
    for (int k = 0; k < 2; ++k) {
        const int cls = 2 * k + (cu >> 7); const int chunk = 64 * (cu & 7) + 16 * (rev ? 3 - cls : cls) + ((cu >> 3) & 15);
        const size_t row0 = (size_t)chunk * GC;
        __syncthreads();
        for (int i0 = 0; i0 < 16; i0 += 4) {
            u32x4 w[4][4]; float s[4], mean[4], s2[4];
#pragma unroll
            for (int rr = 0; rr < 4; ++rr) { const bf16* vr = ZZ + (row0 + 16 * wid + i0 + rr) * 4096 + GW;
#pragma unroll
                for (int j = 0; j < 4; ++j) w[rr][j] = *(const u32x4*)(vr + (lane + 64 * j) * 8); }
#pragma unroll
            for (int rr = 0; rr < 4; ++rr) { float a = 0.f;
#pragma unroll
                for (int j = 0; j < 4; ++j)
#pragma unroll
                    for (int e = 0; e < 4; ++e) a += bflo(w[rr][j][e]) + bfhi(w[rr][j][e]);
                s[rr] = a; }
#pragma unroll
            for (int rr = 0; rr < 4; ++rr) mean[rr] = wave_sum(s[rr]) * (1.f / GW);
#pragma unroll
            for (int rr = 0; rr < 4; ++rr) { float a = 0.f;
#pragma unroll
                for (int j = 0; j < 4; ++j)
#pragma unroll
                    for (int e = 0; e < 4; ++e) { const float d0 = bflo(w[rr][j][e]) - mean[rr], d1 = bfhi(w[rr][j][e]) - mean[rr]; a += d0 * d0 + d1 * d1; }
                s2[rr] = a; }
#pragma unroll
            for (int rr = 0; rr < 4; ++rr) { const float rstd = 1.f / sqrtf(wave_sum(s2[rr]) * (1.f / GW) + LN_EPS); const int r = 16 * wid + i0 + rr;
                if (lane == 0) { st[2 * r] = mean[rr]; st[2 * r + 1] = rstd; } }
        }
        const int c8 = tid & 31, srow = tid >> 5;
        LAS unsigned char* const wl = lds + 72704;
        const int wt = tid >> 2, wq = tid & 3;
        u32x4 nv[8], nw[4];
#pragma unroll
        for (int it = 0; it < 8; ++it) nv[it] = *(const u32x4*)(ZZ + (row0 + it * 16 + srow) * 4096 + GW + c8 * 8);
#pragma unroll
        for (int q = 0; q < 4; ++q) nw[q] = *(const u32x4*)(Wc + (size_t)wt * GC + wq * 32 + q * 8);
        for (int g = 0; g < GG; ++g) {
            __syncthreads();
            { const float* gp = gam + g * 256 + c8 * 8; const float* bp = bet + g * 256 + c8 * 8;
              const f32x4 ga = *(const f32x4*)gp, gb = *(const f32x4*)(gp + 4), ba = *(const f32x4*)bp, bb = *(const f32x4*)(bp + 4);
#pragma unroll
              for (int q = 0; q < 4; ++q) *(LAS u32x4*)(wl + wt * 272 + wq * 64 + q * 16) = nw[q];
#pragma unroll
              for (int it = 0; it < 8; ++it) { const int s = it * 16 + srow;
                  const u32x4 w = nv[it];
                  const float mean = st[2 * s], rstd = st[2 * s + 1];
                  u32x4 o;
                  o.x = pk2((bflo(w.x) - mean) * rstd * ga.x + ba.x, (bfhi(w.x) - mean) * rstd * ga.y + ba.y);
                  o.y = pk2((bflo(w.y) - mean) * rstd * ga.z + ba.z, (bfhi(w.y) - mean) * rstd * ga.w + ba.w);
                  o.z = pk2((bflo(w.z) - mean) * rstd * gb.x + bb.x, (bfhi(w.z) - mean) * rstd * gb.y + bb.y);
                  o.w = pk2((bflo(w.w) - mean) * rstd * gb.z + bb.z, (bfhi(w.w) - mean) * rstd * gb.w + bb.w);
                  *(LAS u32x4*)(lds + s * 544 + c8 * 16) = o; } }
            __syncthreads();
            if (g + 1 < GG) {
#pragma unroll
                for (int it = 0; it < 8; ++it) nv[it] = *(const u32x4*)(ZZ + (row0 + it * 16 + srow) * 4096 + GW + (g + 1) * 256 + c8 * 8);
#pragma unroll
                for (int q = 0; q < 4; ++q) nw[q] = *(const u32x4*)(Wc + (size_t)(g + 1) * GC * GC + (size_t)wt * GC + wq * 32 + q * 8); }
            u32x2 uu[4][4];
#pragma unroll
            for (int tb = 0; tb < 4; ++tb)
#pragma unroll
                for (int cb = 0; cb < 4; ++cb) uu[tb][cb] = *(const u32x2*)(ZZ + (row0 + 64 * wr + 16 * tb + fr) * 4096 + g * 256 + 64 * wc + 16 * cb + 4 * kg);
            f32x4 acc[4][4];
#pragma unroll
            for (int a = 0; a < 4; ++a)
#pragma unroll
                for (int b2 = 0; b2 < 4; ++b2) acc[a][b2] = (f32x4){0.f, 0.f, 0.f, 0.f};
#pragma unroll
            for (int ks = 0; ks < 4; ++ks) {
                if (32 * ks <= 64 * wr + 63) {
                    bf16x8 X[4], Y[4];
#pragma unroll
                    for (int tb = 0; tb < 4; ++tb) { LAS const unsigned char* wp = wl + (64 * wr + 16 * tb + fr) * 272 + (32 * ks + 4 * kg) * 2;
                        const u32x2 a = *(LAS const u32x2*)wp, b2 = *(LAS const u32x2*)(wp + 32); const u32x4 w = (u32x4){a.x, a.y, b2.x, b2.y}; Y[tb] = __builtin_bit_cast(bf16x8, w); }
#pragma unroll
                    for (int cb = 0; cb < 4; ++cb) { LAS const unsigned char* xa = lds + (32 * ks + 4 * kg + (fr >> 2)) * 544 + (64 * wc + 16 * cb + 4 * (fr & 3)) * 2;
                        const s16x4 lo = vtr(xa), hi4 = vtr(xa + 16 * 544);
                        X[cb] = (bf16x8){lo[0], lo[1], lo[2], lo[3], hi4[0], hi4[1], hi4[2], hi4[3]}; }
#pragma unroll
                    for (int tb = 0; tb < 4; ++tb)
#pragma unroll
                        for (int cb = 0; cb < 4; ++cb) acc[tb][cb] = __builtin_amdgcn_mfma_f32_16x16x32_bf16(X[cb], Y[tb], acc[tb][cb], 0, 0, 0);
                }
            }
#pragma unroll
            for (int tb = 0; tb < 4; ++tb) { const int t = 64 * wr + 16 * tb + fr; const float bsv = bs[g * GC + t];
#pragma unroll
                for (int cb = 0; cb < 4; ++cb) { const int c = g * 256 + 64 * wc + 16 * cb + 4 * kg;
                    const u32x2 u = uu[tb][cb];
                    u32x2 o; o.x = pk2(bflo(u.x) * (acc[tb][cb][0] + bsv), bfhi(u.x) * (acc[tb][cb][1] + bsv)); o.y = pk2(bflo(u.y) * (acc[tb][cb][2] + bsv), bfhi(u.y) * (acc[tb][cb][3] + bsv));
                    *(u32x2*)(GT + (row0 + t) * GW + c) = o; } }
        }
    }
}

#ifndef PROBE
#define PROBE 0
#endif
#ifndef G2_REV
#define G2_REV 1
#endif
__device__ __forceinline__ void gbar(unsigned* ctr, unsigned target) {
    asm volatile("s_waitcnt vmcnt(0)" ::: "memory");
    __syncthreads();
    if (threadIdx.x == 0) {
        __builtin_amdgcn_fence(__ATOMIC_RELEASE, "agent");
        asm volatile("s_waitcnt vmcnt(0)" ::: "memory");
        __hip_atomic_fetch_add(ctr, 1u, __ATOMIC_RELAXED, __HIP_MEMORY_SCOPE_AGENT);
        while (__hip_atomic_load(ctr, __ATOMIC_RELAXED, __HIP_MEMORY_SCOPE_AGENT) < target) __builtin_amdgcn_s_sleep(1);
        __builtin_amdgcn_fence(__ATOMIC_ACQUIRE, "agent");
        asm volatile("s_waitcnt vmcnt(0)" ::: "memory");
    }
    __syncthreads();
}
#define GSYNC() do { bar_target += (unsigned)G; gbar(bar_ctr, bar_target); if (PROBE == 7) { bar_target += (unsigned)G; gbar(bar_ctr, bar_target); } } while (0)
__global__ void __launch_bounds__(512, 2) fwd_kernel(Args args) {
    extern __shared__ __attribute__((aligned(16))) unsigned char lds_raw[];
    cg::grid_group grid = cg::this_grid();
    LAS unsigned char* lds = (LAS unsigned char*)lds_raw;
    const int G = gridDim.x, cu = blockIdx.x, ngw = G * 8;
    unsigned char* ws = args.ws;
    const float* x = args.in[0];
    float* out = args.out;
    bf16* HB = (bf16*)(ws + WS_HB);
    unsigned* bar_ctr = (unsigned*)(ws + WS_CTL); unsigned bar_target = 0u;
    if (cu == 0 && threadIdx.x < 8) __hip_atomic_store((unsigned*)(ws + WS_CTL + 8192) + 64 * threadIdx.x, 0u, __ATOMIC_RELAXED, __HIP_MEMORY_SCOPE_AGENT);
    if (cu == 0 && threadIdx.x == 0) __hip_atomic_store(bar_ctr, 0u, __ATOMIC_RELAXED, __HIP_MEMORY_SCOPE_AGENT);

    for (int rep = 0; rep < (PROBE == 8 ? 2 : 1); ++rep) {
        const int tid = opaque_tid(), lane = tid & 63, wave = __builtin_amdgcn_readfirstlane(tid >> 6), gw = cu * 8 + wave;
        LAS float* scr = (LAS float*)(lds + wave * 16384);
        for (int mat = 0; mat < 16; ++mat) {
            const float* W; bf16* WT; int K, N, perm = 0;
            if (mat < 2)       { W = args.in[1] + (size_t)mat * DM * 3072;        WT = (bf16*)(ws + WS_ATTN_IN) + (size_t)mat * 3072 * DM;        K = DM; N = 3072; }
            else if (mat < 4)  { W = args.in[2] + (size_t)(mat - 2) * DM * DM;    WT = (bf16*)(ws + WS_ATTN_OUT) + (size_t)(mat - 2) * DM * DM;   K = DM; N = DM; }
            else if (mat < 6)  { W = args.in[3] + (size_t)(mat - 4) * DM * 4096;  WT = (bf16*)(ws + WS_GMLP_IN) + (size_t)(mat - 4) * 4096 * DM;  K = DM; N = 4096; }
            else if (mat < 8)  { W = args.in[8] + (size_t)(mat - 6) * GW * DM;    WT = (bf16*)(ws + WS_GMLP_OUT) + (size_t)(mat - 6) * DM * GW;   K = GW; N = DM; }
            else if (mat < 12) { W = args.in[9] + (size_t)(mat - 8) * DM * FF2;   WT = (bf16*)(ws + WS_FFN_UP) + (size_t)(mat - 8) * FF2 * DM;    K = DM; N = FF2; perm = 1; }
            else               { W = args.in[12] + (size_t)(mat - 12) * FF * DM;  WT = (bf16*)(ws + WS_FFN_DOWN) + (size_t)(mat - 12) * DM * FF;  K = FF; N = DM; }
            const int nitems = (K / 64) * (N / 32);
            for (int it = gw; it < nitems; it += ngw) transpose_item(W, K, N, WT, perm, scr, it, lane);
        }
        { const float* wsrc = args.in[6]; bf16* wd = (bf16*)(ws + WS_WS);
          for (int i = cu * 512 + tid; i < 2 * GG * GC * GC; i += G * 512) { const int s = i & 127, t = (i >> 7) & 127; const float v = (s <= t) ? wsrc[i] : 0.f; wd[i] = (bf16)(pk2(v, v) & 0xffffu); } }
        for (int m = gw; m < NTOK; m += ngw) {
            const f32x4* xr = (const f32x4*)(x + (size_t)m * DM) + lane; u32x2* o8 = (u32x2*)(HB + (size_t)m * DM) + lane;
#pragma unroll
            for (int j = 0; j < 4; ++j) { const f32x4 v = xr[64 * j]; u32x2 w; w.x = pk2(v.x, v.y); w.y = pk2(v.z, v.w); o8[64 * j] = w; }
        }
    }
    grid.sync();

    int dir = 0;
    for (int layer = 0; layer < DEPTH; ++layer) {
        const int j = layer >> 1, mixer = layer & 1;
        for (int step = 0; step < 2; ++step) {
            if (step == 0) {
                pg8::Gemm g; pg8::EpiBf16 E;
                if (mixer == 0) { g = pg8::Gemm{HB, (const bf16*)(ws + WS_ATTN_IN) + (size_t)j * 3072 * DM, NTOK, 3072, DM};
                    E = pg8::EpiBf16{(bf16*)(ws + WS_Q), DM, 0, DM, (size_t)NTOK * DM, 0.125f}; }
                else { g = pg8::Gemm{HB, (const bf16*)(ws + WS_GMLP_IN) + (size_t)j * 4096 * DM, NTOK, 4096, DM};
                    E = pg8::EpiBf16{(bf16*)(ws + WS_ZZ), 4096, 1, 0, 0, 1.f}; }
                pg8::StaticOrder S; S.rev = dir; dir ^= 1; S.init(g.M, g.N, G, cu);
                for (int rep = 0; rep < (PROBE == 1 ? 2 : 1); ++rep)
                pg8::gemm_phase<pg8::EpiBf16, pg8::StaticOrder, true, true>(lds, g, S, E);
            } else {
                pg8::Gemm g{HB, (const bf16*)(ws + WS_FFN_UP) + (size_t)layer * FF2 * DM, NTOK, FF2, DM};
                pg8::EpiConv E{(bf16*)(ws + WS_G), args.in[10] + (size_t)layer * 3 * FF2, args.in[11] + (size_t)layer * FF2, lds + 131072, FF, FF2, FF, (float*)(ws + WS_HT)};
                pg8::StaticOrder S; S.rev = dir; dir ^= 1; S.init(g.M, g.N, G, cu);
                for (int rep = 0; rep < (PROBE == 4 ? 2 : 1); ++rep)
                pg8::gemm_phase<pg8::EpiConv, pg8::StaticOrder, true, true>(lds, g, S, E);
                GSYNC();
                ffn_fix_phase((const float*)(ws + WS_HT), (bf16*)(ws + WS_G), args.in[10] + (size_t)layer * 3 * FF2, args.in[11] + (size_t)layer * FF2, cu, G, opaque_tid());
            }
            GSYNC();
            if (step == 0) {
                for (int rep = 0; rep < (((PROBE == 2 && mixer == 0) || (PROBE == 3 && mixer == 1)) ? 2 : 1); ++rep)
                if (mixer == 0) attn_phase(lds, (const bf16*)(ws + WS_Q), (const bf16*)(ws + WS_K), (const bf16*)(ws + WS_V), (bf16*)(ws + WS_O), cu, G, dir);
                else spatial_phase(lds, (const bf16*)(ws + WS_ZZ), (bf16*)(ws + WS_GT), (const bf16*)(ws + WS_WS) + (size_t)j * GG * GC * GC, args.in[7] + j * GG * GC, args.in[4] + j * GW, args.in[5] + j * GW, cu, G, dir); dir ^= 1;
                GSYNC();
            }
            const int lnidx = 2 * layer + step;
            {
                pg8::Gemm g;
                if (step == 0 && mixer == 0) g = pg8::Gemm{(const bf16*)(ws + WS_O), (const bf16*)(ws + WS_ATTN_OUT) + (size_t)j * DM * DM, NTOK, DM, DM};
                else if (step == 0) g = pg8::Gemm{(const bf16*)(ws + WS_GT), (const bf16*)(ws + WS_GMLP_OUT) + (size_t)j * DM * GW, NTOK, DM, GW};
                else g = pg8::Gemm{(const bf16*)(ws + WS_G), (const bf16*)(ws + WS_FFN_DOWN) + (size_t)layer * DM * FF, NTOK, DM, FF};
                const int pl = (lnidx - 1) >> 1;
                const float* pgam = lnidx == 0 ? nullptr : (((lnidx - 1) & 1) ? args.in[15] : args.in[13]) + pl * DM;
                const float* pbet = lnidx == 0 ? nullptr : (((lnidx - 1) & 1) ? args.in[16] : args.in[14]) + pl * DM;
                const float* cgam = (step == 0 ? args.in[13] : args.in[15]) + layer * DM;
                const float* cbet = (step == 0 ? args.in[14] : args.in[16]) + layer * DM;
                pg8::EpiResLn E{lnidx == 0 ? x : out, out, lnidx == 0 ? nullptr : (const float*)(ws + WS_MS) + (size_t)((lnidx & 1) ^ 1) * NTOK * 2, pgam, pbet, (float*)(ws + WS_ST),
                                (float*)(ws + WS_MS) + (size_t)(lnidx & 1) * NTOK * 2, cgam, cbet, HB, (unsigned*)(ws + WS_CTL + 8192), 128u * (unsigned)lnidx, lnidx == 2 * DEPTH - 1 ? 1 : 0, lds + 131072, dir};
                pg8::StaticOrder S; S.rev = dir; dir ^= 1; S.init(g.M, g.N, G, cu);
                if (PROBE == 9) { pg8::EpiBf16 E0{(bf16*)(ws + WS_R + (step == 1 ? 512 * MiB : 0)), DM, 0, 0, 0, 1.f};
                    pg8::gemm_phase<pg8::EpiBf16, pg8::StaticOrder, true, true>(lds, g, S, E0); }
                pg8::gemm_phase<pg8::EpiResLn, pg8::StaticOrder, true, true>(lds, g, S, E);
            }
            if (lnidx != 2 * DEPTH - 1) GSYNC();
        }
    }
}

extern "C" void kernel_launch(void* const* d_in, const int* in_sizes, int n_in, void* d_out, int out_size, void* d_ws, size_t ws_size, hipStream_t stream) {
    static int grid = 0;
    if (grid == 0) {
        if (n_in != 17 || out_size != NTOK * DM || ws_size < WS_END) { fprintf(stderr, "kernel_launch: unexpected shapes (n_in %d, out %d, ws %zu)\n", n_in, out_size, ws_size); grid = -1; return; }
        int dev = 0, cus = 0, per_cu = 0;
        hipGetDevice(&dev);
        hipDeviceGetAttribute(&cus, hipDeviceAttributeMultiprocessorCount, dev);
        if (hipFuncSetAttribute((const void*)fwd_kernel, hipFuncAttributeMaxDynamicSharedMemorySize, LDS_BYTES) != hipSuccess) { fprintf(stderr, "kernel_launch: hipFuncSetAttribute failed\n"); grid = -1; return; }
        if (hipOccupancyMaxActiveBlocksPerMultiprocessor(&per_cu, (const void*)fwd_kernel, 512, LDS_BYTES) != hipSuccess || per_cu < 1) { fprintf(stderr, "kernel_launch: occupancy query says %d\n", per_cu); per_cu = 1; }
        (void)hipGetLastError();
        grid = cus * per_cu;
        fprintf(stderr, "kernel_launch: grid %d (cus %d x %d)\n", grid, cus, per_cu);
        if (grid != 256) { fprintf(stderr, "kernel_launch: the fused LayerNorm epilogue's group barrier is laid out for a 256-workgroup grid; nothing launched\n"); grid = -1; return; }
    }
    if (grid < 0) return;
    Args a{};
    for (int i = 0; i < 17; ++i) a.in[i] = (const float*)d_in[i];
    a.out = (float*)d_out; a.ws = (unsigned char*)d_ws;
    void* kargs[] = {&a};
    hipError_t e = hipLaunchCooperativeKernel((const void*)fwd_kernel, dim3(grid), dim3(512), kargs, LDS_BYTES, stream);
    if (e != hipSuccess) fprintf(stderr, "cooperative launch failed: %s (grid %d)\n", hipGetErrorString(e), grid);
}
```

```cpp
#include <hip/hip_runtime.h>
#include <hip/hip_cooperative_groups.h>
#include <cstdio>
#include <cstdint>
namespace cg = cooperative_groups;
__device__ __forceinline__ int opaque_tid() { int t = threadIdx.x; asm volatile("" : "+v"(t)); return t; }
namespace pg8 {
#define PG8_LAS __attribute__((address_space(3)))
typedef unsigned short bf16_t;
typedef short bf16x8 __attribute__((ext_vector_type(8)));
typedef float f32x4 __attribute__((ext_vector_type(4)));
typedef unsigned u32x4 __attribute__((ext_vector_type(4)));
constexpr int BM = 256, BK = 64, HALF = 128, HTB = HALF * BK * 2  , STAGE_BYTES = 8 * HTB, NXCD = 8, WGM = 8;

__host__ __device__ __forceinline__ int lds_byte(int r, int c) { const int st = (r >> 4) * 2 + (c >> 5), rr = r & 15, cc = c & 31, ob = rr * 64 + cc * 2; return st * 1024 + (ob ^ (((ob >> 9) & 1) << 5)); }
__host__ __device__ __forceinline__ void stage_rc(int b, int& R, int& C) { const int st = b / 1024, sb = b % 1024, swz = sb ^ (((sb >> 9) & 1) << 5); R = (st >> 1) * 16 + swz / 64; C = (st & 1) * 32 + (swz % 64) / 2; }
__host__ __device__ __forceinline__ int perm32(int rho) { const int n = rho >> 4, i = rho & 15; return 8 * (i >> 2) + 4 * n + (i & 3); }

struct Unit { int pm, pn; };
struct Gemm { const bf16_t* A; const bf16_t* Bt; int M, N, K; };

struct StaticOrder {
    int nM, nN, nwg, G, c, rev = 0;
    __host__ __device__ void init(int M, int N, int G_, int c_) { nM = M / BM; nN = N / BM; nwg = nM * nN; G = G_; c = c_; }
    __host__ __device__ bool next(int i, Unit& u) const {
        if ((long)i * G + c >= nwg) return false;
        const long L = (long)(rev ? (nwg / G - 1 - i) : i) * G + c;
        int wgid = (int)L; { const int q = nwg / NXCD, r = nwg % NXCD, xcd = wgid % NXCD, off = wgid / NXCD; wgid = (xcd < r ? xcd * (q + 1) : r * (q + 1) + (xcd - r) * q) + off; }
        const int nig = WGM * nN, gid = wgid / nig, fm = gid * WGM, gsz = (nM - fm) < WGM ? (nM - fm) : WGM;
        u.pm = fm + ((wgid % nig) % gsz); u.pn = (wgid % nig) / gsz; return true;
    }
    __device__ __forceinline__ void a_ready(const Unit&) const {}
    __device__ __forceinline__ void done(const Unit&) const {}
};
__device__ __forceinline__ unsigned cvt_pk_bf16(float lo, float hi) { unsigned r; asm volatile("v_cvt_pk_bf16_f32 %0, %1, %2" : "=v"(r) : "v"(lo), "v"(hi)); return r; }
typedef float f32x2 __attribute__((ext_vector_type(2)));
typedef unsigned u32x2e __attribute__((ext_vector_type(2)));
__device__ __forceinline__ float gelu_tanh(float x) {
    const float t = x * (-2.302208198f + (-0.1029432397f) * x * x);
    return x * __builtin_amdgcn_rcpf(1.0f + __builtin_amdgcn_exp2f(t));
}
struct EpiBf16 {
    static constexpr bool PERM = true, AFTER_DRAIN = false;
    bf16_t* O; int ldc; int act; int split_cols; size_t split_stride; float scale0;
    __device__ __forceinline__ void operator()(const f32x4 (&acc)[2][2][4][2], const Unit& u, int wr, int wc, int fr, int fq) const {
        const int row0 = u.pm * BM + wr * 64 + fr; int colt = u.pn * BM; bf16_t* base = O;
        float sc = 1.f; if (split_cols) { const int t = colt / split_cols; base += (size_t)t * split_stride; colt -= t * split_cols; if (t == 0) sc = scale0; }
        const int col0 = colt + wc * 32 + 8 * fq;
#pragma unroll
        for (int ai = 0; ai < 2; ++ai)
#pragma unroll
            for (int m = 0; m < 4; ++m) { bf16_t* rowp = base + (size_t)(row0 + ai * HALF + m * 16) * ldc + col0;
#pragma unroll
                for (int bj = 0; bj < 2; ++bj) { f32x4 v0 = acc[ai][bj][m][0], v1 = acc[ai][bj][m][1];
                    if (act) { v0 = (f32x4){gelu_tanh(v0[0]), gelu_tanh(v0[1]), gelu_tanh(v0[2]), gelu_tanh(v0[3])};
                               v1 = (f32x4){gelu_tanh(v1[0]), gelu_tanh(v1[1]), gelu_tanh(v1[2]), gelu_tanh(v1[3])}; }
                    v0 = v0 * sc; v1 = v1 * sc; u32x4 w; w.x = cvt_pk_bf16(v0[0], v0[1]); w.y = cvt_pk_bf16(v0[2], v0[3]); w.z = cvt_pk_bf16(v1[0], v1[1]); w.w = cvt_pk_bf16(v1[2], v1[3]);
                    *(u32x4*)(rowp + bj * HALF) = w; } }
    }
};
struct EpiRes {
    static constexpr bool PERM = false, AFTER_DRAIN = false;
    const float* base; float* out; int ldc; float alpha;
    __device__ __forceinline__ void operator()(const f32x4 (&acc)[2][2][4][2], const Unit& u, int wr, int wc, int fr, int fq) const {
        const int col0 = u.pn * BM + wc * 32 + 4 * fq;
#pragma unroll
        for (int ai = 0; ai < 2; ++ai)
#pragma unroll
            for (int m = 0; m < 4; ++m) { const size_t off = (size_t)(u.pm * BM + ai * HALF + wr * 64 + m * 16 + fr) * ldc + col0;
#pragma unroll
                for (int bj = 0; bj < 2; ++bj)
#pragma unroll
                    for (int n = 0; n < 2; ++n) { const f32x4 bs = *(const f32x4*)(base + off + bj * HALF + n * 16);
                        *(f32x4*)(out + off + bj * HALF + n * 16) = bs * alpha + acc[ai][bj][m][n]; }
                asm volatile("" ::: "memory"); }
    }
};

template <int CTRL> __device__ __forceinline__ float dpp_mov(float old, float src) {
    return __builtin_bit_cast(float, __builtin_amdgcn_update_dpp(__builtin_bit_cast(int, old), __builtin_bit_cast(int, src), CTRL, 0xf, 0xf, false));
}
struct SeqOrder {
    int G, c;
    __device__ bool next(int i, Unit& u) const { if (i >= 22) return false; int it, step;
        if (i < 16) { it = c + G * (i >> 3); step = i & 7; } else { const int v = 6 * c + (i - 16); it = 512 + (v >> 3); step = v & 7; }
        u.pn = it >> 5; u.pm = 8 * (it & 31) + step; return true; }
    __device__ __forceinline__ void a_ready(const Unit&) const {}
    __device__ __forceinline__ void done(const Unit&) const {}
};
struct EpiConv {
    static constexpr bool PERM = true, AFTER_DRAIN = false;
    bf16_t* O; const float* cw; const float* cb; PG8_LAS unsigned char* hl; int ldo, ncol2, nfeat; float* ht;
    __device__ __forceinline__ void operator()(const f32x4 (&acc)[2][2][4][2], const Unit& u, int wr, int wc, int fr, int fq) const {
        const int lcol = wc * 32 + 8 * fq;
        { const int t = opaque_tid();
          if (t < 256) { const int p = t >> 5, ch = t & 31, pp = p & 3; const float* src = (pp < 3 ? cw + pp * ncol2 : cb) + (p >> 2) * nfeat + 128 * u.pn + 4 * ch;
              *(PG8_LAS f32x4*)(hl + 10240 + (p * 128 + 4 * ch) * 4) = *(const f32x4*)src; } }
        float* const htu = ht + (size_t)(u.pm * 22 + u.pn) * 1024;
        if (fr >= 14) {
#pragma unroll
            for (int ai = 0; ai < 2; ++ai) { const int k = 2 * ai + wr;
                if (k < 3) { PG8_LAS unsigned char* hp = hl + k * 2048 + (fr - 14) * 1024 + lcol * 4;
#pragma unroll
                    for (int bj = 0; bj < 2; ++bj)
#pragma unroll
                        for (int n = 0; n < 2; ++n) *(PG8_LAS f32x4*)(hp + bj * 512 + n * 16) = acc[ai][bj][3][n]; }
                else {
#pragma unroll
                    for (int bj = 0; bj < 2; ++bj)
#pragma unroll
                        for (int n = 0; n < 2; ++n) *(f32x4*)(htu + (2 + fr - 14) * 256 + bj * 128 + lcol + 4 * n) = acc[ai][bj][3][n]; } }
        }
        if (wr == 0 && fr < 2) {
#pragma unroll
            for (int bj = 0; bj < 2; ++bj)
#pragma unroll
                for (int n = 0; n < 2; ++n) *(f32x4*)(htu + fr * 256 + bj * 128 + lcol + 4 * n) = acc[0][bj][0][n];
        }
        asm volatile("s_waitcnt lgkmcnt(0)" ::: "memory"); __builtin_amdgcn_s_barrier(); asm volatile("" ::: "memory");
#pragma unroll
        for (int n = 0; n < 2; ++n) {
            const int f = 128 * u.pn + lcol + 4 * n;
            PG8_LAS const float* const wl = (PG8_LAS const float*)(hl + 10240) + lcol + 4 * n;
            const f32x4 wg0 = *(PG8_LAS const f32x4*)(wl), wg1 = *(PG8_LAS const f32x4*)(wl + 128), wg2 = *(PG8_LAS const f32x4*)(wl + 256), bg = *(PG8_LAS const f32x4*)(wl + 384);
            const f32x4 wv0 = *(PG8_LAS const f32x4*)(wl + 512), wv1 = *(PG8_LAS const f32x4*)(wl + 640), wv2 = *(PG8_LAS const f32x4*)(wl + 768), bv = *(PG8_LAS const f32x4*)(wl + 896);
#pragma unroll
            for (int ai = 0; ai < 2; ++ai) {
                const int k = 2 * ai + wr;
                const int rslot = k > 0 ? k - 1 : 0;
                PG8_LAS const unsigned char* hp = hl + rslot * 2048 + (lcol + 4 * n) * 4;
                f32x4 hg2 = *(PG8_LAS const f32x4*)hp, hv2 = *(PG8_LAS const f32x4*)(hp + 512), hg1 = *(PG8_LAS const f32x4*)(hp + 1024), hv1 = *(PG8_LAS const f32x4*)(hp + 1536);
                if (k == 0) { hg2 = (f32x4){0.f, 0.f, 0.f, 0.f}; hv2 = hg2; hg1 = hg2; hv1 = hg2; }
#pragma unroll
                for (int m = 0; m < 4; ++m) {
                    float r[4];
#pragma unroll
                    for (int e = 0; e < 4; ++e) {
                        const float xg = acc[ai][0][m][n][e], xv = acc[ai][1][m][n][e];
                        float o1g, o2g, o1v, o2v;
                        if (m == 0) { o1g = hg1[e]; o2g = fr == 0 ? hg2[e] : hg1[e]; o1v = hv1[e]; o2v = fr == 0 ? hv2[e] : hv1[e]; }
                        else { const float pgv = acc[ai][0][m > 0 ? m - 1 : 0][n][e], pvv = acc[ai][1][m > 0 ? m - 1 : 0][n][e];
                            o1g = dpp_mov<0x121>(pgv, pgv); o2g = dpp_mov<0x122>(pgv, pgv); o1v = dpp_mov<0x121>(pvv, pvv); o2v = dpp_mov<0x122>(pvv, pvv); }
                        const float p1g = dpp_mov<0x111>(o1g, xg), p2g = dpp_mov<0x112>(o2g, xg), p1v = dpp_mov<0x111>(o1v, xv), p2v = dpp_mov<0x112>(o2v, xv);
                        const float yg = bg[e] + wg2[e] * xg + wg1[e] * p1g + wg0[e] * p2g;
                        const float yv = bv[e] + wv2[e] * xv + wv1[e] * p1v + wv0[e] * p2v;
                        r[e] = yg * __builtin_amdgcn_rcpf(1.0f + __builtin_amdgcn_exp2f(-1.4426950408889634f * yg)) * yv;
                    }
                    u32x2e w; w.x = cvt_pk_bf16(r[0], r[1]); w.y = cvt_pk_bf16(r[2], r[3]);
                    *(u32x2e*)(O + (size_t)(u.pm * BM + ai * HALF + wr * 64 + m * 16 + fr) * ldo + f) = w;
                }
            }
        }
    }
};

struct EpiResLn {
    static constexpr bool PERM = false, AFTER_DRAIN = false;
    const unsigned short* base16; int isbf; float* out; float* st; const float* cg; const float* cbeta; bf16_t* hb; unsigned short* hf; unsigned* gcnt; unsigned tgt0; int last; PG8_LAS unsigned char* xl; int rev;
    static constexpr int ldc = 1024; static constexpr float alpha = 1.681792830507429f, eps = 1e-5f;
    typedef _Float16 h16x2 __attribute__((ext_vector_type(2)));
    __device__ __forceinline__ f32x4 dec(u32x2e w) const {
        if (isbf) return (f32x4){__uint_as_float(w.x << 16), __uint_as_float(w.x & 0xffff0000u), __uint_as_float(w.y << 16), __uint_as_float(w.y & 0xffff0000u)};
        const float f0 = (float)__builtin_bit_cast(_Float16, (unsigned short)(w.x & 0xffffu)), f1 = (float)__builtin_bit_cast(_Float16, (unsigned short)(w.x >> 16));
        const float f2 = (float)__builtin_bit_cast(_Float16, (unsigned short)(w.y & 0xffffu)), f3 = (float)__builtin_bit_cast(_Float16, (unsigned short)(w.y >> 16));
        return (f32x4){f0, f1, f2, f3}; }
    __device__ __forceinline__ void operator()(f32x4 (&acc)[2][2][4][2], const Unit& u, int wr, int wc, int fr, int fq) const {
        asm volatile("" : "+v"(fr), "+v"(fq));
        typedef float f32x2s __attribute__((ext_vector_type(2)));
        PG8_LAS float* const sl = (PG8_LAS float*)xl; PG8_LAS float* const gl = (PG8_LAS float*)(xl + 8192);
        const int col0 = u.pn * BM + wc * 32 + 4 * fq, lc0 = wc * 32 + 4 * fq;
        { const int t = opaque_tid();
          if (t < 128) { const int which = t >> 6, c4 = 4 * (t & 63); *(PG8_LAS f32x4*)(gl + which * 256 + c4) = *(const f32x4*)((which ? cbeta : cg) + u.pn * BM + c4); } }
        u32x2e nb[4];
        { const size_t off = ((size_t)u.pm * BM + wr * 64 + fr) * ldc + col0;
#pragma unroll
          for (int q = 0; q < 4; ++q) nb[q] = *(const u32x2e*)(base16 + off + (q >> 1) * HALF + (q & 1) * 16); }
#pragma unroll
        for (int i = 0; i < 8; ++i) { const int ai = i >> 2, m = i & 3; const int lrow = ai * HALF + wr * 64 + m * 16 + fr;
            u32x2e cur[4];
#pragma unroll
            for (int q = 0; q < 4; ++q) cur[q] = nb[q];
            if (i < 7) { const int lr2 = ((i + 1) >> 2) * HALF + wr * 64 + ((i + 1) & 3) * 16 + fr; const size_t off2 = ((size_t)u.pm * BM + lr2) * ldc + col0;
#pragma unroll
                for (int q = 0; q < 4; ++q) nb[q] = *(const u32x2e*)(base16 + off2 + (q >> 1) * HALF + (q & 1) * 16); }
            asm volatile("" ::: "memory");
            float rsum = 0.f, rq = 0.f;
#pragma unroll
            for (int q = 0; q < 4; ++q) { const int bj = q >> 1, n = q & 1;
                const f32x4 y = dec(cur[q]) * alpha + acc[ai][bj][m][n];
                acc[ai][bj][m][n] = y;
                rsum += (y[0] + y[1]) + (y[2] + y[3]); rq += (y[0] * y[0] + y[1] * y[1]) + (y[2] * y[2] + y[3] * y[3]); }
            rsum += __shfl_xor(rsum, 16); rsum += __shfl_xor(rsum, 32); rq += __shfl_xor(rq, 16); rq += __shfl_xor(rq, 32);
            if (fq == 0) { sl[(lrow * 4 + wc) * 2] = rsum; sl[(lrow * 4 + wc) * 2 + 1] = rq; }
            asm volatile("" ::: "memory"); }
        asm volatile("s_waitcnt lgkmcnt(0)" ::: "memory"); __builtin_amdgcn_s_barrier(); asm volatile("" ::: "memory");
        const int t = opaque_tid();
        if (t < 256) { const f32x4 a = *(PG8_LAS const f32x4*)(sl + t * 8), b = *(PG8_LAS const f32x4*)(sl + t * 8 + 4);
            const float ssum = (a[0] + a[2]) + (b[0] + b[2]), ssq = (a[1] + a[3]) + (b[1] + b[3]);
            __hip_atomic_store((unsigned long long*)(st + ((size_t)u.pm * BM + t) * 8 + u.pn * 2), ((unsigned long long)__float_as_uint(ssq) << 32) | __float_as_uint(ssum), __ATOMIC_RELAXED, __HIP_MEMORY_SCOPE_AGENT); }
        asm volatile("s_waitcnt vmcnt(0) lgkmcnt(0)" ::: "memory"); __builtin_amdgcn_s_barrier(); asm volatile("" ::: "memory");
        if (t == 0) {
            unsigned* const ctr = gcnt + 64 * (blockIdx.x & 7); const unsigned target = tgt0 + 32u * (unsigned)((rev ? 3 - ((u.pm >> 3) & 3) : ((u.pm >> 3) & 3)) + 1);
            __hip_atomic_fetch_add(ctr, 1u, __ATOMIC_RELAXED, __HIP_MEMORY_SCOPE_AGENT);
            while (__hip_atomic_load(ctr, __ATOMIC_RELAXED, __HIP_MEMORY_SCOPE_AGENT) < target) __builtin_amdgcn_s_sleep(1);
        }
        __builtin_amdgcn_s_barrier(); asm volatile("" ::: "memory");
        if (t < 256) { const size_t row = (size_t)u.pm * BM + t;
            float s = 0.f, q = 0.f;
#pragma unroll
            for (int k4 = 0; k4 < 4; ++k4) { const unsigned long long w = __hip_atomic_load((const unsigned long long*)(st + row * 8 + 2 * k4), __ATOMIC_RELAXED, __HIP_MEMORY_SCOPE_AGENT);
                s += __uint_as_float((unsigned)w); q += __uint_as_float((unsigned)(w >> 32)); }
            const float mean = s * (1.f / 1024.f), rstd = 1.f / sqrtf(q * (1.f / 1024.f) - mean * mean + eps);
            *(PG8_LAS f32x2s*)(sl + 2 * t) = (f32x2s){mean, rstd}; }
        asm volatile("s_waitcnt lgkmcnt(0)" ::: "memory"); __builtin_amdgcn_s_barrier(); asm volatile("" ::: "memory");
#pragma unroll
        for (int i = 0; i < 8; ++i) { const int ai = i >> 2, m = i & 3; const int lrow = ai * HALF + wr * 64 + m * 16 + fr; const size_t off = ((size_t)u.pm * BM + lrow) * ldc + col0;
            const f32x2s mr = *(PG8_LAS const f32x2s*)(sl + 2 * lrow);
#pragma unroll
            for (int q = 0; q < 4; ++q) { const int bj = q >> 1, n = q & 1;
                const f32x4 g4 = *(PG8_LAS const f32x4*)(gl + lc0 + bj * HALF + n * 16), b4 = *(PG8_LAS const f32x4*)(gl + 256 + lc0 + bj * HALF + n * 16);
                const f32x4 o = (acc[ai][bj][m][n] - mr.x) * mr.y * g4 + b4;
                if (last) *(f32x4*)(out + off + bj * HALF + n * 16) = o;
                else { u32x2e w; w.x = cvt_pk_bf16(o[0], o[1]); w.y = cvt_pk_bf16(o[2], o[3]); *(u32x2e*)(hb + off + bj * HALF + n * 16) = w;
                    const h16x2 ha = {(_Float16)o[0], (_Float16)o[1]}, hc = {(_Float16)o[2], (_Float16)o[3]};
                    u32x2e w2; w2.x = __builtin_bit_cast(unsigned, ha); w2.y = __builtin_bit_cast(unsigned, hc); *(u32x2e*)(hf + off + bj * HALF + n * 16) = w2; } }
            asm volatile("" ::: "memory"); }
    }
};

template <class Epi, class Sched, bool ALIGN_EPI = false, bool SP2 = false>
__device__ __forceinline__ void gemm_phase(PG8_LAS unsigned char* lds, const Gemm g, const Sched& S, const Epi& E) {
    const int tid = opaque_tid(), wid = __builtin_amdgcn_readfirstlane(tid >> 6), lane = tid & 63, wr = wid >> 2, wc = wid & 3, fr = lane & 15, fq = lane >> 4;
    const int K = g.K, nt = K / BK;
    unsigned voffA[2], voffB[2];
#pragma unroll
    for (int i = 0; i < 2; ++i) { int R, C; stage_rc(tid * 16 + i * 8192, R, C); const int Rb = Epi::PERM ? ((R & ~31) + perm32(R & 31)) : R;
        voffA[i] = (unsigned)(R * K + C) * 2u; voffB[i] = (unsigned)(Rb * K + C) * 2u; }
    const size_t kstep = (size_t)(BK * 2);
    const size_t hstep = (size_t)HALF * K * 2;
    const size_t tstep = 2 * hstep;
    const unsigned ldsw = (unsigned)wid * 1024u;
    const int aoff = lds_byte(wr * 64 + fr, fq * 8), boff = lds_byte(wc * 32 + fr, fq * 8);
#define PG8_SA(b, h) (((b) * 2 + (h)) * HTB)
#define PG8_SB(b, h) ((4 + (b) * 2 + (h)) * HTB)
#define PG8_STAGE(bufoff, gbase, voff) do { _Pragma("unroll") for (int _i = 0; _i < 2; ++_i) \
        __builtin_amdgcn_global_load_lds((const unsigned*)((const char*)(gbase) + (voff)[_i]), (PG8_LAS unsigned*)(lds + (bufoff) + ldsw + _i * 8192), 16, 0, 0); } while (0)
#define PG8_LDA(dst, b, h) do { _Pragma("unroll") for (int m = 0; m < 4; ++m) _Pragma("unroll") for (int k = 0; k < 2; ++k) dst[m][k] = *(const PG8_LAS bf16x8*)(lds + PG8_SA(b, h) + aoff + m * 2048 + k * 1024); } while (0)
#define PG8_LDB(dst, b, h) do { _Pragma("unroll") for (int n = 0; n < 2; ++n) _Pragma("unroll") for (int k = 0; k < 2; ++k) dst[n][k] = *(const PG8_LAS bf16x8*)(lds + PG8_SB(b, h) + boff + n * 2048 + k * 1024); } while (0)
#define PG8_MMA(ai, bj, At, Bt) do { __builtin_amdgcn_s_setprio(1); _Pragma("unroll") for (int m = 0; m < 4; ++m) _Pragma("unroll") for (int n = 0; n < 2; ++n) _Pragma("unroll") for (int k = 0; k < 2; ++k) \
        acc[ai][bj][m][n] = __builtin_amdgcn_mfma_f32_16x16x32_bf16(Bt[n][k], At[m][k], acc[ai][bj][m][n], 0, 0, 0); __builtin_amdgcn_s_setprio(0); } while (0)
#define PG8_WAIT_V(n) asm volatile("s_waitcnt vmcnt(" #n ")" ::: "memory")
#define PG8_WAIT_L(n) asm volatile("s_waitcnt lgkmcnt(" #n ")" ::: "memory")
#define PG8_BAR __builtin_amdgcn_s_barrier()
#define PG8_SCHED __builtin_amdgcn_sched_barrier(0)
    Unit cur, nxt; int ui = 0;
    if (!S.next(0, cur)) return;
    f32x4 acc[2][2][4][2];
#pragma unroll
    for (int a = 0; a < 2; ++a)
#pragma unroll
        for (int b = 0; b < 2; ++b)
#pragma unroll
            for (int m = 0; m < 4; ++m)
#pragma unroll
                for (int n = 0; n < 2; ++n) acc[a][b][m][n] = (f32x4){0.f, 0.f, 0.f, 0.f};
    bf16x8 At[4][2], B0[2][2], B1[2][2];
    const char* cA = (const char*)g.A + (size_t)cur.pm * tstep; const char* cB = (const char*)g.Bt + (size_t)cur.pn * tstep;
    S.a_ready(cur);
    if constexpr (SP2) {
        PG8_STAGE(PG8_SB(0, 0), cB, voffB); PG8_STAGE(PG8_SB(0, 1), cB + hstep, voffB); PG8_STAGE(PG8_SA(0, 0), cA, voffA); PG8_STAGE(PG8_SA(0, 1), cA + hstep, voffA);
        if (wr == 1) PG8_BAR;
        PG8_WAIT_V(2); PG8_BAR;
        PG8_STAGE(PG8_SB(1, 0), cB + kstep, voffB); PG8_STAGE(PG8_SA(1, 0), cA + kstep, voffA); PG8_STAGE(PG8_SB(1, 1), cB + hstep + kstep, voffB);
        PG8_WAIT_V(6); PG8_BAR;
    } else {
        PG8_STAGE(PG8_SB(0, 0), cB, voffB); PG8_STAGE(PG8_SA(0, 0), cA, voffA); PG8_STAGE(PG8_SB(0, 1), cB + hstep, voffB); PG8_STAGE(PG8_SA(0, 1), cA + hstep, voffA);
        if (wr == 1) PG8_BAR;
        PG8_WAIT_V(4); PG8_BAR;
        PG8_STAGE(PG8_SB(1, 0), cB + kstep, voffB); PG8_STAGE(PG8_SA(1, 0), cA + kstep, voffA); PG8_STAGE(PG8_SB(1, 1), cB + hstep + kstep, voffB);
        PG8_WAIT_V(6); PG8_BAR;
    }
    for (;;) {
        const bool has_next = S.next(ui + 1, nxt);
        const char* nA = has_next ? (const char*)g.A + (size_t)nxt.pm * tstep : cA; const char* nB = has_next ? (const char*)g.Bt + (size_t)nxt.pn * tstep : cB;
        for (int t = 0; t < nt; t += 2) {
            const bool last = (t == nt - 2);
            const char* a1 = cA + (size_t)(t + 1) * kstep;
            const char* a2 = last ? nA : cA + (size_t)(t + 2) * kstep; const char* b2 = last ? nB : cB + (size_t)(t + 2) * kstep;
            const char* a3 = a2 + kstep; const char* b3 = b2 + kstep;
            if (last && has_next) S.a_ready(nxt);
            if constexpr (SP2) {
            PG8_LDB(B0, 0, 0); PG8_LDB(B1, 0, 1); PG8_SCHED; PG8_LDA(At, 0, 0); PG8_STAGE(PG8_SA(1, 1), a1 + hstep, voffA);
            PG8_WAIT_V(8); PG8_WAIT_L(0); PG8_BAR; PG8_MMA(0, 0, At, B0); PG8_MMA(0, 1, At, B1); PG8_BAR; PG8_SCHED;
            PG8_LDA(At, 0, 1); PG8_STAGE(PG8_SB(0, 0), b2, voffB); PG8_STAGE(PG8_SB(0, 1), b2 + hstep, voffB); PG8_STAGE(PG8_SA(0, 0), a2, voffA);
            PG8_WAIT_V(8); PG8_WAIT_L(0); PG8_BAR; PG8_MMA(1, 0, At, B0); PG8_MMA(1, 1, At, B1); PG8_BAR; PG8_SCHED;
            PG8_LDB(B0, 1, 0); PG8_LDB(B1, 1, 1); PG8_SCHED; PG8_LDA(At, 1, 0); PG8_STAGE(PG8_SA(0, 1), a2 + hstep, voffA);
            PG8_WAIT_V(8); PG8_WAIT_L(0); PG8_BAR; PG8_MMA(0, 0, At, B0); PG8_MMA(0, 1, At, B1); PG8_BAR; PG8_SCHED;
            PG8_LDA(At, 1, 1); PG8_STAGE(PG8_SB(1, 0), b3, voffB); PG8_STAGE(PG8_SB(1, 1), b3 + hstep, voffB); PG8_STAGE(PG8_SA(1, 0), a3, voffA);
            PG8_WAIT_V(8); PG8_WAIT_L(0); PG8_BAR; PG8_MMA(1, 0, At, B0); PG8_MMA(1, 1, At, B1); PG8_BAR; PG8_SCHED;
            } else {
            PG8_LDB(B0, 0, 0); PG8_SCHED; PG8_LDA(At, 0, 0); PG8_STAGE(PG8_SA(1, 1), a1 + hstep, voffA);
            PG8_WAIT_L(8); PG8_BAR; PG8_WAIT_L(0); PG8_MMA(0, 0, At, B0); PG8_BAR; PG8_SCHED;
            PG8_LDB(B1, 0, 1); PG8_STAGE(PG8_SB(0, 0), b2, voffB);
            PG8_BAR; PG8_WAIT_L(0); PG8_MMA(0, 1, At, B1); PG8_BAR;
            PG8_LDA(At, 0, 1); PG8_STAGE(PG8_SA(0, 0), a2, voffA);
            PG8_BAR; PG8_WAIT_L(0); PG8_MMA(1, 0, At, B0); PG8_BAR; PG8_SCHED;
            PG8_STAGE(PG8_SB(0, 1), b2 + hstep, voffB);
            PG8_WAIT_V(6); PG8_BAR; PG8_MMA(1, 1, At, B1); PG8_BAR;
            PG8_LDB(B0, 1, 0); PG8_SCHED; PG8_LDA(At, 1, 0); PG8_STAGE(PG8_SA(0, 1), a2 + hstep, voffA);
            PG8_WAIT_L(8); PG8_BAR; PG8_WAIT_L(0); PG8_MMA(0, 0, At, B0); PG8_BAR; PG8_SCHED;
            PG8_LDB(B1, 1, 1); PG8_STAGE(PG8_SB(1, 0), b3, voffB);
            PG8_BAR; PG8_WAIT_L(0); PG8_MMA(0, 1, At, B1); PG8_BAR;
            PG8_LDA(At, 1, 1); PG8_STAGE(PG8_SA(1, 0), a3, voffA);
            PG8_BAR; PG8_WAIT_L(0); PG8_MMA(1, 0, At, B0); PG8_BAR; PG8_SCHED;
            PG8_STAGE(PG8_SB(1, 1), b3 + hstep, voffB);
            PG8_WAIT_V(6); PG8_BAR; PG8_MMA(1, 1, At, B1); PG8_BAR;
            }
        }
        if constexpr (ALIGN_EPI) { if (wr == 0) PG8_BAR; }
        if constexpr (!Epi::AFTER_DRAIN) { E(acc, cur, wr, wc, fr, fq); S.done(cur); }
        if (!has_next) break;
#pragma unroll
        for (int a = 0; a < 2; ++a)
#pragma unroll
            for (int b = 0; b < 2; ++b)
#pragma unroll
                for (int m = 0; m < 4; ++m)
#pragma unroll
                    for (int n = 0; n < 2; ++n) acc[a][b][m][n] = (f32x4){0.f, 0.f, 0.f, 0.f};
        cur = nxt; cA = nA; cB = nB; ++ui;
        if constexpr (ALIGN_EPI) { if (wr == 1) PG8_BAR; }
    }
    PG8_WAIT_V(0);
    if constexpr (!ALIGN_EPI) { if (wr == 0) PG8_BAR; }
    PG8_BAR;
    if constexpr (Epi::AFTER_DRAIN) { E.fused(acc, cur, wr, wc, fr, fq, lds, wid, lane); S.done(cur); }
#undef PG8_SA
#undef PG8_SB
#undef PG8_STAGE
#undef PG8_LDA
#undef PG8_LDB
#undef PG8_MMA
#undef PG8_WAIT_V
#undef PG8_WAIT_L
#undef PG8_BAR
#undef PG8_SCHED
}
}

constexpr int NB = 32, SEQ = 2048, DM = 1024, NTOK = NB * SEQ;
constexpr int NH = 16, HD = 64, GW = 2048, GG = 8, GC = 128, FF = 2816, FF2 = 5632, DEPTH = 4;
constexpr float LN_EPS = 1e-5f;
constexpr float DN_ALPHA = 1.681792830507429f;
constexpr int HALF_TOK = NTOK / 2;

constexpr size_t MiB = 1u << 20;
constexpr size_t WS_ATTN_IN = 0, WS_ATTN_OUT = 12 * MiB, WS_GMLP_IN = 16 * MiB, WS_GMLP_OUT = 32 * MiB, WS_FFN_UP = 40 * MiB, WS_FFN_DOWN = 84 * MiB, WS_WS = 106 * MiB;
constexpr size_t WS_MS = 110 * MiB;
constexpr size_t WS_CTL = 107 * MiB;
constexpr size_t WS_ST = 108 * MiB;
constexpr size_t WS_HB = 112 * MiB;
constexpr size_t WS_R = 240 * MiB;
constexpr size_t WS_Q = WS_R, WS_K = WS_R + 128 * MiB, WS_V = WS_R + 256 * MiB, WS_O = WS_R + 384 * MiB;
constexpr size_t WS_ZZ = WS_R, WS_GT = WS_R + 512 * MiB;
constexpr size_t WS_HT = WS_R + 400 * MiB;
constexpr size_t WS_G = WS_R;
constexpr size_t WS_END = 1008 * MiB;

constexpr int LDS_BYTES = 147456;

#define LAS __attribute__((address_space(3)))
typedef unsigned short bf16;
typedef unsigned u32x4 __attribute__((ext_vector_type(4)));
typedef unsigned u32x2 __attribute__((ext_vector_type(2)));
typedef float f32x4 __attribute__((ext_vector_type(4)));
typedef float f32x16 __attribute__((ext_vector_type(16)));
typedef short bf16x8 __attribute__((ext_vector_type(8)));
typedef short s16x4 __attribute__((ext_vector_type(4)));

__device__ __forceinline__ unsigned pk2(float lo, float hi) { return pg8::cvt_pk_bf16(lo, hi); }
__device__ __forceinline__ float bflo(unsigned w) { return __uint_as_float(w << 16); }
__device__ __forceinline__ float bfhi(unsigned w) { return __uint_as_float(w & 0xffff0000u); }
__device__ __forceinline__ float wave_sum(float v) {
#pragma unroll
    for (int o = 1; o < 64; o <<= 1) v += __shfl_xor(v, o);
    return v;
}
__device__ __forceinline__ s16x4 vtr(LAS const unsigned char* p) { return __builtin_bit_cast(s16x4, __builtin_amdgcn_ds_read_tr16_b64_v4i16((LAS s16x4*)p)); }

__device__ __forceinline__ void transpose_item(const float* W, int K, int N, bf16* WT, int perm, LAS float* scr, int item, int lane) {
    const int nblk = N / 32, kb = item / nblk, nb = item % nblk, k0 = 64 * kb, n0 = 32 * nb;
    int r0 = n0;
    if (perm) { const int bj = n0 / FF, f0 = n0 - bj * FF; r0 = (f0 >> 7) * 256 + bj * 128 + (f0 & 127); }
#pragma unroll 8
    for (int i = 0; i < 32; ++i) { const int kk = 2 * i + (lane >> 5); scr[kk * 33 + (lane & 31)] = W[(size_t)(k0 + kk) * N + n0 + (lane & 31)]; }
    asm volatile("s_waitcnt lgkmcnt(0)" ::: "memory");
    const int c = lane & 7;
#pragma unroll
    for (int j = 0; j < 4; ++j) { const int n = (lane >> 3) + 8 * j; const LAS float* s = scr + (8 * c) * 33 + n;
        u32x4 o; o.x = pk2(s[0 * 33], s[1 * 33]); o.y = pk2(s[2 * 33], s[3 * 33]); o.z = pk2(s[4 * 33], s[5 * 33]); o.w = pk2(s[6 * 33], s[7 * 33]);
        *(u32x4*)(WT + (size_t)(r0 + n) * K + k0 + 8 * c) = o; }
    asm volatile("s_waitcnt lgkmcnt(0)" ::: "memory");
}

struct Args { const float* in[17]; float* out; unsigned char* ws; };

__device__ __forceinline__ void ln_apply(const float* Y, float* Yo, bf16* HB, const float* st, float* ms, const float* gam, const float* bet, int gw, int ngw, int lane) {
    f32x4 g4[4], b4[4];
#pragma unroll
    for (int j = 0; j < 4; ++j) { g4[j] = ((const f32x4*)gam)[lane + 64 * j]; b4[j] = ((const f32x4*)bet)[lane + 64 * j]; }
    for (int m = gw; m < NTOK; m += ngw) {
        const f32x4* yr = (const f32x4*)(Y + (size_t)m * DM) + lane;
        f32x4 v[4];
#pragma unroll
        for (int j = 0; j < 4; ++j) v[j] = yr[64 * j];
        const f32x4 a = *(const f32x4*)(st + (size_t)m * 8), b = *(const f32x4*)(st + (size_t)m * 8 + 4);
        const float s = (a[0] + a[2]) + (b[0] + b[2]), q = (a[1] + a[3]) + (b[1] + b[3]);
        const float mean = s * (1.f / DM), rstd = 1.f / sqrtf(q * (1.f / DM) - mean * mean + LN_EPS);
        if (lane == 0) { ms[(size_t)m * 2] = mean; ms[(size_t)m * 2 + 1] = rstd; }
        u32x2* o8 = (u32x2*)(HB + (size_t)m * DM) + lane;
#pragma unroll
        for (int j = 0; j < 4; ++j) { const f32x4 o = (v[j] - mean) * rstd * g4[j] + b4[j]; if (Yo) ((f32x4*)(Yo + (size_t)m * DM) + lane)[64 * j] = o; u32x2 w; w.x = pk2(o.x, o.y); w.y = pk2(o.z, o.w); o8[64 * j] = w; }
    }
}

__device__ __forceinline__ void ffn_fix_phase(const float* HT, bf16* Gb, const float* cw, const float* cb, int cu, int G, int tid) {
    const int sub = tid >> 6, r = (tid >> 5) & 1, f = (tid & 31) * 4;
    for (int up = cu * 8 + sub; up < 224 * 22; up += G * 8) {
        const int pn = up % 22, pq = up / 22, pm = pq + pq / 7 + 1;
        const float* hc = HT + (size_t)(pm * 22 + pn) * 1024; const float* hp = HT + (size_t)((pm - 1) * 22 + pn) * 1024;
        f32x4 y[2];
#pragma unroll
        for (int hh = 0; hh < 2; ++hh) { const int c = hh * 128 + f; const int F = hh * FF + 128 * pn + f;
            const f32x4 h0 = *(const f32x4*)(hc + c), h1 = *(const f32x4*)(hc + 256 + c), t0 = *(const f32x4*)(hp + 512 + c), t1 = *(const f32x4*)(hp + 768 + c);
            const f32x4 x0 = r ? h1 : h0, xm1 = r ? h0 : t1, xm2 = r ? t1 : t0;
            y[hh] = *(const f32x4*)(cb + F) + *(const f32x4*)(cw + F) * xm2 + *(const f32x4*)(cw + FF2 + F) * xm1 + *(const f32x4*)(cw + 2 * FF2 + F) * x0; }
        float v[4];
#pragma unroll
        for (int e = 0; e < 4; ++e) v[e] = y[0][e] * __builtin_amdgcn_rcpf(1.0f + __builtin_amdgcn_exp2f(-1.4426950408889634f * y[0][e])) * y[1][e];
        u32x2 w; w.x = pk2(v[0], v[1]); w.y = pk2(v[2], v[3]);
        *(u32x2*)(Gb + (size_t)(pm * 256 + r) * FF + 128 * pn + f) = w;
    }
}

__device__ __forceinline__ void attn_phase(LAS unsigned char* lds, const bf16* Q, const bf16* K, const bf16* V, bf16* O, int cu, int G, int rev) {
    const int tid = opaque_tid(), lane = tid & 63, wid = __builtin_amdgcn_readfirstlane(tid >> 6), q32 = lane & 31, hi = lane >> 5, li = lane & 15;
    LAS unsigned char* Ks = lds + wid * 10752;
    LAS unsigned char* Vs = Ks + 4608;
    const int lkey = lane >> 3, lch = lane & 7;
    const float LOG2E = 1.4426950408889634f;
    for (int k = 0; k < 16; ++k) {
        const int idx = cu * 8 + wid + 2048 * (k & 3), b = 4 * (idx & 7) + (rev ? 3 - (k >> 2) : (k >> 2)), h = (idx >> 3) & 15, qb = idx >> 7;
        const size_t rowbase = (size_t)b * SEQ;
        const int q0w = qb * 32;
        bf16x8 qf[4];
        { const bf16* qp = Q + (rowbase + q0w + q32) * DM + h * HD + hi * 8;
#pragma unroll
          for (int ks = 0; ks < 4; ++ks) qf[ks] = *(const bf16x8*)(qp + ks * 16); }
        f32x16 o0, o1;
#pragma unroll
        for (int r = 0; r < 16; ++r) { o0[r] = 0.f; o1[r] = 0.f; }
        float R = 0.f;
        const bf16* kp = K + (rowbase + lkey) * DM + h * HD + lch * 8;
        const bf16* vp = V + (rowbase + lkey) * DM + h * HD + lch * 8;
        u32x4 kr[4], vr[4];
#pragma unroll
        for (int jj = 0; jj < 4; ++jj) { kr[jj] = *(const u32x4*)(kp + (size_t)(q0w + 8 * jj) * DM); vr[jj] = *(const u32x4*)(vp + (size_t)(q0w + 8 * jj) * DM); }
        for (int key0 = q0w; key0 >= 0; key0 -= 32) {
#pragma unroll
            for (int jj = 0; jj < 4; ++jj) { *(LAS u32x4*)(Ks + (lkey + 8 * jj) * 144 + lch * 16) = kr[jj]; *(LAS u32x4*)(Vs + (lkey + 8 * jj) * 192 + lch * 16) = vr[jj]; }
            asm volatile("s_waitcnt lgkmcnt(0)" ::: "memory");
            if (key0 >= 32) {
#pragma unroll
                for (int jj = 0; jj < 4; ++jj) { kr[jj] = *(const u32x4*)(kp + (size_t)(key0 - 32 + 8 * jj) * DM); vr[jj] = *(const u32x4*)(vp + (size_t)(key0 - 32 + 8 * jj) * DM); } }
            const bool diag = (key0 == q0w);
            f32x16 s;
#pragma unroll
            for (int r = 0; r < 16; ++r) s[r] = 0.f;
#pragma unroll
            for (int ks = 0; ks < 4; ++ks) { const bf16x8 kf = *(LAS const bf16x8*)(Ks + q32 * 144 + (16 * ks + 8 * hi) * 2);
                s = __builtin_amdgcn_mfma_f32_32x32x16_bf16(kf, qf[ks], s, 0, 0, 0); }
            float zs[16], l1[16];
#pragma unroll
            for (int r = 0; r < 16; ++r) { const float z = s[r] * LOG2E; const float e = __builtin_amdgcn_exp2f(-__builtin_fabsf(z)); const float t = __builtin_amdgcn_logf(1.0f + e);
                float l = -(__builtin_fmaxf(z, 0.f) + t);
                if (diag) { const int kl = 8 * (r >> 2) + 4 * hi + (r & 3); if (kl >= q32) l = 0.f; }
                zs[r] = z; l1[r] = l; }
            float G0[4], G1[4];
#pragma unroll
            for (int j = 0; j < 4; ++j) { const float gs = (l1[4 * j] + l1[4 * j + 1]) + (l1[4 * j + 2] + l1[4 * j + 3]);
                auto rr = __builtin_amdgcn_permlane32_swap(__float_as_uint(gs), __float_as_uint(gs), false, false); G0[j] = __uint_as_float(rr[0]); G1[j] = __uint_as_float(rr[1]); }
            float p[16]; float run = R;
#pragma unroll
            for (int j = 3; j >= 0; --j) { float sfx = run + (hi == 0 ? G1[j] : 0.f);
#pragma unroll
                for (int e = 3; e >= 0; --e) { const int r = 4 * j + e; float val = __builtin_amdgcn_exp2f(l1[r] + zs[r] + sfx);
                    if (diag) { const int kl = 8 * j + 4 * hi + e; if (kl >= q32) val = 0.f; }
                    p[r] = val; sfx += l1[r]; }
                run += G0[j] + G1[j]; }
            R = run;
#pragma unroll
            for (int ks2 = 0; ks2 < 2; ++ks2) {
                u32x4 pw; pw.x = pk2(p[8 * ks2], p[8 * ks2 + 1]); pw.y = pk2(p[8 * ks2 + 2], p[8 * ks2 + 3]); pw.z = pk2(p[8 * ks2 + 4], p[8 * ks2 + 5]); pw.w = pk2(p[8 * ks2 + 6], p[8 * ks2 + 7]);
                const bf16x8 pb = __builtin_bit_cast(bf16x8, pw);
#pragma unroll
                for (int dh = 0; dh < 2; ++dh) {
                    LAS const unsigned char* va = Vs + (16 * ks2 + 4 * hi + (li >> 2)) * 192 + (32 * dh + 16 * ((lane >> 4) & 1) + 4 * (li & 3)) * 2;
                    const s16x4 lo = vtr(va), hi4 = vtr(va + 8 * 192);
                    const bf16x8 vf = (bf16x8){lo[0], lo[1], lo[2], lo[3], hi4[0], hi4[1], hi4[2], hi4[3]};
                    if (dh == 0) o0 = __builtin_amdgcn_mfma_f32_32x32x16_bf16(vf, pb, o0, 0, 0, 0);
                    else         o1 = __builtin_amdgcn_mfma_f32_32x32x16_bf16(vf, pb, o1, 0, 0, 0);
                }
            }
            asm volatile("s_waitcnt lgkmcnt(0)" ::: "memory");
            if (__all(R < -150.0f)) break;
        }
        bf16* op = O + (rowbase + q0w + q32) * DM + h * HD + 4 * hi;
#pragma unroll
        for (int j = 0; j < 4; ++j) { u32x2 w0, w1; w0.x = pk2(o0[4 * j], o0[4 * j + 1]); w0.y = pk2(o0[4 * j + 2], o0[4 * j + 3]); w1.x = pk2(o1[4 * j], o1[4 * j + 1]); w1.y = pk2(o1[4 * j + 2], o1[4 * j + 3]);
            *(u32x2*)(op + 8 * j) = w0; *(u32x2*)(op + 32 + 8 * j) = w1; }
    }
    __syncthreads();
}

__device__ __forceinline__ void spatial_phase(LAS unsigned char* lds, const bf16* ZZ, bf16* GT, const bf16* Wc, const float* bs, const float* gam, const float* bet, int cu, int G, int rev) {
    const int tid = opaque_tid(), lane = tid & 63, wid = __builtin_amdgcn_readfirstlane(tid >> 6), fr = lane & 15, kg = lane >> 4;
    LAS float* st = (LAS float*)(lds + 69632);
    const int wr = wid >> 2, wc = wid & 3;
    for (int k = 0; k < 2; ++k) {
        const int cls = 2 * k + (cu >> 7); const int chunk = 64 * (cu & 7) + 16 * (rev ? 3 - cls : cls) + ((cu >> 3) & 15);
        const size_t row0 = (size_t)chunk * GC;
        __syncthreads();
        for (int i0 = 0; i0 < 16; i0 += 4) {
            u32x4 w[4][4]; float s[4], mean[4], s2[4];
#pragma unroll
            for (int rr = 0; rr < 4; ++rr) { const bf16* vr = ZZ + (row0 + 16 * wid + i0 + rr) * 4096 + GW;
#pragma unroll
                for (int j = 0; j < 4; ++j) w[rr][j] = *(const u32x4*)(vr + (lane + 64 * j) * 8); }
#pragma unroll
            for (int rr = 0; rr < 4; ++rr) { float a = 0.f;
#pragma unroll
                for (int j = 0; j < 4; ++j)
#pragma unroll
                    for (int e = 0; e < 4; ++e) a += bflo(w[rr][j][e]) + bfhi(w[rr][j][e]);
                s[rr] = a; }
#pragma unroll
            for (int rr = 0; rr < 4; ++rr) mean[rr] = wave_sum(s[rr]) * (1.f / GW);
#pragma unroll
            for (int rr = 0; rr < 4; ++rr) { float a = 0.f;
#pragma unroll
                for (int j = 0; j < 4; ++j)
#pragma unroll
                    for (int e = 0; e < 4; ++e) { const float d0 = bflo(w[rr][j][e]) - mean[rr], d1 = bfhi(w[rr][j][e]) - mean[rr]; a += d0 * d0 + d1 * d1; }
                s2[rr] = a; }
#pragma unroll
            for (int rr = 0; rr < 4; ++rr) { const float rstd = 1.f / sqrtf(wave_sum(s2[rr]) * (1.f / GW) + LN_EPS); const int r = 16 * wid + i0 + rr;
                if (lane == 0) { st[2 * r] = mean[rr]; st[2 * r + 1] = rstd; } }
        }
        const int c8 = tid & 31, srow = tid >> 5;
        LAS unsigned char* const wl = lds + 72704;
        const int wt = tid >> 2, wq = tid & 3;
        u32x4 nv[8], nw[4];
#pragma unroll
        for (int it = 0; it < 8; ++it) nv[it] = *(const u32x4*)(ZZ + (row0 + it * 16 + srow) * 4096 + GW + c8 * 8);
#pragma unroll
        for (int q = 0; q < 4; ++q) nw[q] = *(const u32x4*)(Wc + (size_t)wt * GC + wq * 32 + q * 8);
        for (int g = 0; g < GG; ++g) {
            __syncthreads();
            { const float* gp = gam + g * 256 + c8 * 8; const float* bp = bet + g * 256 + c8 * 8;
              const f32x4 ga = *(const f32x4*)gp, gb = *(const f32x4*)(gp + 4), ba = *(const f32x4*)bp, bb = *(const f32x4*)(bp + 4);
#pragma unroll
              for (int q = 0; q < 4; ++q) *(LAS u32x4*)(wl + wt * 272 + wq * 64 + q * 16) = nw[q];
#pragma unroll
              for (int it = 0; it < 8; ++it) { const int s = it * 16 + srow;
                  const u32x4 w = nv[it];
                  const float mean = st[2 * s], rstd = st[2 * s + 1];
                  u32x4 o;
                  o.x = pk2((bflo(w.x) - mean) * rstd * ga.x + ba.x, (bfhi(w.x) - mean) * rstd * ga.y + ba.y);
                  o.y = pk2((bflo(w.y) - mean) * rstd * ga.z + ba.z, (bfhi(w.y) - mean) * rstd * ga.w + ba.w);
                  o.z = pk2((bflo(w.z) - mean) * rstd * gb.x + bb.x, (bfhi(w.z) - mean) * rstd * gb.y + bb.y);
                  o.w = pk2((bflo(w.w) - mean) * rstd * gb.z + bb.z, (bfhi(w.w) - mean) * rstd * gb.w + bb.w);
                  *(LAS u32x4*)(lds + s * 544 + c8 * 16) = o; } }
            __syncthreads();
            if (g + 1 < GG) {
#pragma unroll
                for (int it = 0; it < 8; ++it) nv[it] = *(const u32x4*)(ZZ + (row0 + it * 16 + srow) * 4096 + GW + (g + 1) * 256 + c8 * 8);
#pragma unroll
                for (int q = 0; q < 4; ++q) nw[q] = *(const u32x4*)(Wc + (size_t)(g + 1) * GC * GC + (size_t)wt * GC + wq * 32 + q * 8); }
            u32x2 uu[4][4];
#pragma unroll
            for (int tb = 0; tb < 4; ++tb)
#pragma unroll
                for (int cb = 0; cb < 4; ++cb) uu[tb][cb] = *(const u32x2*)(ZZ + (row0 + 64 * wr + 16 * tb + fr) * 4096 + g * 256 + 64 * wc + 16 * cb + 4 * kg);
            f32x4 acc[4][4];
#pragma unroll
            for (int a = 0; a < 4; ++a)
#pragma unroll
                for (int b2 = 0; b2 < 4; ++b2) acc[a][b2] = (f32x4){0.f, 0.f, 0.f, 0.f};
#pragma unroll
            for (int ks = 0; ks < 4; ++ks) {
                if (32 * ks <= 64 * wr + 63) {
                    bf16x8 X[4], Y[4];
#pragma unroll
                    for (int tb = 0; tb < 4; ++tb) { LAS const unsigned char* wp = wl + (64 * wr + 16 * tb + fr) * 272 + (32 * ks + 4 * kg) * 2;
                        const u32x2 a = *(LAS const u32x2*)wp, b2 = *(LAS const u32x2*)(wp + 32); const u32x4 w = (u32x4){a.x, a.y, b2.x, b2.y}; Y[tb] = __builtin_bit_cast(bf16x8, w); }
#pragma unroll
                    for (int cb = 0; cb < 4; ++cb) { LAS const unsigned char* xa = lds + (32 * ks + 4 * kg + (fr >> 2)) * 544 + (64 * wc + 16 * cb + 4 * (fr & 3)) * 2;
                        const s16x4 lo = vtr(xa), hi4 = vtr(xa + 16 * 544);
                        X[cb] = (bf16x8){lo[0], lo[1], lo[2], lo[3], hi4[0], hi4[1], hi4[2], hi4[3]}; }
#pragma unroll
                    for (int tb = 0; tb < 4; ++tb)
#pragma unroll
                        for (int cb = 0; cb < 4; ++cb) acc[tb][cb] = __builtin_amdgcn_mfma_f32_16x16x32_bf16(X[cb], Y[tb], acc[tb][cb], 0, 0, 0);
                }
            }
#pragma unroll
            for (int tb = 0; tb < 4; ++tb) { const int t = 64 * wr + 16 * tb + fr; const float bsv = bs[g * GC + t];
#pragma unroll
                for (int cb = 0; cb < 4; ++cb) { const int c = g * 256 + 64 * wc + 16 * cb + 4 * kg;
                    const u32x2 u = uu[tb][cb];
                    u32x2 o; o.x = pk2(bflo(u.x) * (acc[tb][cb][0] + bsv), bfhi(u.x) * (acc[tb][cb][1] + bsv)); o.y = pk2(bflo(u.y) * (acc[tb][cb][2] + bsv), bfhi(u.y) * (acc[tb][cb][3] + bsv));
                    *(u32x2*)(GT + (row0 + t) * GW + c) = o; } }
        }
    }
}

#ifndef PROBE
#define PROBE 0
#endif
#ifndef G2_REV
#define G2_REV 1
#endif
__device__ __forceinline__ void gbar(unsigned* ctr, unsigned target) {
    asm volatile("s_waitcnt vmcnt(0)" ::: "memory");
    __syncthreads();
    if (threadIdx.x == 0) {
        __builtin_amdgcn_fence(__ATOMIC_RELEASE, "agent");
        asm volatile("s_waitcnt vmcnt(0)" ::: "memory");
        __hip_atomic_fetch_add(ctr, 1u, __ATOMIC_RELAXED, __HIP_MEMORY_SCOPE_AGENT);
        while (__hip_atomic_load(ctr, __ATOMIC_RELAXED, __HIP_MEMORY_SCOPE_AGENT) < target) __builtin_amdgcn_s_sleep(1);
        __builtin_amdgcn_fence(__ATOMIC_ACQUIRE, "agent");
        asm volatile("s_waitcnt vmcnt(0)" ::: "memory");
    }
    __syncthreads();
}
#define GSYNC() do { bar_target += (unsigned)G; gbar(bar_ctr, bar_target); if (PROBE == 7) { bar_target += (unsigned)G; gbar(bar_ctr, bar_target); } } while (0)
__global__ void __launch_bounds__(512, 2) fwd_kernel(Args args) {
    extern __shared__ __attribute__((aligned(16))) unsigned char lds_raw[];
    cg::grid_group grid = cg::this_grid();
    LAS unsigned char* lds = (LAS unsigned char*)lds_raw;
    const int G = gridDim.x, cu = blockIdx.x, ngw = G * 8;
    unsigned char* ws = args.ws;
    const float* x = args.in[0];
    float* out = args.out;
    bf16* HB = (bf16*)(ws + WS_HB);
    unsigned* bar_ctr = (unsigned*)(ws + WS_CTL); unsigned bar_target = 0u;
    if (cu == 0 && threadIdx.x < 8) __hip_atomic_store((unsigned*)(ws + WS_CTL + 8192) + 64 * threadIdx.x, 0u, __ATOMIC_RELAXED, __HIP_MEMORY_SCOPE_AGENT);
    if (cu == 0 && threadIdx.x == 0) __hip_atomic_store(bar_ctr, 0u, __ATOMIC_RELAXED, __HIP_MEMORY_SCOPE_AGENT);

    for (int rep = 0; rep < (PROBE == 8 ? 2 : 1); ++rep) {
        const int tid = opaque_tid(), lane = tid & 63, wave = __builtin_amdgcn_readfirstlane(tid >> 6), gw = cu * 8 + wave;
        LAS float* scr = (LAS float*)(lds + wave * 16384);
        for (int mat = 0; mat < 16; ++mat) {
            const float* W; bf16* WT; int K, N, perm = 0;
            if (mat < 2)       { W = args.in[1] + (size_t)mat * DM * 3072;        WT = (bf16*)(ws + WS_ATTN_IN) + (size_t)mat * 3072 * DM;        K = DM; N = 3072; }
            else if (mat < 4)  { W = args.in[2] + (size_t)(mat - 2) * DM * DM;    WT = (bf16*)(ws + WS_ATTN_OUT) + (size_t)(mat - 2) * DM * DM;   K = DM; N = DM; }
            else if (mat < 6)  { W = args.in[3] + (size_t)(mat - 4) * DM * 4096;  WT = (bf16*)(ws + WS_GMLP_IN) + (size_t)(mat - 4) * 4096 * DM;  K = DM; N = 4096; }
            else if (mat < 8)  { W = args.in[8] + (size_t)(mat - 6) * GW * DM;    WT = (bf16*)(ws + WS_GMLP_OUT) + (size_t)(mat - 6) * DM * GW;   K = GW; N = DM; }
            else if (mat < 12) { W = args.in[9] + (size_t)(mat - 8) * DM * FF2;   WT = (bf16*)(ws + WS_FFN_UP) + (size_t)(mat - 8) * FF2 * DM;    K = DM; N = FF2; perm = 1; }
            else               { W = args.in[12] + (size_t)(mat - 12) * FF * DM;  WT = (bf16*)(ws + WS_FFN_DOWN) + (size_t)(mat - 12) * DM * FF;  K = FF; N = DM; }
            const int nitems = (K / 64) * (N / 32);
            for (int it = gw; it < nitems; it += ngw) transpose_item(W, K, N, WT, perm, scr, it, lane);
        }
        { const float* wsrc = args.in[6]; bf16* wd = (bf16*)(ws + WS_WS);
          for (int i = cu * 512 + tid; i < 2 * GG * GC * GC; i += G * 512) { const int s = i & 127, t = (i >> 7) & 127; const float v = (s <= t) ? wsrc[i] : 0.f; wd[i] = (bf16)(pk2(v, v) & 0xffffu); } }
        for (int m = gw; m < NTOK; m += ngw) {
            const f32x4* xr = (const f32x4*)(x + (size_t)m * DM) + lane; u32x2* o8 = (u32x2*)(HB + (size_t)m * DM) + lane;
#pragma unroll
            for (int j = 0; j < 4; ++j) { const f32x4 v = xr[64 * j]; u32x2 w; w.x = pk2(v.x, v.y); w.y = pk2(v.z, v.w); o8[64 * j] = w;
                typedef _Float16 h16x2 __attribute__((ext_vector_type(2))); const h16x2 ha = {(_Float16)v.x, (_Float16)v.y}, hc = {(_Float16)v.z, (_Float16)v.w};
                u32x2 w2; w2.x = __builtin_bit_cast(unsigned, ha); w2.y = __builtin_bit_cast(unsigned, hc); ((u32x2*)((unsigned short*)out + (size_t)m * DM) + lane)[64 * j] = w2; }
        }
    }
    grid.sync();

    int dir = 0;
    for (int layer = 0; layer < DEPTH; ++layer) {
        const int j = layer >> 1, mixer = layer & 1;
        for (int step = 0; step < 2; ++step) {
            if (step == 0) {
                pg8::Gemm g; pg8::EpiBf16 E;
                if (mixer == 0) { g = pg8::Gemm{HB, (const bf16*)(ws + WS_ATTN_IN) + (size_t)j * 3072 * DM, NTOK, 3072, DM};
                    E = pg8::EpiBf16{(bf16*)(ws + WS_Q), DM, 0, DM, (size_t)NTOK * DM, 0.125f}; }
                else { g = pg8::Gemm{HB, (const bf16*)(ws + WS_GMLP_IN) + (size_t)j * 4096 * DM, NTOK, 4096, DM};
                    E = pg8::EpiBf16{(bf16*)(ws + WS_ZZ), 4096, 1, 0, 0, 1.f}; }
                pg8::StaticOrder S; S.rev = dir; dir ^= 1; S.init(g.M, g.N, G, cu);
                for (int rep = 0; rep < (PROBE == 1 ? 2 : 1); ++rep)
                pg8::gemm_phase<pg8::EpiBf16, pg8::StaticOrder, true, true>(lds, g, S, E);
            } else {
                pg8::Gemm g{HB, (const bf16*)(ws + WS_FFN_UP) + (size_t)layer * FF2 * DM, NTOK, FF2, DM};
                pg8::EpiConv E{(bf16*)(ws + WS_G), args.in[10] + (size_t)layer * 3 * FF2, args.in[11] + (size_t)layer * FF2, lds + 131072, FF, FF2, FF, (float*)(ws + WS_HT)};
                pg8::StaticOrder S; S.rev = dir; dir ^= 1; S.init(g.M, g.N, G, cu);
                for (int rep = 0; rep < (PROBE == 4 ? 2 : 1); ++rep)
                pg8::gemm_phase<pg8::EpiConv, pg8::StaticOrder, true, true>(lds, g, S, E);
                GSYNC();
                ffn_fix_phase((const float*)(ws + WS_HT), (bf16*)(ws + WS_G), args.in[10] + (size_t)layer * 3 * FF2, args.in[11] + (size_t)layer * FF2, cu, G, opaque_tid());
            }
            GSYNC();
            if (step == 0) {
                for (int rep = 0; rep < (((PROBE == 2 && mixer == 0) || (PROBE == 3 && mixer == 1)) ? 2 : 1); ++rep)
                if (mixer == 0) attn_phase(lds, (const bf16*)(ws + WS_Q), (const bf16*)(ws + WS_K), (const bf16*)(ws + WS_V), (bf16*)(ws + WS_O), cu, G, dir);
                else spatial_phase(lds, (const bf16*)(ws + WS_ZZ), (bf16*)(ws + WS_GT), (const bf16*)(ws + WS_WS) + (size_t)j * GG * GC * GC, args.in[7] + j * GG * GC, args.in[4] + j * GW, args.in[5] + j * GW, cu, G, dir); dir ^= 1;
                GSYNC();
            }
            const int lnidx = 2 * layer + step;
            {
                pg8::Gemm g;
                if (step == 0 && mixer == 0) g = pg8::Gemm{(const bf16*)(ws + WS_O), (const bf16*)(ws + WS_ATTN_OUT) + (size_t)j * DM * DM, NTOK, DM, DM};
                else if (step == 0) g = pg8::Gemm{(const bf16*)(ws + WS_GT), (const bf16*)(ws + WS_GMLP_OUT) + (size_t)j * DM * GW, NTOK, DM, GW};
                else g = pg8::Gemm{(const bf16*)(ws + WS_G), (const bf16*)(ws + WS_FFN_DOWN) + (size_t)layer * DM * FF, NTOK, DM, FF};
                const int pl = (lnidx - 1) >> 1;
                const float* pgam = lnidx == 0 ? nullptr : (((lnidx - 1) & 1) ? args.in[15] : args.in[13]) + pl * DM;
                const float* pbet = lnidx == 0 ? nullptr : (((lnidx - 1) & 1) ? args.in[16] : args.in[14]) + pl * DM;
                const float* cgam = (step == 0 ? args.in[13] : args.in[15]) + layer * DM;
                const float* cbet = (step == 0 ? args.in[14] : args.in[16]) + layer * DM;
                const bool lastln = lnidx == 2 * DEPTH - 1;
                pg8::EpiResLn E{lastln ? (const unsigned short*)HB : (const unsigned short*)out, lastln ? 1 : 0, out, (float*)(ws + WS_ST), cgam, cbet, HB, (unsigned short*)out,
                                (unsigned*)(ws + WS_CTL + 8192), 128u * (unsigned)lnidx, lastln ? 1 : 0, lds + 131072, dir};
                pg8::StaticOrder S; S.rev = dir; dir ^= 1; S.init(g.M, g.N, G, cu);
                if (PROBE == 9) { pg8::EpiBf16 E0{(bf16*)(ws + WS_R + (step == 1 ? 512 * MiB : 0)), DM, 0, 0, 0, 1.f};
                    pg8::gemm_phase<pg8::EpiBf16, pg8::StaticOrder, true, true>(lds, g, S, E0); }
                pg8::gemm_phase<pg8::EpiResLn, pg8::StaticOrder, true, true>(lds, g, S, E);
            }
            if (lnidx != 2 * DEPTH - 1) GSYNC();
        }
    }
}

extern "C" void kernel_launch(void* const* d_in, const int* in_sizes, int n_in, void* d_out, int out_size, void* d_ws, size_t ws_size, hipStream_t stream) {
    static int grid = 0;
    if (grid == 0) {
        if (n_in != 17 || out_size != NTOK * DM || ws_size < WS_END) { fprintf(stderr, "kernel_launch: unexpected shapes (n_in %d, out %d, ws %zu)\n", n_in, out_size, ws_size); grid = -1; return; }
        int dev = 0, cus = 0, per_cu = 0;
        hipGetDevice(&dev);
        hipDeviceGetAttribute(&cus, hipDeviceAttributeMultiprocessorCount, dev);
        if (hipFuncSetAttribute((const void*)fwd_kernel, hipFuncAttributeMaxDynamicSharedMemorySize, LDS_BYTES) != hipSuccess) { fprintf(stderr, "kernel_launch: hipFuncSetAttribute failed\n"); grid = -1; return; }
        if (hipOccupancyMaxActiveBlocksPerMultiprocessor(&per_cu, (const void*)fwd_kernel, 512, LDS_BYTES) != hipSuccess || per_cu < 1) { fprintf(stderr, "kernel_launch: occupancy query says %d\n", per_cu); per_cu = 1; }
        (void)hipGetLastError();
        grid = cus * per_cu;
        fprintf(stderr, "kernel_launch: grid %d (cus %d x %d)\n", grid, cus, per_cu);
        if (grid != 256) { fprintf(stderr, "kernel_launch: the fused LayerNorm epilogue's group barrier is laid out for a 256-workgroup grid; nothing launched\n"); grid = -1; return; }
    }
    if (grid < 0) return;
    Args a{};
    for (int i = 0; i < 17; ++i) a.in[i] = (const float*)d_in[i];
    a.out = (float*)d_out; a.ws = (unsigned char*)d_ws;
    void* kargs[] = {&a};
    hipError_t e = hipLaunchCooperativeKernel((const void*)fwd_kernel, dim3(grid), dim3(512), kargs, LDS_BYTES, stream);
    if (e != hipSuccess) fprintf(stderr, "cooperative launch failed: %s (grid %d)\n", hipGetErrorString(e), grid);
}
```

```cpp
#include <hip/hip_runtime.h>
#include <hip/hip_cooperative_groups.h>
#include <cstdio>
#include <cstdint>
namespace cg = cooperative_groups;
__device__ __forceinline__ int opaque_tid() { int t = threadIdx.x; asm volatile("" : "+v"(t)); return t; }
namespace pg8 {
#define PG8_LAS __attribute__((address_space(3)))
typedef unsigned short bf16_t;
typedef short bf16x8 __attribute__((ext_vector_type(8)));
typedef float f32x4 __attribute__((ext_vector_type(4)));
typedef unsigned u32x4 __attribute__((ext_vector_type(4)));
constexpr int BM = 256, BK = 64, HALF = 128, HTB = HALF * BK * 2  , STAGE_BYTES = 8 * HTB, NXCD = 8, WGM = 8;

__host__ __device__ __forceinline__ int lds_byte(int r, int c) { const int st = (r >> 4) * 2 + (c >> 5), rr = r & 15, cc = c & 31, ob = rr * 64 + cc * 2; return st * 1024 + (ob ^ (((ob >> 9) & 1) << 5)); }
__host__ __device__ __forceinline__ void stage_rc(int b, int& R, int& C) { const int st = b / 1024, sb = b % 1024, swz = sb ^ (((sb >> 9) & 1) << 5); R = (st >> 1) * 16 + swz / 64; C = (st & 1) * 32 + (swz % 64) / 2; }
__host__ __device__ __forceinline__ int perm32(int rho) { const int n = rho >> 4, i = rho & 15; return 8 * (i >> 2) + 4 * n + (i & 3); }

struct Unit { int pm, pn; };
struct Gemm { const bf16_t* A; const bf16_t* Bt; int M, N, K; };

struct StaticOrder {
    int nM, nN, nwg, G, c, rev = 0;
    __host__ __device__ void init(int M, int N, int G_, int c_) { nM = M / BM; nN = N / BM; nwg = nM * nN; G = G_; c = c_; }
    __host__ __device__ bool next(int i, Unit& u) const {
        if ((long)i * G + c >= nwg) return false;
        const long L = (long)(rev ? (nwg / G - 1 - i) : i) * G + c;
        int wgid = (int)L; { const int q = nwg / NXCD, r = nwg % NXCD, xcd = wgid % NXCD, off = wgid / NXCD; wgid = (xcd < r ? xcd * (q + 1) : r * (q + 1) + (xcd - r) * q) + off; }
        const int nig = WGM * nN, gid = wgid / nig, fm = gid * WGM, gsz = (nM - fm) < WGM ? (nM - fm) : WGM;
        u.pm = fm + ((wgid % nig) % gsz); u.pn = (wgid % nig) / gsz; return true;
    }
    __device__ __forceinline__ void a_ready(const Unit&) const {}
    __device__ __forceinline__ void done(const Unit&) const {}
};
__device__ __forceinline__ unsigned cvt_pk_bf16(float lo, float hi) { unsigned r; asm volatile("v_cvt_pk_bf16_f32 %0, %1, %2" : "=v"(r) : "v"(lo), "v"(hi)); return r; }
typedef float f32x2 __attribute__((ext_vector_type(2)));
typedef unsigned u32x2e __attribute__((ext_vector_type(2)));
__device__ __forceinline__ float gelu_tanh(float x) {
    const float t = x * (-2.302208198f + (-0.1029432397f) * x * x);
    return x * __builtin_amdgcn_rcpf(1.0f + __builtin_amdgcn_exp2f(t));
}
struct EpiBf16 {
    static constexpr bool PERM = true, AFTER_DRAIN = false;
    bf16_t* O; int ldc; int act; int split_cols; size_t split_stride; float scale0;
    float* vst; PG8_LAS float* sl;
    __device__ __forceinline__ void operator()(const f32x4 (&acc)[2][2][4][2], const Unit& u, int wr, int wc, int fr, int fq) const {
        const int row0 = u.pm * BM + wr * 64 + fr; int colt = u.pn * BM; bf16_t* base = O;
        float sc = 1.f; if (split_cols) { const int t = colt / split_cols; base += (size_t)t * split_stride; colt -= t * split_cols; if (t == 0) sc = scale0; }
        const int col0 = colt + wc * 32 + 8 * fq;
        const bool dost = vst != nullptr && u.pn >= 8;
#pragma unroll
        for (int ai = 0; ai < 2; ++ai)
#pragma unroll
            for (int m = 0; m < 4; ++m) { bf16_t* rowp = base + (size_t)(row0 + ai * HALF + m * 16) * ldc + col0; float rs = 0.f, rq = 0.f;
#pragma unroll
                for (int bj = 0; bj < 2; ++bj) { f32x4 v0 = acc[ai][bj][m][0], v1 = acc[ai][bj][m][1];
                    if (act) { v0 = (f32x4){gelu_tanh(v0[0]), gelu_tanh(v0[1]), gelu_tanh(v0[2]), gelu_tanh(v0[3])};
                               v1 = (f32x4){gelu_tanh(v1[0]), gelu_tanh(v1[1]), gelu_tanh(v1[2]), gelu_tanh(v1[3])}; }
                    if (dost) { rs += ((v0[0] + v0[1]) + (v0[2] + v0[3])) + ((v1[0] + v1[1]) + (v1[2] + v1[3]));
                                rq += ((v0[0] * v0[0] + v0[1] * v0[1]) + (v0[2] * v0[2] + v0[3] * v0[3])) + ((v1[0] * v1[0] + v1[1] * v1[1]) + (v1[2] * v1[2] + v1[3] * v1[3])); }
                    v0 = v0 * sc; v1 = v1 * sc; u32x4 w; w.x = cvt_pk_bf16(v0[0], v0[1]); w.y = cvt_pk_bf16(v0[2], v0[3]); w.z = cvt_pk_bf16(v1[0], v1[1]); w.w = cvt_pk_bf16(v1[2], v1[3]);
                    *(u32x4*)(rowp + bj * HALF) = w; }
                if (dost) { rs += __shfl_xor(rs, 16); rs += __shfl_xor(rs, 32); rq += __shfl_xor(rq, 16); rq += __shfl_xor(rq, 32);
                    const int lrow = ai * HALF + wr * 64 + m * 16 + fr; if (fq == 0) { sl[(lrow * 4 + wc) * 2] = rs; sl[(lrow * 4 + wc) * 2 + 1] = rq; } } }
        if (dost) {
            asm volatile("s_waitcnt lgkmcnt(0)" ::: "memory"); __builtin_amdgcn_s_barrier(); asm volatile("" ::: "memory");
            const int t = opaque_tid();
            if (t < 256) { const f32x4 a = *(PG8_LAS const f32x4*)(sl + t * 8), b = *(PG8_LAS const f32x4*)(sl + t * 8 + 4);
                typedef float f32x2v __attribute__((ext_vector_type(2)));
                *(f32x2v*)(vst + ((size_t)u.pm * BM + t) * 16 + (u.pn - 8) * 2) = (f32x2v){(a[0] + a[2]) + (b[0] + b[2]), (a[1] + a[3]) + (b[1] + b[3])}; }
        }
    }
};
struct EpiRes {
    static constexpr bool PERM = false, AFTER_DRAIN = false;
    const float* base; float* out; int ldc; float alpha;
    __device__ __forceinline__ void operator()(const f32x4 (&acc)[2][2][4][2], const Unit& u, int wr, int wc, int fr, int fq) const {
        const int col0 = u.pn * BM + wc * 32 + 4 * fq;
#pragma unroll
        for (int ai = 0; ai < 2; ++ai)
#pragma unroll
            for (int m = 0; m < 4; ++m) { const size_t off = (size_t)(u.pm * BM + ai * HALF + wr * 64 + m * 16 + fr) * ldc + col0;
#pragma unroll
                for (int bj = 0; bj < 2; ++bj)
#pragma unroll
                    for (int n = 0; n < 2; ++n) { const f32x4 bs = *(const f32x4*)(base + off + bj * HALF + n * 16);
                        *(f32x4*)(out + off + bj * HALF + n * 16) = bs * alpha + acc[ai][bj][m][n]; }
                asm volatile("" ::: "memory"); }
    }
};

template <int CTRL> __device__ __forceinline__ float dpp_mov(float old, float src) {
    return __builtin_bit_cast(float, __builtin_amdgcn_update_dpp(__builtin_bit_cast(int, old), __builtin_bit_cast(int, src), CTRL, 0xf, 0xf, false));
}
struct SeqOrder {
    int G, c;
    __device__ bool next(int i, Unit& u) const { if (i >= 22) return false; int it, step;
        if (i < 16) { it = c + G * (i >> 3); step = i & 7; } else { const int v = 6 * c + (i - 16); it = 512 + (v >> 3); step = v & 7; }
        u.pn = it >> 5; u.pm = 8 * (it & 31) + step; return true; }
    __device__ __forceinline__ void a_ready(const Unit&) const {}
    __device__ __forceinline__ void done(const Unit&) const {}
};
struct EpiConv {
    static constexpr bool PERM = true, AFTER_DRAIN = false;
    bf16_t* O; const float* cw; const float* cb; PG8_LAS unsigned char* hl; int ldo, ncol2, nfeat; float* ht;
    __device__ __forceinline__ void operator()(const f32x4 (&acc)[2][2][4][2], const Unit& u, int wr, int wc, int fr, int fq) const {
        const int lcol = wc * 32 + 8 * fq;
        { const int t = opaque_tid();
          if (t < 256) { const int p = t >> 5, ch = t & 31, pp = p & 3; const float* src = (pp < 3 ? cw + pp * ncol2 : cb) + (p >> 2) * nfeat + 128 * u.pn + 4 * ch;
              *(PG8_LAS f32x4*)(hl + 10240 + (p * 128 + 4 * ch) * 4) = *(const f32x4*)src; } }
        float* const htu = ht + (size_t)(u.pm * 22 + u.pn) * 1024;
        if (fr >= 14) {
#pragma unroll
            for (int ai = 0; ai < 2; ++ai) { const int k = 2 * ai + wr;
                if (k < 3) { PG8_LAS unsigned char* hp = hl + k * 2048 + (fr - 14) * 1024 + lcol * 4;
#pragma unroll
                    for (int bj = 0; bj < 2; ++bj)
#pragma unroll
                        for (int n = 0; n < 2; ++n) *(PG8_LAS f32x4*)(hp + bj * 512 + n * 16) = acc[ai][bj][3][n]; }
                else {
#pragma unroll
                    for (int bj = 0; bj < 2; ++bj)
#pragma unroll
                        for (int n = 0; n < 2; ++n) *(f32x4*)(htu + (2 + fr - 14) * 256 + bj * 128 + lcol + 4 * n) = acc[ai][bj][3][n]; } }
        }
        if (wr == 0 && fr < 2) {
#pragma unroll
            for (int bj = 0; bj < 2; ++bj)
#pragma unroll
                for (int n = 0; n < 2; ++n) *(f32x4*)(htu + fr * 256 + bj * 128 + lcol + 4 * n) = acc[0][bj][0][n];
        }
        asm volatile("s_waitcnt lgkmcnt(0)" ::: "memory"); __builtin_amdgcn_s_barrier(); asm volatile("" ::: "memory");
#pragma unroll
        for (int n = 0; n < 2; ++n) {
            const int f = 128 * u.pn + lcol + 4 * n;
            PG8_LAS const float* const wl = (PG8_LAS const float*)(hl + 10240) + lcol + 4 * n;
            const f32x4 wg0 = *(PG8_LAS const f32x4*)(wl), wg1 = *(PG8_LAS const f32x4*)(wl + 128), wg2 = *(PG8_LAS const f32x4*)(wl + 256), bg = *(PG8_LAS const f32x4*)(wl + 384);
            const f32x4 wv0 = *(PG8_LAS const f32x4*)(wl + 512), wv1 = *(PG8_LAS const f32x4*)(wl + 640), wv2 = *(PG8_LAS const f32x4*)(wl + 768), bv = *(PG8_LAS const f32x4*)(wl + 896);
#pragma unroll
            for (int ai = 0; ai < 2; ++ai) {
                const int k = 2 * ai + wr;
                const int rslot = k > 0 ? k - 1 : 0;
                PG8_LAS const unsigned char* hp = hl + rslot * 2048 + (lcol + 4 * n) * 4;
                f32x4 hg2 = *(PG8_LAS const f32x4*)hp, hv2 = *(PG8_LAS const f32x4*)(hp + 512), hg1 = *(PG8_LAS const f32x4*)(hp + 1024), hv1 = *(PG8_LAS const f32x4*)(hp + 1536);
                if (k == 0) { hg2 = (f32x4){0.f, 0.f, 0.f, 0.f}; hv2 = hg2; hg1 = hg2; hv1 = hg2; }
#pragma unroll
                for (int m = 0; m < 4; ++m) {
                    float r[4];
#pragma unroll
                    for (int e = 0; e < 4; ++e) {
                        const float xg = acc[ai][0][m][n][e], xv = acc[ai][1][m][n][e];
                        float o1g, o2g, o1v, o2v;
                        if (m == 0) { o1g = hg1[e]; o2g = fr == 0 ? hg2[e] : hg1[e]; o1v = hv1[e]; o2v = fr == 0 ? hv2[e] : hv1[e]; }
                        else { const float pgv = acc[ai][0][m > 0 ? m - 1 : 0][n][e], pvv = acc[ai][1][m > 0 ? m - 1 : 0][n][e];
                            o1g = dpp_mov<0x121>(pgv, pgv); o2g = dpp_mov<0x122>(pgv, pgv); o1v = dpp_mov<0x121>(pvv, pvv); o2v = dpp_mov<0x122>(pvv, pvv); }
                        const float p1g = dpp_mov<0x111>(o1g, xg), p2g = dpp_mov<0x112>(o2g, xg), p1v = dpp_mov<0x111>(o1v, xv), p2v = dpp_mov<0x112>(o2v, xv);
                        const float yg = bg[e] + wg2[e] * xg + wg1[e] * p1g + wg0[e] * p2g;
                        const float yv = bv[e] + wv2[e] * xv + wv1[e] * p1v + wv0[e] * p2v;
                        r[e] = yg * __builtin_amdgcn_rcpf(1.0f + __builtin_amdgcn_exp2f(-1.4426950408889634f * yg)) * yv;
                    }
                    u32x2e w; w.x = cvt_pk_bf16(r[0], r[1]); w.y = cvt_pk_bf16(r[2], r[3]);
                    *(u32x2e*)(O + (size_t)(u.pm * BM + ai * HALF + wr * 64 + m * 16 + fr) * ldo + f) = w;
                }
            }
        }
    }
};

struct EpiResLn {
    static constexpr bool PERM = false, AFTER_DRAIN = false;
    const unsigned short* base16; int isbf; float* out; float* st; const float* cg; const float* cbeta; bf16_t* hb; unsigned short* hf; unsigned* gcnt; unsigned tgt0; int last; PG8_LAS unsigned char* xl; int rev;
    static constexpr int ldc = 1024; static constexpr float alpha = 1.681792830507429f, eps = 1e-5f;
    typedef _Float16 h16x2 __attribute__((ext_vector_type(2)));
    __device__ __forceinline__ f32x4 dec(u32x2e w) const {
        if (isbf) return (f32x4){__uint_as_float(w.x << 16), __uint_as_float(w.x & 0xffff0000u), __uint_as_float(w.y << 16), __uint_as_float(w.y & 0xffff0000u)};
        const float f0 = (float)__builtin_bit_cast(_Float16, (unsigned short)(w.x & 0xffffu)), f1 = (float)__builtin_bit_cast(_Float16, (unsigned short)(w.x >> 16));
        const float f2 = (float)__builtin_bit_cast(_Float16, (unsigned short)(w.y & 0xffffu)), f3 = (float)__builtin_bit_cast(_Float16, (unsigned short)(w.y >> 16));
        return (f32x4){f0, f1, f2, f3}; }
    __device__ __forceinline__ void operator()(f32x4 (&acc)[2][2][4][2], const Unit& u, int wr, int wc, int fr, int fq) const {
        asm volatile("" : "+v"(fr), "+v"(fq));
        typedef float f32x2s __attribute__((ext_vector_type(2)));
        PG8_LAS float* const sl = (PG8_LAS float*)xl; PG8_LAS float* const gl = (PG8_LAS float*)(xl + 8192);
        const int col0 = u.pn * BM + wc * 32 + 4 * fq, lc0 = wc * 32 + 4 * fq;
        { const int t = opaque_tid();
          if (t < 128) { const int which = t >> 6, c4 = 4 * (t & 63); *(PG8_LAS f32x4*)(gl + which * 256 + c4) = *(const f32x4*)((which ? cbeta : cg) + u.pn * BM + c4); } }
        u32x2e nb[4];
        { const size_t off = ((size_t)u.pm * BM + wr * 64 + fr) * ldc + col0;
#pragma unroll
          for (int q = 0; q < 4; ++q) nb[q] = *(const u32x2e*)(base16 + off + (q >> 1) * HALF + (q & 1) * 16); }
#pragma unroll
        for (int i = 0; i < 8; ++i) { const int ai = i >> 2, m = i & 3; const int lrow = ai * HALF + wr * 64 + m * 16 + fr;
            u32x2e cur[4];
#pragma unroll
            for (int q = 0; q < 4; ++q) cur[q] = nb[q];
            if (i < 7) { const int lr2 = ((i + 1) >> 2) * HALF + wr * 64 + ((i + 1) & 3) * 16 + fr; const size_t off2 = ((size_t)u.pm * BM + lr2) * ldc + col0;
#pragma unroll
                for (int q = 0; q < 4; ++q) nb[q] = *(const u32x2e*)(base16 + off2 + (q >> 1) * HALF + (q & 1) * 16); }
            asm volatile("" ::: "memory");
            float rsum = 0.f, rq = 0.f;
#pragma unroll
            for (int q = 0; q < 4; ++q) { const int bj = q >> 1, n = q & 1;
                const f32x4 y = dec(cur[q]) * alpha + acc[ai][bj][m][n];
                acc[ai][bj][m][n] = y;
                rsum += (y[0] + y[1]) + (y[2] + y[3]); rq += (y[0] * y[0] + y[1] * y[1]) + (y[2] * y[2] + y[3] * y[3]); }
            rsum += __shfl_xor(rsum, 16); rsum += __shfl_xor(rsum, 32); rq += __shfl_xor(rq, 16); rq += __shfl_xor(rq, 32);
            if (fq == 0) { sl[(lrow * 4 + wc) * 2] = rsum; sl[(lrow * 4 + wc) * 2 + 1] = rq; }
            asm volatile("" ::: "memory"); }
        asm volatile("s_waitcnt lgkmcnt(0)" ::: "memory"); __builtin_amdgcn_s_barrier(); asm volatile("" ::: "memory");
        const int t = opaque_tid();
        if (t < 256) { const f32x4 a = *(PG8_LAS const f32x4*)(sl + t * 8), b = *(PG8_LAS const f32x4*)(sl + t * 8 + 4);
            const float ssum = (a[0] + a[2]) + (b[0] + b[2]), ssq = (a[1] + a[3]) + (b[1] + b[3]);
            __hip_atomic_store((unsigned long long*)(st + ((size_t)u.pm * BM + t) * 8 + u.pn * 2), ((unsigned long long)__float_as_uint(ssq) << 32) | __float_as_uint(ssum), __ATOMIC_RELAXED, __HIP_MEMORY_SCOPE_AGENT); }
        asm volatile("s_waitcnt vmcnt(0) lgkmcnt(0)" ::: "memory"); __builtin_amdgcn_s_barrier(); asm volatile("" ::: "memory");
        if (t == 0) {
            unsigned* const ctr = gcnt + 64 * (blockIdx.x & 7); const unsigned target = tgt0 + 32u * (unsigned)((rev ? 3 - ((u.pm >> 3) & 3) : ((u.pm >> 3) & 3)) + 1);
            __hip_atomic_fetch_add(ctr, 1u, __ATOMIC_RELAXED, __HIP_MEMORY_SCOPE_AGENT);
            while (__hip_atomic_load(ctr, __ATOMIC_RELAXED, __HIP_MEMORY_SCOPE_AGENT) < target) __builtin_amdgcn_s_sleep(1);
        }
        __builtin_amdgcn_s_barrier(); asm volatile("" ::: "memory");
        if (t < 256) { const size_t row = (size_t)u.pm * BM + t;
            float s = 0.f, q = 0.f;
#pragma unroll
            for (int k4 = 0; k4 < 4; ++k4) { const unsigned long long w = __hip_atomic_load((const unsigned long long*)(st + row * 8 + 2 * k4), __ATOMIC_RELAXED, __HIP_MEMORY_SCOPE_AGENT);
                s += __uint_as_float((unsigned)w); q += __uint_as_float((unsigned)(w >> 32)); }
            const float mean = s * (1.f / 1024.f), rstd = 1.f / sqrtf(q * (1.f / 1024.f) - mean * mean + eps);
            *(PG8_LAS f32x2s*)(sl + 2 * t) = (f32x2s){mean, rstd}; }
        asm volatile("s_waitcnt lgkmcnt(0)" ::: "memory"); __builtin_amdgcn_s_barrier(); asm volatile("" ::: "memory");
#pragma unroll
        for (int i = 0; i < 8; ++i) { const int ai = i >> 2, m = i & 3; const int lrow = ai * HALF + wr * 64 + m * 16 + fr; const size_t off = ((size_t)u.pm * BM + lrow) * ldc + col0;
            const f32x2s mr = *(PG8_LAS const f32x2s*)(sl + 2 * lrow);
#pragma unroll
            for (int q = 0; q < 4; ++q) { const int bj = q >> 1, n = q & 1;
                const f32x4 g4 = *(PG8_LAS const f32x4*)(gl + lc0 + bj * HALF + n * 16), b4 = *(PG8_LAS const f32x4*)(gl + 256 + lc0 + bj * HALF + n * 16);
                const f32x4 o = (acc[ai][bj][m][n] - mr.x) * mr.y * g4 + b4;
                if (last) *(f32x4*)(out + off + bj * HALF + n * 16) = o;
                else { u32x2e w; w.x = cvt_pk_bf16(o[0], o[1]); w.y = cvt_pk_bf16(o[2], o[3]); *(u32x2e*)(hb + off + bj * HALF + n * 16) = w;
                    const h16x2 ha = {(_Float16)o[0], (_Float16)o[1]}, hc = {(_Float16)o[2], (_Float16)o[3]};
                    u32x2e w2; w2.x = __builtin_bit_cast(unsigned, ha); w2.y = __builtin_bit_cast(unsigned, hc); *(u32x2e*)(hf + off + bj * HALF + n * 16) = w2; } }
            asm volatile("" ::: "memory"); }
    }
};

template <class Epi, class Sched, bool ALIGN_EPI = false, bool SP2 = false>
__device__ __forceinline__ void gemm_phase(PG8_LAS unsigned char* lds, const Gemm g, const Sched& S, const Epi& E) {
    const int tid = opaque_tid(), wid = __builtin_amdgcn_readfirstlane(tid >> 6), lane = tid & 63, wr = wid >> 2, wc = wid & 3, fr = lane & 15, fq = lane >> 4;
    const int K = g.K, nt = K / BK;
    unsigned voffA[2], voffB[2];
#pragma unroll
    for (int i = 0; i < 2; ++i) { int R, C; stage_rc(tid * 16 + i * 8192, R, C); const int Rb = Epi::PERM ? ((R & ~31) + perm32(R & 31)) : R;
        voffA[i] = (unsigned)(R * K + C) * 2u; voffB[i] = (unsigned)(Rb * K + C) * 2u; }
    const size_t kstep = (size_t)(BK * 2);
    const size_t hstep = (size_t)HALF * K * 2;
    const size_t tstep = 2 * hstep;
    const unsigned ldsw = (unsigned)wid * 1024u;
    const int aoff = lds_byte(wr * 64 + fr, fq * 8), boff = lds_byte(wc * 32 + fr, fq * 8);
#define PG8_SA(b, h) (((b) * 2 + (h)) * HTB)
#define PG8_SB(b, h) ((4 + (b) * 2 + (h)) * HTB)
#define PG8_STAGE(bufoff, gbase, voff) do { _Pragma("unroll") for (int _i = 0; _i < 2; ++_i) \
        __builtin_amdgcn_global_load_lds((const unsigned*)((const char*)(gbase) + (voff)[_i]), (PG8_LAS unsigned*)(lds + (bufoff) + ldsw + _i * 8192), 16, 0, 0); } while (0)
#define PG8_LDA(dst, b, h) do { _Pragma("unroll") for (int m = 0; m < 4; ++m) _Pragma("unroll") for (int k = 0; k < 2; ++k) dst[m][k] = *(const PG8_LAS bf16x8*)(lds + PG8_SA(b, h) + aoff + m * 2048 + k * 1024); } while (0)
#define PG8_LDB(dst, b, h) do { _Pragma("unroll") for (int n = 0; n < 2; ++n) _Pragma("unroll") for (int k = 0; k < 2; ++k) dst[n][k] = *(const PG8_LAS bf16x8*)(lds + PG8_SB(b, h) + boff + n * 2048 + k * 1024); } while (0)
#define PG8_MMA(ai, bj, At, Bt) do { __builtin_amdgcn_s_setprio(1); _Pragma("unroll") for (int m = 0; m < 4; ++m) _Pragma("unroll") for (int n = 0; n < 2; ++n) _Pragma("unroll") for (int k = 0; k < 2; ++k) \
        acc[ai][bj][m][n] = __builtin_amdgcn_mfma_f32_16x16x32_bf16(Bt[n][k], At[m][k], acc[ai][bj][m][n], 0, 0, 0); __builtin_amdgcn_s_setprio(0); } while (0)
#define PG8_WAIT_V(n) asm volatile("s_waitcnt vmcnt(" #n ")" ::: "memory")
#define PG8_WAIT_L(n) asm volatile("s_waitcnt lgkmcnt(" #n ")" ::: "memory")
#define PG8_BAR __builtin_amdgcn_s_barrier()
#define PG8_SCHED __builtin_amdgcn_sched_barrier(0)
    Unit cur, nxt; int ui = 0;
    if (!S.next(0, cur)) return;
    f32x4 acc[2][2][4][2];
#pragma unroll
    for (int a = 0; a < 2; ++a)
#pragma unroll
        for (int b = 0; b < 2; ++b)
#pragma unroll
            for (int m = 0; m < 4; ++m)
#pragma unroll
                for (int n = 0; n < 2; ++n) acc[a][b][m][n] = (f32x4){0.f, 0.f, 0.f, 0.f};
    bf16x8 At[4][2], B0[2][2], B1[2][2];
    const char* cA = (const char*)g.A + (size_t)cur.pm * tstep; const char* cB = (const char*)g.Bt + (size_t)cur.pn * tstep;
    S.a_ready(cur);
    if constexpr (SP2) {
        PG8_STAGE(PG8_SB(0, 0), cB, voffB); PG8_STAGE(PG8_SB(0, 1), cB + hstep, voffB); PG8_STAGE(PG8_SA(0, 0), cA, voffA); PG8_STAGE(PG8_SA(0, 1), cA + hstep, voffA);
        if (wr == 1) PG8_BAR;
        PG8_WAIT_V(2); PG8_BAR;
        PG8_STAGE(PG8_SB(1, 0), cB + kstep, voffB); PG8_STAGE(PG8_SA(1, 0), cA + kstep, voffA); PG8_STAGE(PG8_SB(1, 1), cB + hstep + kstep, voffB);
        PG8_WAIT_V(6); PG8_BAR;
    } else {
        PG8_STAGE(PG8_SB(0, 0), cB, voffB); PG8_STAGE(PG8_SA(0, 0), cA, voffA); PG8_STAGE(PG8_SB(0, 1), cB + hstep, voffB); PG8_STAGE(PG8_SA(0, 1), cA + hstep, voffA);
        if (wr == 1) PG8_BAR;
        PG8_WAIT_V(4); PG8_BAR;
        PG8_STAGE(PG8_SB(1, 0), cB + kstep, voffB); PG8_STAGE(PG8_SA(1, 0), cA + kstep, voffA); PG8_STAGE(PG8_SB(1, 1), cB + hstep + kstep, voffB);
        PG8_WAIT_V(6); PG8_BAR;
    }
    for (;;) {
        const bool has_next = S.next(ui + 1, nxt);
        const char* nA = has_next ? (const char*)g.A + (size_t)nxt.pm * tstep : cA; const char* nB = has_next ? (const char*)g.Bt + (size_t)nxt.pn * tstep : cB;
        for (int t = 0; t < nt; t += 2) {
            const bool last = (t == nt - 2);
            const char* a1 = cA + (size_t)(t + 1) * kstep;
            const char* a2 = last ? nA : cA + (size_t)(t + 2) * kstep; const char* b2 = last ? nB : cB + (size_t)(t + 2) * kstep;
            const char* a3 = a2 + kstep; const char* b3 = b2 + kstep;
            if (last && has_next) S.a_ready(nxt);
            if constexpr (SP2) {
            PG8_LDB(B0, 0, 0); PG8_LDB(B1, 0, 1); PG8_SCHED; PG8_LDA(At, 0, 0); PG8_STAGE(PG8_SA(1, 1), a1 + hstep, voffA);
            PG8_WAIT_V(8); PG8_WAIT_L(0); PG8_BAR; PG8_MMA(0, 0, At, B0); PG8_MMA(0, 1, At, B1); PG8_BAR; PG8_SCHED;
            PG8_LDA(At, 0, 1); PG8_STAGE(PG8_SB(0, 0), b2, voffB); PG8_STAGE(PG8_SB(0, 1), b2 + hstep, voffB); PG8_STAGE(PG8_SA(0, 0), a2, voffA);
            PG8_WAIT_V(8); PG8_WAIT_L(0); PG8_BAR; PG8_MMA(1, 0, At, B0); PG8_MMA(1, 1, At, B1); PG8_BAR; PG8_SCHED;
            PG8_LDB(B0, 1, 0); PG8_LDB(B1, 1, 1); PG8_SCHED; PG8_LDA(At, 1, 0); PG8_STAGE(PG8_SA(0, 1), a2 + hstep, voffA);
            PG8_WAIT_V(8); PG8_WAIT_L(0); PG8_BAR; PG8_MMA(0, 0, At, B0); PG8_MMA(0, 1, At, B1); PG8_BAR; PG8_SCHED;
            PG8_LDA(At, 1, 1); PG8_STAGE(PG8_SB(1, 0), b3, voffB); PG8_STAGE(PG8_SB(1, 1), b3 + hstep, voffB); PG8_STAGE(PG8_SA(1, 0), a3, voffA);
            PG8_WAIT_V(8); PG8_WAIT_L(0); PG8_BAR; PG8_MMA(1, 0, At, B0); PG8_MMA(1, 1, At, B1); PG8_BAR; PG8_SCHED;
            } else {
            PG8_LDB(B0, 0, 0); PG8_SCHED; PG8_LDA(At, 0, 0); PG8_STAGE(PG8_SA(1, 1), a1 + hstep, voffA);
            PG8_WAIT_L(8); PG8_BAR; PG8_WAIT_L(0); PG8_MMA(0, 0, At, B0); PG8_BAR; PG8_SCHED;
            PG8_LDB(B1, 0, 1); PG8_STAGE(PG8_SB(0, 0), b2, voffB);
            PG8_BAR; PG8_WAIT_L(0); PG8_MMA(0, 1, At, B1); PG8_BAR;
            PG8_LDA(At, 0, 1); PG8_STAGE(PG8_SA(0, 0), a2, voffA);
            PG8_BAR; PG8_WAIT_L(0); PG8_MMA(1, 0, At, B0); PG8_BAR; PG8_SCHED;
            PG8_STAGE(PG8_SB(0, 1), b2 + hstep, voffB);
            PG8_WAIT_V(6); PG8_BAR; PG8_MMA(1, 1, At, B1); PG8_BAR;
            PG8_LDB(B0, 1, 0); PG8_SCHED; PG8_LDA(At, 1, 0); PG8_STAGE(PG8_SA(0, 1), a2 + hstep, voffA);
            PG8_WAIT_L(8); PG8_BAR; PG8_WAIT_L(0); PG8_MMA(0, 0, At, B0); PG8_BAR; PG8_SCHED;
            PG8_LDB(B1, 1, 1); PG8_STAGE(PG8_SB(1, 0), b3, voffB);
            PG8_BAR; PG8_WAIT_L(0); PG8_MMA(0, 1, At, B1); PG8_BAR;
            PG8_LDA(At, 1, 1); PG8_STAGE(PG8_SA(1, 0), a3, voffA);
            PG8_BAR; PG8_WAIT_L(0); PG8_MMA(1, 0, At, B0); PG8_BAR; PG8_SCHED;
            PG8_STAGE(PG8_SB(1, 1), b3 + hstep, voffB);
            PG8_WAIT_V(6); PG8_BAR; PG8_MMA(1, 1, At, B1); PG8_BAR;
            }
        }
        if constexpr (ALIGN_EPI) { if (wr == 0) PG8_BAR; }
        if constexpr (!Epi::AFTER_DRAIN) { E(acc, cur, wr, wc, fr, fq); S.done(cur); }
        if (!has_next) break;
#pragma unroll
        for (int a = 0; a < 2; ++a)
#pragma unroll
            for (int b = 0; b < 2; ++b)
#pragma unroll
                for (int m = 0; m < 4; ++m)
#pragma unroll
                    for (int n = 0; n < 2; ++n) acc[a][b][m][n] = (f32x4){0.f, 0.f, 0.f, 0.f};
        cur = nxt; cA = nA; cB = nB; ++ui;
        if constexpr (ALIGN_EPI) { if (wr == 1) PG8_BAR; }
    }
    PG8_WAIT_V(0);
    if constexpr (!ALIGN_EPI) { if (wr == 0) PG8_BAR; }
    PG8_BAR;
    if constexpr (Epi::AFTER_DRAIN) { E.fused(acc, cur, wr, wc, fr, fq, lds, wid, lane); S.done(cur); }
#undef PG8_SA
#undef PG8_SB
#undef PG8_STAGE
#undef PG8_LDA
#undef PG8_LDB
#undef PG8_MMA
#undef PG8_WAIT_V
#undef PG8_WAIT_L
#undef PG8_BAR
#undef PG8_SCHED
}
}

constexpr int NB = 32, SEQ = 2048, DM = 1024, NTOK = NB * SEQ;
constexpr int NH = 16, HD = 64, GW = 2048, GG = 8, GC = 128, FF = 2816, FF2 = 5632, DEPTH = 4;
constexpr float LN_EPS = 1e-5f;
constexpr float DN_ALPHA = 1.681792830507429f;
constexpr int HALF_TOK = NTOK / 2;

constexpr size_t MiB = 1u << 20;
constexpr size_t WS_ATTN_IN = 0, WS_ATTN_OUT = 12 * MiB, WS_GMLP_IN = 16 * MiB, WS_GMLP_OUT = 32 * MiB, WS_FFN_UP = 40 * MiB, WS_FFN_DOWN = 84 * MiB, WS_WS = 106 * MiB;
constexpr size_t WS_MS = 110 * MiB;
constexpr size_t WS_CTL = 107 * MiB;
constexpr size_t WS_ST = 108 * MiB;
constexpr size_t WS_HB = 112 * MiB;
constexpr size_t WS_R = 240 * MiB;
constexpr size_t WS_Q = WS_R, WS_K = WS_R + 128 * MiB, WS_V = WS_R + 256 * MiB, WS_O = WS_R + 384 * MiB;
constexpr size_t WS_ZZ = WS_R, WS_GT = WS_R + 512 * MiB;
constexpr size_t WS_HT = WS_R + 400 * MiB;
constexpr size_t WS_G = WS_R;
constexpr size_t WS_VST = 1008 * MiB;
constexpr size_t WS_END = 1012 * MiB;

constexpr int LDS_BYTES = 147456;

#define LAS __attribute__((address_space(3)))
typedef unsigned short bf16;
typedef unsigned u32x4 __attribute__((ext_vector_type(4)));
typedef unsigned u32x2 __attribute__((ext_vector_type(2)));
typedef float f32x4 __attribute__((ext_vector_type(4)));
typedef float f32x16 __attribute__((ext_vector_type(16)));
typedef short bf16x8 __attribute__((ext_vector_type(8)));
typedef short s16x4 __attribute__((ext_vector_type(4)));

__device__ __forceinline__ unsigned pk2(float lo, float hi) { return pg8::cvt_pk_bf16(lo, hi); }
__device__ __forceinline__ float bflo(unsigned w) { return __uint_as_float(w << 16); }
__device__ __forceinline__ float bfhi(unsigned w) { return __uint_as_float(w & 0xffff0000u); }
__device__ __forceinline__ float wave_sum(float v) {
#pragma unroll
    for (int o = 1; o < 64; o <<= 1) v += __shfl_xor(v, o);
    return v;
}
__device__ __forceinline__ s16x4 vtr(LAS const unsigned char* p) { return __builtin_bit_cast(s16x4, __builtin_amdgcn_ds_read_tr16_b64_v4i16((LAS s16x4*)p)); }

__device__ __forceinline__ void transpose_item(const float* W, int K, int N, bf16* WT, int perm, LAS float* scr, int item, int lane) {
    const int nblk = N / 32, kb = item / nblk, nb = item % nblk, k0 = 64 * kb, n0 = 32 * nb;
    int r0 = n0;
    if (perm) { const int bj = n0 / FF, f0 = n0 - bj * FF; r0 = (f0 >> 7) * 256 + bj * 128 + (f0 & 127); }
#pragma unroll 8
    for (int i = 0; i < 32; ++i) { const int kk = 2 * i + (lane >> 5); scr[kk * 33 + (lane & 31)] = W[(size_t)(k0 + kk) * N + n0 + (lane & 31)]; }
    asm volatile("s_waitcnt lgkmcnt(0)" ::: "memory");
    const int c = lane & 7;
#pragma unroll
    for (int j = 0; j < 4; ++j) { const int n = (lane >> 3) + 8 * j; const LAS float* s = scr + (8 * c) * 33 + n;
        u32x4 o; o.x = pk2(s[0 * 33], s[1 * 33]); o.y = pk2(s[2 * 33], s[3 * 33]); o.z = pk2(s[4 * 33], s[5 * 33]); o.w = pk2(s[6 * 33], s[7 * 33]);
        *(u32x4*)(WT + (size_t)(r0 + n) * K + k0 + 8 * c) = o; }
    asm volatile("s_waitcnt lgkmcnt(0)" ::: "memory");
}

struct Args { const float* in[17]; float* out; unsigned char* ws; };

__device__ __forceinline__ void ln_apply(const float* Y, float* Yo, bf16* HB, const float* st, float* ms, const float* gam, const float* bet, int gw, int ngw, int lane) {
    f32x4 g4[4], b4[4];
#pragma unroll
    for (int j = 0; j < 4; ++j) { g4[j] = ((const f32x4*)gam)[lane + 64 * j]; b4[j] = ((const f32x4*)bet)[lane + 64 * j]; }
    for (int m = gw; m < NTOK; m += ngw) {
        const f32x4* yr = (const f32x4*)(Y + (size_t)m * DM) + lane;
        f32x4 v[4];
#pragma unroll
        for (int j = 0; j < 4; ++j) v[j] = yr[64 * j];
        const f32x4 a = *(const f32x4*)(st + (size_t)m * 8), b = *(const f32x4*)(st + (size_t)m * 8 + 4);
        const float s = (a[0] + a[2]) + (b[0] + b[2]), q = (a[1] + a[3]) + (b[1] + b[3]);
        const float mean = s * (1.f / DM), rstd = 1.f / sqrtf(q * (1.f / DM) - mean * mean + LN_EPS);
        if (lane == 0) { ms[(size_t)m * 2] = mean; ms[(size_t)m * 2 + 1] = rstd; }
        u32x2* o8 = (u32x2*)(HB + (size_t)m * DM) + lane;
#pragma unroll
        for (int j = 0; j < 4; ++j) { const f32x4 o = (v[j] - mean) * rstd * g4[j] + b4[j]; if (Yo) ((f32x4*)(Yo + (size_t)m * DM) + lane)[64 * j] = o; u32x2 w; w.x = pk2(o.x, o.y); w.y = pk2(o.z, o.w); o8[64 * j] = w; }
    }
}

__device__ __forceinline__ void ffn_fix_phase(const float* HT, bf16* Gb, const float* cw, const float* cb, int cu, int G, int tid) {
    const int sub = tid >> 6, r = (tid >> 5) & 1, f = (tid & 31) * 4;
    for (int up = cu * 8 + sub; up < 224 * 22; up += G * 8) {
        const int pn = up % 22, pq = up / 22, pm = pq + pq / 7 + 1;
        const float* hc = HT + (size_t)(pm * 22 + pn) * 1024; const float* hp = HT + (size_t)((pm - 1) * 22 + pn) * 1024;
        f32x4 y[2];
#pragma unroll
        for (int hh = 0; hh < 2; ++hh) { const int c = hh * 128 + f; const int F = hh * FF + 128 * pn + f;
            const f32x4 h0 = *(const f32x4*)(hc + c), h1 = *(const f32x4*)(hc + 256 + c), t0 = *(const f32x4*)(hp + 512 + c), t1 = *(const f32x4*)(hp + 768 + c);
            const f32x4 x0 = r ? h1 : h0, xm1 = r ? h0 : t1, xm2 = r ? t1 : t0;
            y[hh] = *(const f32x4*)(cb + F) + *(const f32x4*)(cw + F) * xm2 + *(const f32x4*)(cw + FF2 + F) * xm1 + *(const f32x4*)(cw + 2 * FF2 + F) * x0; }
        float v[4];
#pragma unroll
        for (int e = 0; e < 4; ++e) v[e] = y[0][e] * __builtin_amdgcn_rcpf(1.0f + __builtin_amdgcn_exp2f(-1.4426950408889634f * y[0][e])) * y[1][e];
        u32x2 w; w.x = pk2(v[0], v[1]); w.y = pk2(v[2], v[3]);
        *(u32x2*)(Gb + (size_t)(pm * 256 + r) * FF + 128 * pn + f) = w;
    }
}

__device__ __forceinline__ void attn_phase(LAS unsigned char* lds, const bf16* Q, const bf16* K, const bf16* V, bf16* O, int cu, int G, int rev) {
    const int tid = opaque_tid(), lane = tid & 63, wid = __builtin_amdgcn_readfirstlane(tid >> 6), q32 = lane & 31, hi = lane >> 5, li = lane & 15;
    LAS unsigned char* Ks = lds + wid * 10752;
    LAS unsigned char* Vs = Ks + 4608;
    const int lkey = lane >> 3, lch = lane & 7;
    const float LOG2E = 1.4426950408889634f;
    for (int k = 0; k < 16; ++k) {
        const int idx = cu * 8 + wid + 2048 * (k & 3), b = 4 * (idx & 7) + (rev ? 3 - (k >> 2) : (k >> 2)), h = (idx >> 3) & 15, qb = idx >> 7;
        const size_t rowbase = (size_t)b * SEQ;
        const int q0w = qb * 32;
        bf16x8 qf[4];
        { const bf16* qp = Q + (rowbase + q0w + q32) * DM + h * HD + hi * 8;
#pragma unroll
          for (int ks = 0; ks < 4; ++ks) qf[ks] = *(const bf16x8*)(qp + ks * 16); }
        f32x16 o0, o1;
#pragma unroll
        for (int r = 0; r < 16; ++r) { o0[r] = 0.f; o1[r] = 0.f; }
        float R = 0.f;
        const bf16* kp = K + (rowbase + lkey) * DM + h * HD + lch * 8;
        const bf16* vp = V + (rowbase + lkey) * DM + h * HD + lch * 8;
        u32x4 kr[4], vr[4];
#pragma unroll
        for (int jj = 0; jj < 4; ++jj) { kr[jj] = *(const u32x4*)(kp + (size_t)(q0w + 8 * jj) * DM); vr[jj] = *(const u32x4*)(vp + (size_t)(q0w + 8 * jj) * DM); }
        for (int key0 = q0w; key0 >= 0; key0 -= 32) {
#pragma unroll
            for (int jj = 0; jj < 4; ++jj) { *(LAS u32x4*)(Ks + (lkey + 8 * jj) * 144 + lch * 16) = kr[jj]; *(LAS u32x4*)(Vs + (lkey + 8 * jj) * 192 + lch * 16) = vr[jj]; }
            asm volatile("s_waitcnt lgkmcnt(0)" ::: "memory");
            if (key0 >= 32) {
#pragma unroll
                for (int jj = 0; jj < 4; ++jj) { kr[jj] = *(const u32x4*)(kp + (size_t)(key0 - 32 + 8 * jj) * DM); vr[jj] = *(const u32x4*)(vp + (size_t)(key0 - 32 + 8 * jj) * DM); } }
            const bool diag = (key0 == q0w);
            f32x16 s;
#pragma unroll
            for (int r = 0; r < 16; ++r) s[r] = 0.f;
#pragma unroll
            for (int ks = 0; ks < 4; ++ks) { const bf16x8 kf = *(LAS const bf16x8*)(Ks + q32 * 144 + (16 * ks + 8 * hi) * 2);
                s = __builtin_amdgcn_mfma_f32_32x32x16_bf16(kf, qf[ks], s, 0, 0, 0); }
            float zs[16], l1[16];
#pragma unroll
            for (int r = 0; r < 16; ++r) { const float z = s[r] * LOG2E; const float e = __builtin_amdgcn_exp2f(-__builtin_fabsf(z)); const float t = __builtin_amdgcn_logf(1.0f + e);
                float l = -(__builtin_fmaxf(z, 0.f) + t);
                if (diag) { const int kl = 8 * (r >> 2) + 4 * hi + (r & 3); if (kl >= q32) l = 0.f; }
                zs[r] = z; l1[r] = l; }
            float G0[4], G1[4];
#pragma unroll
            for (int j = 0; j < 4; ++j) { const float gs = (l1[4 * j] + l1[4 * j + 1]) + (l1[4 * j + 2] + l1[4 * j + 3]);
                auto rr = __builtin_amdgcn_permlane32_swap(__float_as_uint(gs), __float_as_uint(gs), false, false); G0[j] = __uint_as_float(rr[0]); G1[j] = __uint_as_float(rr[1]); }
            float p[16]; float run = R;
#pragma unroll
            for (int j = 3; j >= 0; --j) { float sfx = run + (hi == 0 ? G1[j] : 0.f);
#pragma unroll
                for (int e = 3; e >= 0; --e) { const int r = 4 * j + e; float val = __builtin_amdgcn_exp2f(l1[r] + zs[r] + sfx);
                    if (diag) { const int kl = 8 * j + 4 * hi + e; if (kl >= q32) val = 0.f; }
                    p[r] = val; sfx += l1[r]; }
                run += G0[j] + G1[j]; }
            R = run;
#pragma unroll
            for (int ks2 = 0; ks2 < 2; ++ks2) {
                u32x4 pw; pw.x = pk2(p[8 * ks2], p[8 * ks2 + 1]); pw.y = pk2(p[8 * ks2 + 2], p[8 * ks2 + 3]); pw.z = pk2(p[8 * ks2 + 4], p[8 * ks2 + 5]); pw.w = pk2(p[8 * ks2 + 6], p[8 * ks2 + 7]);
                const bf16x8 pb = __builtin_bit_cast(bf16x8, pw);
#pragma unroll
                for (int dh = 0; dh < 2; ++dh) {
                    LAS const unsigned char* va = Vs + (16 * ks2 + 4 * hi + (li >> 2)) * 192 + (32 * dh + 16 * ((lane >> 4) & 1) + 4 * (li & 3)) * 2;
                    const s16x4 lo = vtr(va), hi4 = vtr(va + 8 * 192);
                    const bf16x8 vf = (bf16x8){lo[0], lo[1], lo[2], lo[3], hi4[0], hi4[1], hi4[2], hi4[3]};
                    if (dh == 0) o0 = __builtin_amdgcn_mfma_f32_32x32x16_bf16(vf, pb, o0, 0, 0, 0);
                    else         o1 = __builtin_amdgcn_mfma_f32_32x32x16_bf16(vf, pb, o1, 0, 0, 0);
                }
            }
            asm volatile("s_waitcnt lgkmcnt(0)" ::: "memory");
            if (__all(R < -150.0f)) break;
        }
        bf16* op = O + (rowbase + q0w + q32) * DM + h * HD + 4 * hi;
#pragma unroll
        for (int j = 0; j < 4; ++j) { u32x2 w0, w1; w0.x = pk2(o0[4 * j], o0[4 * j + 1]); w0.y = pk2(o0[4 * j + 2], o0[4 * j + 3]); w1.x = pk2(o1[4 * j], o1[4 * j + 1]); w1.y = pk2(o1[4 * j + 2], o1[4 * j + 3]);
            *(u32x2*)(op + 8 * j) = w0; *(u32x2*)(op + 32 + 8 * j) = w1; }
    }
    __syncthreads();
}

__device__ __forceinline__ void spatial_phase(LAS unsigned char* lds, const bf16* ZZ, bf16* GT, const bf16* Wc, const float* bs, const float* gam, const float* bet, const float* VST, int cu, int G, int rev) {
    const int tid = opaque_tid(), lane = tid & 63, wid = __builtin_amdgcn_readfirstlane(tid >> 6), fr = lane & 15, kg = lane >> 4;
    LAS float* st = (LAS float*)(lds + 69632);
    const int wr = wid >> 2, wc = wid & 3;
    for (int k = 0; k < 2; ++k) {
        const int cls = 2 * k + (cu >> 7); const int chunk = 64 * (cu & 7) + 16 * (rev ? 3 - cls : cls) + ((cu >> 3) & 15);
        const size_t row0 = (size_t)chunk * GC;
        __syncthreads();
        { const int row = tid >> 2, part = tid & 3;
          const f32x4 a = *(const f32x4*)(VST + (row0 + row) * 16 + part * 4);
          float sm = a[0] + a[2], sq = a[1] + a[3];
          sm += __shfl_xor(sm, 1); sm += __shfl_xor(sm, 2); sq += __shfl_xor(sq, 1); sq += __shfl_xor(sq, 2);
          if (part == 0) { const float mean = sm * (1.f / GW); st[2 * row] = mean; st[2 * row + 1] = 1.f / sqrtf(sq * (1.f / GW) - mean * mean + LN_EPS); } }
        const int c8 = tid & 31, srow = tid >> 5;
        LAS unsigned char* const wl = lds + 72704;
        const int wt = tid >> 2, wq = tid & 3;
        u32x4 nv[8], nw[4];
#pragma unroll
        for (int it = 0; it < 8; ++it) nv[it] = *(const u32x4*)(ZZ + (row0 + it * 16 + srow) * 4096 + GW + c8 * 8);
#pragma unroll
        for (int q = 0; q < 4; ++q) nw[q] = *(const u32x4*)(Wc + (size_t)wt * GC + wq * 32 + q * 8);
        for (int g = 0; g < GG; ++g) {
            __syncthreads();
            { const float* gp = gam + g * 256 + c8 * 8; const float* bp = bet + g * 256 + c8 * 8;
              const f32x4 ga = *(const f32x4*)gp, gb = *(const f32x4*)(gp + 4), ba = *(const f32x4*)bp, bb = *(const f32x4*)(bp + 4);
#pragma unroll
              for (int q = 0; q < 4; ++q) *(LAS u32x4*)(wl + wt * 272 + wq * 64 + q * 16) = nw[q];
#pragma unroll
              for (int it = 0; it < 8; ++it) { const int s = it * 16 + srow;
                  const u32x4 w = nv[it];
                  const float mean = st[2 * s], rstd = st[2 * s + 1];
                  u32x4 o;
                  o.x = pk2((bflo(w.x) - mean) * rstd * ga.x + ba.x, (bfhi(w.x) - mean) * rstd * ga.y + ba.y);
                  o.y = pk2((bflo(w.y) - mean) * rstd * ga.z + ba.z, (bfhi(w.y) - mean) * rstd * ga.w + ba.w);
                  o.z = pk2((bflo(w.z) - mean) * rstd * gb.x + bb.x, (bfhi(w.z) - mean) * rstd * gb.y + bb.y);
                  o.w = pk2((bflo(w.w) - mean) * rstd * gb.z + bb.z, (bfhi(w.w) - mean) * rstd * gb.w + bb.w);
                  *(LAS u32x4*)(lds + s * 544 + c8 * 16) = o; } }
            __syncthreads();
            if (g + 1 < GG) {
#pragma unroll
                for (int it = 0; it < 8; ++it) nv[it] = *(const u32x4*)(ZZ + (row0 + it * 16 + srow) * 4096 + GW + (g + 1) * 256 + c8 * 8);
#pragma unroll
                for (int q = 0; q < 4; ++q) nw[q] = *(const u32x4*)(Wc + (size_t)(g + 1) * GC * GC + (size_t)wt * GC + wq * 32 + q * 8); }
            u32x2 uu[4][4];
#pragma unroll
            for (int tb = 0; tb < 4; ++tb)
#pragma unroll
                for (int cb = 0; cb < 4; ++cb) uu[tb][cb] = *(const u32x2*)(ZZ + (row0 + 64 * wr + 16 * tb + fr) * 4096 + g * 256 + 64 * wc + 16 * cb + 4 * kg);
            f32x4 acc[4][4];
#pragma unroll
            for (int a = 0; a < 4; ++a)
#pragma unroll
                for (int b2 = 0; b2 < 4; ++b2) acc[a][b2] = (f32x4){0.f, 0.f, 0.f, 0.f};
#pragma unroll
            for (int ks = 0; ks < 4; ++ks) {
                if (32 * ks <= 64 * wr + 63) {
                    bf16x8 X[4], Y[4];
#pragma unroll
                    for (int tb = 0; tb < 4; ++tb) { LAS const unsigned char* wp = wl + (64 * wr + 16 * tb + fr) * 272 + (32 * ks + 4 * kg) * 2;
                        const u32x2 a = *(LAS const u32x2*)wp, b2 = *(LAS const u32x2*)(wp + 32); const u32x4 w = (u32x4){a.x, a.y, b2.x, b2.y}; Y[tb] = __builtin_bit_cast(bf16x8, w); }
#pragma unroll
                    for (int cb = 0; cb < 4; ++cb) { LAS const unsigned char* xa = lds + (32 * ks + 4 * kg + (fr >> 2)) * 544 + (64 * wc + 16 * cb + 4 * (fr & 3)) * 2;
                        const s16x4 lo = vtr(xa), hi4 = vtr(xa + 16 * 544);
                        X[cb] = (bf16x8){lo[0], lo[1], lo[2], lo[3], hi4[0], hi4[1], hi4[2], hi4[3]}; }
#pragma unroll
                    for (int tb = 0; tb < 4; ++tb)
#pragma unroll
                        for (int cb = 0; cb < 4; ++cb) acc[tb][cb] = __builtin_amdgcn_mfma_f32_16x16x32_bf16(X[cb], Y[tb], acc[tb][cb], 0, 0, 0);
                }
            }
#pragma unroll
            for (int tb = 0; tb < 4; ++tb) { const int t = 64 * wr + 16 * tb + fr; const float bsv = bs[g * GC + t];
#pragma unroll
                for (int cb = 0; cb < 4; ++cb) { const int c = g * 256 + 64 * wc + 16 * cb + 4 * kg;
                    const u32x2 u = uu[tb][cb];
                    u32x2 o; o.x = pk2(bflo(u.x) * (acc[tb][cb][0] + bsv), bfhi(u.x) * (acc[tb][cb][1] + bsv)); o.y = pk2(bflo(u.y) * (acc[tb][cb][2] + bsv), bfhi(u.y) * (acc[tb][cb][3] + bsv));
                    *(u32x2*)(GT + (row0 + t) * GW + c) = o; } }
        }
    }
}

#ifndef PROBE
#define PROBE 0
#endif
#ifndef G2_REV
#define G2_REV 1
#endif
__device__ __forceinline__ void gbar(unsigned* ctr, unsigned target) {
    asm volatile("s_waitcnt vmcnt(0)" ::: "memory");
    __syncthreads();
    if (threadIdx.x == 0) {
        __builtin_amdgcn_fence(__ATOMIC_RELEASE, "agent");
        asm volatile("s_waitcnt vmcnt(0)" ::: "memory");
        __hip_atomic_fetch_add(ctr, 1u, __ATOMIC_RELAXED, __HIP_MEMORY_SCOPE_AGENT);
        while (__hip_atomic_load(ctr, __ATOMIC_RELAXED, __HIP_MEMORY_SCOPE_AGENT) < target) __builtin_amdgcn_s_sleep(1);
        __builtin_amdgcn_fence(__ATOMIC_ACQUIRE, "agent");
        asm volatile("s_waitcnt vmcnt(0)" ::: "memory");
    }
    __syncthreads();
}
#define GSYNC() do { bar_target += (unsigned)G; gbar(bar_ctr, bar_target); if (PROBE == 7) { bar_target += (unsigned)G; gbar(bar_ctr, bar_target); } } while (0)
__global__ void __launch_bounds__(512, 2) fwd_kernel(Args args) {
    extern __shared__ __attribute__((aligned(16))) unsigned char lds_raw[];
    cg::grid_group grid = cg::this_grid();
    LAS unsigned char* lds = (LAS unsigned char*)lds_raw;
    const int G = gridDim.x, cu = blockIdx.x, ngw = G * 8;
    unsigned char* ws = args.ws;
    const float* x = args.in[0];
    float* out = args.out;
    bf16* HB = (bf16*)(ws + WS_HB);
    unsigned* bar_ctr = (unsigned*)(ws + WS_CTL); unsigned bar_target = 0u;
    if (cu == 0 && threadIdx.x < 8) __hip_atomic_store((unsigned*)(ws + WS_CTL + 8192) + 64 * threadIdx.x, 0u, __ATOMIC_RELAXED, __HIP_MEMORY_SCOPE_AGENT);
    if (cu == 0 && threadIdx.x == 0) __hip_atomic_store(bar_ctr, 0u, __ATOMIC_RELAXED, __HIP_MEMORY_SCOPE_AGENT);

    for (int rep = 0; rep < (PROBE == 8 ? 2 : 1); ++rep) {
        const int tid = opaque_tid(), lane = tid & 63, wave = __builtin_amdgcn_readfirstlane(tid >> 6), gw = cu * 8 + wave;
        LAS float* scr = (LAS float*)(lds + wave * 16384);
        for (int mat = 0; mat < 16; ++mat) {
            const float* W; bf16* WT; int K, N, perm = 0;
            if (mat < 2)       { W = args.in[1] + (size_t)mat * DM * 3072;        WT = (bf16*)(ws + WS_ATTN_IN) + (size_t)mat * 3072 * DM;        K = DM; N = 3072; }
            else if (mat < 4)  { W = args.in[2] + (size_t)(mat - 2) * DM * DM;    WT = (bf16*)(ws + WS_ATTN_OUT) + (size_t)(mat - 2) * DM * DM;   K = DM; N = DM; }
            else if (mat < 6)  { W = args.in[3] + (size_t)(mat - 4) * DM * 4096;  WT = (bf16*)(ws + WS_GMLP_IN) + (size_t)(mat - 4) * 4096 * DM;  K = DM; N = 4096; }
            else if (mat < 8)  { W = args.in[8] + (size_t)(mat - 6) * GW * DM;    WT = (bf16*)(ws + WS_GMLP_OUT) + (size_t)(mat - 6) * DM * GW;   K = GW; N = DM; }
            else if (mat < 12) { W = args.in[9] + (size_t)(mat - 8) * DM * FF2;   WT = (bf16*)(ws + WS_FFN_UP) + (size_t)(mat - 8) * FF2 * DM;    K = DM; N = FF2; perm = 1; }
            else               { W = args.in[12] + (size_t)(mat - 12) * FF * DM;  WT = (bf16*)(ws + WS_FFN_DOWN) + (size_t)(mat - 12) * DM * FF;  K = FF; N = DM; }
            const int nitems = (K / 64) * (N / 32);
            for (int it = gw; it < nitems; it += ngw) transpose_item(W, K, N, WT, perm, scr, it, lane);
        }
        { const float* wsrc = args.in[6]; bf16* wd = (bf16*)(ws + WS_WS);
          for (int i = cu * 512 + tid; i < 2 * GG * GC * GC; i += G * 512) { const int s = i & 127, t = (i >> 7) & 127; const float v = (s <= t) ? wsrc[i] : 0.f; wd[i] = (bf16)(pk2(v, v) & 0xffffu); } }
        for (int m = gw; m < NTOK; m += ngw) {
            const f32x4* xr = (const f32x4*)(x + (size_t)m * DM) + lane; u32x2* o8 = (u32x2*)(HB + (size_t)m * DM) + lane;
#pragma unroll
            for (int j = 0; j < 4; ++j) { const f32x4 v = xr[64 * j]; u32x2 w; w.x = pk2(v.x, v.y); w.y = pk2(v.z, v.w); o8[64 * j] = w;
                typedef _Float16 h16x2 __attribute__((ext_vector_type(2))); const h16x2 ha = {(_Float16)v.x, (_Float16)v.y}, hc = {(_Float16)v.z, (_Float16)v.w};
                u32x2 w2; w2.x = __builtin_bit_cast(unsigned, ha); w2.y = __builtin_bit_cast(unsigned, hc); ((u32x2*)((unsigned short*)out + (size_t)m * DM) + lane)[64 * j] = w2; }
        }
    }
    grid.sync();

    int dir = 0;
    for (int layer = 0; layer < DEPTH; ++layer) {
        const int j = layer >> 1, mixer = layer & 1;
        for (int step = 0; step < 2; ++step) {
            if (step == 0) {
                pg8::Gemm g; pg8::EpiBf16 E;
                if (mixer == 0) { g = pg8::Gemm{HB, (const bf16*)(ws + WS_ATTN_IN) + (size_t)j * 3072 * DM, NTOK, 3072, DM};
                    E = pg8::EpiBf16{(bf16*)(ws + WS_Q), DM, 0, DM, (size_t)NTOK * DM, 0.125f, nullptr, nullptr}; }
                else { g = pg8::Gemm{HB, (const bf16*)(ws + WS_GMLP_IN) + (size_t)j * 4096 * DM, NTOK, 4096, DM};
                    E = pg8::EpiBf16{(bf16*)(ws + WS_ZZ), 4096, 1, 0, 0, 1.f, (float*)(ws + WS_VST), (LAS float*)(lds + 131072)}; }
                pg8::StaticOrder S; S.rev = dir; dir ^= 1; S.init(g.M, g.N, G, cu);
                for (int rep = 0; rep < (PROBE == 1 ? 2 : 1); ++rep)
                pg8::gemm_phase<pg8::EpiBf16, pg8::StaticOrder, true, true>(lds, g, S, E);
            } else {
                pg8::Gemm g{HB, (const bf16*)(ws + WS_FFN_UP) + (size_t)layer * FF2 * DM, NTOK, FF2, DM};
                pg8::EpiConv E{(bf16*)(ws + WS_G), args.in[10] + (size_t)layer * 3 * FF2, args.in[11] + (size_t)layer * FF2, lds + 131072, FF, FF2, FF, (float*)(ws + WS_HT)};
                pg8::StaticOrder S; S.rev = dir; dir ^= 1; S.init(g.M, g.N, G, cu);
                for (int rep = 0; rep < (PROBE == 4 ? 2 : 1); ++rep)
                pg8::gemm_phase<pg8::EpiConv, pg8::StaticOrder, true, true>(lds, g, S, E);
                GSYNC();
                ffn_fix_phase((const float*)(ws + WS_HT), (bf16*)(ws + WS_G), args.in[10] + (size_t)layer * 3 * FF2, args.in[11] + (size_t)layer * FF2, cu, G, opaque_tid());
            }
            GSYNC();
            if (step == 0) {
                for (int rep = 0; rep < (((PROBE == 2 && mixer == 0) || (PROBE == 3 && mixer == 1)) ? 2 : 1); ++rep)
                if (mixer == 0) attn_phase(lds, (const bf16*)(ws + WS_Q), (const bf16*)(ws + WS_K), (const bf16*)(ws + WS_V), (bf16*)(ws + WS_O), cu, G, dir);
                else spatial_phase(lds, (const bf16*)(ws + WS_ZZ), (bf16*)(ws + WS_GT), (const bf16*)(ws + WS_WS) + (size_t)j * GG * GC * GC, args.in[7] + j * GG * GC, args.in[4] + j * GW, args.in[5] + j * GW, (const float*)(ws + WS_VST), cu, G, dir); dir ^= 1;
                GSYNC();
            }
            const int lnidx = 2 * layer + step;
            {
                pg8::Gemm g;
                if (step == 0 && mixer == 0) g = pg8::Gemm{(const bf16*)(ws + WS_O), (const bf16*)(ws + WS_ATTN_OUT) + (size_t)j * DM * DM, NTOK, DM, DM};
                else if (step == 0) g = pg8::Gemm{(const bf16*)(ws + WS_GT), (const bf16*)(ws + WS_GMLP_OUT) + (size_t)j * DM * GW, NTOK, DM, GW};
                else g = pg8::Gemm{(const bf16*)(ws + WS_G), (const bf16*)(ws + WS_FFN_DOWN) + (size_t)layer * DM * FF, NTOK, DM, FF};
                const int pl = (lnidx - 1) >> 1;
                const float* pgam = lnidx == 0 ? nullptr : (((lnidx - 1) & 1) ? args.in[15] : args.in[13]) + pl * DM;
                const float* pbet = lnidx == 0 ? nullptr : (((lnidx - 1) & 1) ? args.in[16] : args.in[14]) + pl * DM;
                const float* cgam = (step == 0 ? args.in[13] : args.in[15]) + layer * DM;
                const float* cbet = (step == 0 ? args.in[14] : args.in[16]) + layer * DM;
                const bool lastln = lnidx == 2 * DEPTH - 1;
                pg8::EpiResLn E{lastln ? (const unsigned short*)HB : (const unsigned short*)out, lastln ? 1 : 0, out, (float*)(ws + WS_ST), cgam, cbet, HB, (unsigned short*)out,
                                (unsigned*)(ws + WS_CTL + 8192), 128u * (unsigned)lnidx, lastln ? 1 : 0, lds + 131072, dir};
                pg8::StaticOrder S; S.rev = dir; dir ^= 1; S.init(g.M, g.N, G, cu);
                if (PROBE == 9) { pg8::EpiBf16 E0{(bf16*)(ws + WS_R + (step == 1 ? 512 * MiB : 0)), DM, 0, 0, 0, 1.f};
                    pg8::gemm_phase<pg8::EpiBf16, pg8::StaticOrder, true, true>(lds, g, S, E0); }
                pg8::gemm_phase<pg8::EpiResLn, pg8::StaticOrder, true, true>(lds, g, S, E);
            }
            if (lnidx != 2 * DEPTH - 1) GSYNC();
        }
    }
}

extern "C" void kernel_launch(void* const* d_in, const int* in_sizes, int n_in, void* d_out, int out_size, void* d_ws, size_t ws_size, hipStream_t stream) {
    static int grid = 0;
    if (grid == 0) {
        if (n_in != 17 || out_size != NTOK * DM || ws_size < WS_END) { fprintf(stderr, "kernel_launch: unexpected shapes (n_in %d, out %d, ws %zu)\n", n_in, out_size, ws_size); grid = -1; return; }
        int dev = 0, cus = 0, per_cu = 0;
        hipGetDevice(&dev);
        hipDeviceGetAttribute(&cus, hipDeviceAttributeMultiprocessorCount, dev);
        if (hipFuncSetAttribute((const void*)fwd_kernel, hipFuncAttributeMaxDynamicSharedMemorySize, LDS_BYTES) != hipSuccess) { fprintf(stderr, "kernel_launch: hipFuncSetAttribute failed\n"); grid = -1; return; }
        if (hipOccupancyMaxActiveBlocksPerMultiprocessor(&per_cu, (const void*)fwd_kernel, 512, LDS_BYTES) != hipSuccess || per_cu < 1) { fprintf(stderr, "kernel_launch: occupancy query says %d\n", per_cu); per_cu = 1; }
        (void)hipGetLastError();
        grid = cus * per_cu;
        fprintf(stderr, "kernel_launch: grid %d (cus %d x %d)\n", grid, cus, per_cu);
        if (grid != 256) { fprintf(stderr, "kernel_launch: the fused LayerNorm epilogue's group barrier is laid out for a 256-workgroup grid; nothing launched\n"); grid = -1; return; }
    }
    if (grid < 0) return;
    Args a{};
    for (int i = 0; i < 17; ++i) a.in[i] = (const float*)d_in[i];
    a.out = (float*)d_out; a.ws = (unsigned char*)d_ws;
    void* kargs[] = {&a};
    hipError_t e = hipLaunchCooperativeKernel((const void*)fwd_kernel, dim3(grid), dim3(512), kargs, LDS_BYTES, stream);
    if (e != hipSuccess) fprintf(stderr, "cooperative launch failed: %s (grid %d)\n", hipGetErrorString(e), grid);
}
```

```cpp
#include <hip/hip_runtime.h>
#include <hip/hip_cooperative_groups.h>
#include <cstdio>
#include <cstdint>
namespace cg = cooperative_groups;
__device__ __forceinline__ int opaque_tid() { int t = threadIdx.x; asm volatile("" : "+v"(t)); return t; }
namespace pg8 {
#define PG8_LAS __attribute__((address_space(3)))
typedef unsigned short bf16_t;
typedef short bf16x8 __attribute__((ext_vector_type(8)));
typedef float f32x4 __attribute__((ext_vector_type(4)));
typedef unsigned u32x4 __attribute__((ext_vector_type(4)));
constexpr int BM = 256, BK = 64, HALF = 128, HTB = HALF * BK * 2  , STAGE_BYTES = 8 * HTB, NXCD = 8, WGM = 8;

__host__ __device__ __forceinline__ int lds_byte(int r, int c) { const int st = (r >> 4) * 2 + (c >> 5), rr = r & 15, cc = c & 31, ob = rr * 64 + cc * 2; return st * 1024 + (ob ^ (((ob >> 9) & 1) << 5)); }
__host__ __device__ __forceinline__ void stage_rc(int b, int& R, int& C) { const int st = b / 1024, sb = b % 1024, swz = sb ^ (((sb >> 9) & 1) << 5); R = (st >> 1) * 16 + swz / 64; C = (st & 1) * 32 + (swz % 64) / 2; }
__host__ __device__ __forceinline__ int perm32(int rho) { const int n = rho >> 4, i = rho & 15; return 8 * (i >> 2) + 4 * n + (i & 3); }

struct Unit { int pm, pn; };
struct Gemm { const bf16_t* A; const bf16_t* Bt; int M, N, K; };

struct StaticOrder {
    int nM, nN, nwg, G, c, rev = 0;
    __host__ __device__ void init(int M, int N, int G_, int c_) { nM = M / BM; nN = N / BM; nwg = nM * nN; G = G_; c = c_; }
    __host__ __device__ bool next(int i, Unit& u) const {
        if ((long)i * G + c >= nwg) return false;
        const long L = (long)(rev ? (nwg / G - 1 - i) : i) * G + c;
        int wgid = (int)L; { const int q = nwg / NXCD, r = nwg % NXCD, xcd = wgid % NXCD, off = wgid / NXCD; wgid = (xcd < r ? xcd * (q + 1) : r * (q + 1) + (xcd - r) * q) + off; }
        const int nig = WGM * nN, gid = wgid / nig, fm = gid * WGM, gsz = (nM - fm) < WGM ? (nM - fm) : WGM;
        u.pm = fm + ((wgid % nig) % gsz); u.pn = (wgid % nig) / gsz; return true;
    }
    __device__ __forceinline__ void a_ready(const Unit&) const {}
    __device__ __forceinline__ void done(const Unit&) const {}
};
__device__ __forceinline__ unsigned cvt_pk_bf16(float lo, float hi) { unsigned r; asm volatile("v_cvt_pk_bf16_f32 %0, %1, %2" : "=v"(r) : "v"(lo), "v"(hi)); return r; }
typedef float f32x2 __attribute__((ext_vector_type(2)));
typedef _Float16 f16x8 __attribute__((ext_vector_type(8)));
template <bool F16> __device__ __forceinline__ f32x4 mma16(bf16x8 a, bf16x8 b, f32x4 c) {
    if constexpr (F16) return __builtin_amdgcn_mfma_f32_16x16x32_f16(__builtin_bit_cast(f16x8, a), __builtin_bit_cast(f16x8, b), c, 0, 0, 0);
    else return __builtin_amdgcn_mfma_f32_16x16x32_bf16(a, b, c, 0, 0, 0);
}
__device__ __forceinline__ unsigned cvt_pk_f16(float lo, float hi) { typedef _Float16 h2 __attribute__((ext_vector_type(2))); const h2 v = {(_Float16)lo, (_Float16)hi}; return __builtin_bit_cast(unsigned, v); }
typedef unsigned u32x2e __attribute__((ext_vector_type(2)));
__device__ __forceinline__ float gelu_tanh(float x) {
    const float t = x * (-2.302208198f + (-0.1029432397f) * x * x);
    return x * __builtin_amdgcn_rcpf(1.0f + __builtin_amdgcn_exp2f(t));
}
struct EpiBf16 {
    static constexpr bool PERM = true, AFTER_DRAIN = false, F16 = true;
    bf16_t* O; int ldc; int act; int split_cols; size_t split_stride; float scale0;
    float* vst; PG8_LAS float* sl;
    __device__ __forceinline__ void operator()(const f32x4 (&acc)[2][2][4][2], const Unit& u, int wr, int wc, int fr, int fq) const {
        const int row0 = u.pm * BM + wr * 64 + fr; int colt = u.pn * BM; bf16_t* base = O;
        float sc = 1.f; if (split_cols) { const int t = colt / split_cols; base += (size_t)t * split_stride; colt -= t * split_cols; if (t == 0) sc = scale0; }
        const int col0 = colt + wc * 32 + 8 * fq;
        const bool dost = vst != nullptr && u.pn >= 8;
#pragma unroll
        for (int ai = 0; ai < 2; ++ai)
#pragma unroll
            for (int m = 0; m < 4; ++m) { bf16_t* rowp = base + (size_t)(row0 + ai * HALF + m * 16) * ldc + col0; float rs = 0.f, rq = 0.f;
#pragma unroll
                for (int bj = 0; bj < 2; ++bj) { f32x4 v0 = acc[ai][bj][m][0], v1 = acc[ai][bj][m][1];
                    if (act) { v0 = (f32x4){gelu_tanh(v0[0]), gelu_tanh(v0[1]), gelu_tanh(v0[2]), gelu_tanh(v0[3])};
                               v1 = (f32x4){gelu_tanh(v1[0]), gelu_tanh(v1[1]), gelu_tanh(v1[2]), gelu_tanh(v1[3])}; }
                    if (dost) { rs += ((v0[0] + v0[1]) + (v0[2] + v0[3])) + ((v1[0] + v1[1]) + (v1[2] + v1[3]));
                                rq += ((v0[0] * v0[0] + v0[1] * v0[1]) + (v0[2] * v0[2] + v0[3] * v0[3])) + ((v1[0] * v1[0] + v1[1] * v1[1]) + (v1[2] * v1[2] + v1[3] * v1[3])); }
                    v0 = v0 * sc; v1 = v1 * sc; u32x4 w; w.x = cvt_pk_bf16(v0[0], v0[1]); w.y = cvt_pk_bf16(v0[2], v0[3]); w.z = cvt_pk_bf16(v1[0], v1[1]); w.w = cvt_pk_bf16(v1[2], v1[3]);
                    *(u32x4*)(rowp + bj * HALF) = w; }
                if (dost) { rs += __shfl_xor(rs, 16); rs += __shfl_xor(rs, 32); rq += __shfl_xor(rq, 16); rq += __shfl_xor(rq, 32);
                    const int lrow = ai * HALF + wr * 64 + m * 16 + fr; if (fq == 0) { sl[(lrow * 4 + wc) * 2] = rs; sl[(lrow * 4 + wc) * 2 + 1] = rq; } } }
        if (dost) {
            asm volatile("s_waitcnt lgkmcnt(0)" ::: "memory"); __builtin_amdgcn_s_barrier(); asm volatile("" ::: "memory");
            const int t = opaque_tid();
            if (t < 256) { const f32x4 a = *(PG8_LAS const f32x4*)(sl + t * 8), b = *(PG8_LAS const f32x4*)(sl + t * 8 + 4);
                typedef float f32x2v __attribute__((ext_vector_type(2)));
                *(f32x2v*)(vst + ((size_t)u.pm * BM + t) * 16 + (u.pn - 8) * 2) = (f32x2v){(a[0] + a[2]) + (b[0] + b[2]), (a[1] + a[3]) + (b[1] + b[3])}; }
        }
    }
};
struct EpiRes {
    static constexpr bool PERM = false, AFTER_DRAIN = false, F16 = false;
    const float* base; float* out; int ldc; float alpha;
    __device__ __forceinline__ void operator()(const f32x4 (&acc)[2][2][4][2], const Unit& u, int wr, int wc, int fr, int fq) const {
        const int col0 = u.pn * BM + wc * 32 + 4 * fq;
#pragma unroll
        for (int ai = 0; ai < 2; ++ai)
#pragma unroll
            for (int m = 0; m < 4; ++m) { const size_t off = (size_t)(u.pm * BM + ai * HALF + wr * 64 + m * 16 + fr) * ldc + col0;
#pragma unroll
                for (int bj = 0; bj < 2; ++bj)
#pragma unroll
                    for (int n = 0; n < 2; ++n) { const f32x4 bs = *(const f32x4*)(base + off + bj * HALF + n * 16);
                        *(f32x4*)(out + off + bj * HALF + n * 16) = bs * alpha + acc[ai][bj][m][n]; }
                asm volatile("" ::: "memory"); }
    }
};

template <int CTRL> __device__ __forceinline__ float dpp_mov(float old, float src) {
    return __builtin_bit_cast(float, __builtin_amdgcn_update_dpp(__builtin_bit_cast(int, old), __builtin_bit_cast(int, src), CTRL, 0xf, 0xf, false));
}
struct SeqOrder {
    int G, c;
    __device__ bool next(int i, Unit& u) const { if (i >= 22) return false; int it, step;
        if (i < 16) { it = c + G * (i >> 3); step = i & 7; } else { const int v = 6 * c + (i - 16); it = 512 + (v >> 3); step = v & 7; }
        u.pn = it >> 5; u.pm = 8 * (it & 31) + step; return true; }
    __device__ __forceinline__ void a_ready(const Unit&) const {}
    __device__ __forceinline__ void done(const Unit&) const {}
};
struct EpiConv {
    static constexpr bool PERM = true, AFTER_DRAIN = false, F16 = true;
    bf16_t* O; const float* cw; const float* cb; PG8_LAS unsigned char* hl; int ldo, ncol2, nfeat; float* ht;
    __device__ __forceinline__ void operator()(const f32x4 (&acc)[2][2][4][2], const Unit& u, int wr, int wc, int fr, int fq) const {
        const int lcol = wc * 32 + 8 * fq;
        { const int t = opaque_tid();
          if (t < 256) { const int p = t >> 5, ch = t & 31, pp = p & 3; const float* src = (pp < 3 ? cw + pp * ncol2 : cb) + (p >> 2) * nfeat + 128 * u.pn + 4 * ch;
              *(PG8_LAS f32x4*)(hl + 10240 + (p * 128 + 4 * ch) * 4) = *(const f32x4*)src; } }
        float* const htu = ht + (size_t)(u.pm * 22 + u.pn) * 1024;
        if (fr >= 14) {
#pragma unroll
            for (int ai = 0; ai < 2; ++ai) { const int k = 2 * ai + wr;
                if (k < 3) { PG8_LAS unsigned char* hp = hl + k * 2048 + (fr - 14) * 1024 + lcol * 4;
#pragma unroll
                    for (int bj = 0; bj < 2; ++bj)
#pragma unroll
                        for (int n = 0; n < 2; ++n) *(PG8_LAS f32x4*)(hp + bj * 512 + n * 16) = acc[ai][bj][3][n]; }
                else {
#pragma unroll
                    for (int bj = 0; bj < 2; ++bj)
#pragma unroll
                        for (int n = 0; n < 2; ++n) *(f32x4*)(htu + (2 + fr - 14) * 256 + bj * 128 + lcol + 4 * n) = acc[ai][bj][3][n]; } }
        }
        if (wr == 0 && fr < 2) {
#pragma unroll
            for (int bj = 0; bj < 2; ++bj)
#pragma unroll
                for (int n = 0; n < 2; ++n) *(f32x4*)(htu + fr * 256 + bj * 128 + lcol + 4 * n) = acc[0][bj][0][n];
        }
        asm volatile("s_waitcnt lgkmcnt(0)" ::: "memory"); __builtin_amdgcn_s_barrier(); asm volatile("" ::: "memory");
#pragma unroll
        for (int n = 0; n < 2; ++n) {
            const int f = 128 * u.pn + lcol + 4 * n;
            PG8_LAS const float* const wl = (PG8_LAS const float*)(hl + 10240) + lcol + 4 * n;
            const f32x4 wg0 = *(PG8_LAS const f32x4*)(wl), wg1 = *(PG8_LAS const f32x4*)(wl + 128), wg2 = *(PG8_LAS const f32x4*)(wl + 256), bg = *(PG8_LAS const f32x4*)(wl + 384);
            const f32x4 wv0 = *(PG8_LAS const f32x4*)(wl + 512), wv1 = *(PG8_LAS const f32x4*)(wl + 640), wv2 = *(PG8_LAS const f32x4*)(wl + 768), bv = *(PG8_LAS const f32x4*)(wl + 896);
#pragma unroll
            for (int ai = 0; ai < 2; ++ai) {
                const int k = 2 * ai + wr;
                const int rslot = k > 0 ? k - 1 : 0;
                PG8_LAS const unsigned char* hp = hl + rslot * 2048 + (lcol + 4 * n) * 4;
                f32x4 hg2 = *(PG8_LAS const f32x4*)hp, hv2 = *(PG8_LAS const f32x4*)(hp + 512), hg1 = *(PG8_LAS const f32x4*)(hp + 1024), hv1 = *(PG8_LAS const f32x4*)(hp + 1536);
                if (k == 0) { hg2 = (f32x4){0.f, 0.f, 0.f, 0.f}; hv2 = hg2; hg1 = hg2; hv1 = hg2; }
#pragma unroll
                for (int m = 0; m < 4; ++m) {
                    float r[4];
#pragma unroll
                    for (int e = 0; e < 4; ++e) {
                        const float xg = acc[ai][0][m][n][e], xv = acc[ai][1][m][n][e];
                        float o1g, o2g, o1v, o2v;
                        if (m == 0) { o1g = hg1[e]; o2g = fr == 0 ? hg2[e] : hg1[e]; o1v = hv1[e]; o2v = fr == 0 ? hv2[e] : hv1[e]; }
                        else { const float pgv = acc[ai][0][m > 0 ? m - 1 : 0][n][e], pvv = acc[ai][1][m > 0 ? m - 1 : 0][n][e];
                            o1g = dpp_mov<0x121>(pgv, pgv); o2g = dpp_mov<0x122>(pgv, pgv); o1v = dpp_mov<0x121>(pvv, pvv); o2v = dpp_mov<0x122>(pvv, pvv); }
                        const float p1g = dpp_mov<0x111>(o1g, xg), p2g = dpp_mov<0x112>(o2g, xg), p1v = dpp_mov<0x111>(o1v, xv), p2v = dpp_mov<0x112>(o2v, xv);
                        const float yg = bg[e] + wg2[e] * xg + wg1[e] * p1g + wg0[e] * p2g;
                        const float yv = bv[e] + wv2[e] * xv + wv1[e] * p1v + wv0[e] * p2v;
                        r[e] = yg * __builtin_amdgcn_rcpf(1.0f + __builtin_amdgcn_exp2f(-1.4426950408889634f * yg)) * yv;
                    }
                    u32x2e w; w.x = cvt_pk_bf16(r[0], r[1]); w.y = cvt_pk_bf16(r[2], r[3]);
                    *(u32x2e*)(O + (size_t)(u.pm * BM + ai * HALF + wr * 64 + m * 16 + fr) * ldo + f) = w;
                }
            }
        }
    }
};

struct EpiResLn {
    static constexpr bool PERM = false, AFTER_DRAIN = false, F16 = false;
    const unsigned short* base16; int isbf; float* out; float* st; const float* cg; const float* cbeta; bf16_t* hb; unsigned short* hf; unsigned* gcnt; unsigned tgt0; int last; PG8_LAS unsigned char* xl; int rev;
    static constexpr int ldc = 1024; static constexpr float alpha = 1.681792830507429f, eps = 1e-5f;
    typedef _Float16 h16x2 __attribute__((ext_vector_type(2)));
    __device__ __forceinline__ f32x4 dec(u32x2e w) const {
        if (isbf) return (f32x4){__uint_as_float(w.x << 16), __uint_as_float(w.x & 0xffff0000u), __uint_as_float(w.y << 16), __uint_as_float(w.y & 0xffff0000u)};
        const float f0 = (float)__builtin_bit_cast(_Float16, (unsigned short)(w.x & 0xffffu)), f1 = (float)__builtin_bit_cast(_Float16, (unsigned short)(w.x >> 16));
        const float f2 = (float)__builtin_bit_cast(_Float16, (unsigned short)(w.y & 0xffffu)), f3 = (float)__builtin_bit_cast(_Float16, (unsigned short)(w.y >> 16));
        return (f32x4){f0, f1, f2, f3}; }
    __device__ __forceinline__ void operator()(f32x4 (&acc)[2][2][4][2], const Unit& u, int wr, int wc, int fr, int fq) const {
        asm volatile("" : "+v"(fr), "+v"(fq));
        typedef float f32x2s __attribute__((ext_vector_type(2)));
        PG8_LAS float* const sl = (PG8_LAS float*)xl; PG8_LAS float* const gl = (PG8_LAS float*)(xl + 8192);
        const int col0 = u.pn * BM + wc * 32 + 4 * fq, lc0 = wc * 32 + 4 * fq;
        { const int t = opaque_tid();
          if (t < 128) { const int which = t >> 6, c4 = 4 * (t & 63); *(PG8_LAS f32x4*)(gl + which * 256 + c4) = *(const f32x4*)((which ? cbeta : cg) + u.pn * BM + c4); } }
        u32x2e nb[4];
        { const size_t off = ((size_t)u.pm * BM + wr * 64 + fr) * ldc + col0;
#pragma unroll
          for (int q = 0; q < 4; ++q) nb[q] = *(const u32x2e*)(base16 + off + (q >> 1) * HALF + (q & 1) * 16); }
#pragma unroll
        for (int i = 0; i < 8; ++i) { const int ai = i >> 2, m = i & 3; const int lrow = ai * HALF + wr * 64 + m * 16 + fr;
            u32x2e cur[4];
#pragma unroll
            for (int q = 0; q < 4; ++q) cur[q] = nb[q];
            if (i < 7) { const int lr2 = ((i + 1) >> 2) * HALF + wr * 64 + ((i + 1) & 3) * 16 + fr; const size_t off2 = ((size_t)u.pm * BM + lr2) * ldc + col0;
#pragma unroll
                for (int q = 0; q < 4; ++q) nb[q] = *(const u32x2e*)(base16 + off2 + (q >> 1) * HALF + (q & 1) * 16); }
            asm volatile("" ::: "memory");
            float rsum = 0.f, rq = 0.f;
#pragma unroll
            for (int q = 0; q < 4; ++q) { const int bj = q >> 1, n = q & 1;
                const f32x4 y = dec(cur[q]) * alpha + acc[ai][bj][m][n];
                acc[ai][bj][m][n] = y;
                rsum += (y[0] + y[1]) + (y[2] + y[3]); rq += (y[0] * y[0] + y[1] * y[1]) + (y[2] * y[2] + y[3] * y[3]); }
            rsum += __shfl_xor(rsum, 16); rsum += __shfl_xor(rsum, 32); rq += __shfl_xor(rq, 16); rq += __shfl_xor(rq, 32);
            if (fq == 0) { sl[(lrow * 4 + wc) * 2] = rsum; sl[(lrow * 4 + wc) * 2 + 1] = rq; }
            asm volatile("" ::: "memory"); }
        asm volatile("s_waitcnt lgkmcnt(0)" ::: "memory"); __builtin_amdgcn_s_barrier(); asm volatile("" ::: "memory");
        const int t = opaque_tid();
        if (t < 256) { const f32x4 a = *(PG8_LAS const f32x4*)(sl + t * 8), b = *(PG8_LAS const f32x4*)(sl + t * 8 + 4);
            const float ssum = (a[0] + a[2]) + (b[0] + b[2]), ssq = (a[1] + a[3]) + (b[1] + b[3]);
            __hip_atomic_store((unsigned long long*)(st + ((size_t)u.pm * BM + t) * 8 + u.pn * 2), ((unsigned long long)__float_as_uint(ssq) << 32) | __float_as_uint(ssum), __ATOMIC_RELAXED, __HIP_MEMORY_SCOPE_AGENT); }
        asm volatile("s_waitcnt vmcnt(0) lgkmcnt(0)" ::: "memory"); __builtin_amdgcn_s_barrier(); asm volatile("" ::: "memory");
        if (t == 0) {
            unsigned* const ctr = gcnt + 64 * (blockIdx.x & 7); const unsigned target = tgt0 + 32u * (unsigned)((rev ? 3 - ((u.pm >> 3) & 3) : ((u.pm >> 3) & 3)) + 1);
            __hip_atomic_fetch_add(ctr, 1u, __ATOMIC_RELAXED, __HIP_MEMORY_SCOPE_AGENT);
            while (__hip_atomic_load(ctr, __ATOMIC_RELAXED, __HIP_MEMORY_SCOPE_AGENT) < target) __builtin_amdgcn_s_sleep(1);
        }
        __builtin_amdgcn_s_barrier(); asm volatile("" ::: "memory");
        if (t < 256) { const size_t row = (size_t)u.pm * BM + t;
            float s = 0.f, q = 0.f;
#pragma unroll
            for (int k4 = 0; k4 < 4; ++k4) { const unsigned long long w = __hip_atomic_load((const unsigned long long*)(st + row * 8 + 2 * k4), __ATOMIC_RELAXED, __HIP_MEMORY_SCOPE_AGENT);
                s += __uint_as_float((unsigned)w); q += __uint_as_float((unsigned)(w >> 32)); }
            const float mean = s * (1.f / 1024.f), rstd = 1.f / sqrtf(q * (1.f / 1024.f) - mean * mean + eps);
            *(PG8_LAS f32x2s*)(sl + 2 * t) = (f32x2s){mean, rstd}; }
        asm volatile("s_waitcnt lgkmcnt(0)" ::: "memory"); __builtin_amdgcn_s_barrier(); asm volatile("" ::: "memory");
#pragma unroll
        for (int i = 0; i < 8; ++i) { const int ai = i >> 2, m = i & 3; const int lrow = ai * HALF + wr * 64 + m * 16 + fr; const size_t off = ((size_t)u.pm * BM + lrow) * ldc + col0;
            const f32x2s mr = *(PG8_LAS const f32x2s*)(sl + 2 * lrow);
#pragma unroll
            for (int q = 0; q < 4; ++q) { const int bj = q >> 1, n = q & 1;
                const f32x4 g4 = *(PG8_LAS const f32x4*)(gl + lc0 + bj * HALF + n * 16), b4 = *(PG8_LAS const f32x4*)(gl + 256 + lc0 + bj * HALF + n * 16);
                const f32x4 o = (acc[ai][bj][m][n] - mr.x) * mr.y * g4 + b4;
                if (last) *(f32x4*)(out + off + bj * HALF + n * 16) = o;
                else { u32x2e w2; w2.x = cvt_pk_f16(o[0], o[1]); w2.y = cvt_pk_f16(o[2], o[3]); *(u32x2e*)(hf + off + bj * HALF + n * 16) = w2; } }
            asm volatile("" ::: "memory"); }
    }
};

template <class Epi, class Sched, bool ALIGN_EPI = false, bool SP2 = false>
__device__ __forceinline__ void gemm_phase(PG8_LAS unsigned char* lds, const Gemm g, const Sched& S, const Epi& E) {
    const int tid = opaque_tid(), wid = __builtin_amdgcn_readfirstlane(tid >> 6), lane = tid & 63, wr = wid >> 2, wc = wid & 3, fr = lane & 15, fq = lane >> 4;
    const int K = g.K, nt = K / BK;
    unsigned voffA[2], voffB[2];
#pragma unroll
    for (int i = 0; i < 2; ++i) { int R, C; stage_rc(tid * 16 + i * 8192, R, C); const int Rb = Epi::PERM ? ((R & ~31) + perm32(R & 31)) : R;
        voffA[i] = (unsigned)(R * K + C) * 2u; voffB[i] = (unsigned)(Rb * K + C) * 2u; }
    const size_t kstep = (size_t)(BK * 2);
    const size_t hstep = (size_t)HALF * K * 2;
    const size_t tstep = 2 * hstep;
    const unsigned ldsw = (unsigned)wid * 1024u;
    const int aoff = lds_byte(wr * 64 + fr, fq * 8), boff = lds_byte(wc * 32 + fr, fq * 8);
#define PG8_SA(b, h) (((b) * 2 + (h)) * HTB)
#define PG8_SB(b, h) ((4 + (b) * 2 + (h)) * HTB)
#define PG8_STAGE(bufoff, gbase, voff) do { _Pragma("unroll") for (int _i = 0; _i < 2; ++_i) \
        __builtin_amdgcn_global_load_lds((const unsigned*)((const char*)(gbase) + (voff)[_i]), (PG8_LAS unsigned*)(lds + (bufoff) + ldsw + _i * 8192), 16, 0, 0); } while (0)
#define PG8_LDA(dst, b, h) do { _Pragma("unroll") for (int m = 0; m < 4; ++m) _Pragma("unroll") for (int k = 0; k < 2; ++k) dst[m][k] = *(const PG8_LAS bf16x8*)(lds + PG8_SA(b, h) + aoff + m * 2048 + k * 1024); } while (0)
#define PG8_LDB(dst, b, h) do { _Pragma("unroll") for (int n = 0; n < 2; ++n) _Pragma("unroll") for (int k = 0; k < 2; ++k) dst[n][k] = *(const PG8_LAS bf16x8*)(lds + PG8_SB(b, h) + boff + n * 2048 + k * 1024); } while (0)
#define PG8_MMA(ai, bj, At, Bt) do { __builtin_amdgcn_s_setprio(1); _Pragma("unroll") for (int m = 0; m < 4; ++m) _Pragma("unroll") for (int n = 0; n < 2; ++n) _Pragma("unroll") for (int k = 0; k < 2; ++k) \
        acc[ai][bj][m][n] = mma16<Epi::F16>(Bt[n][k], At[m][k], acc[ai][bj][m][n]); __builtin_amdgcn_s_setprio(0); } while (0)
#define PG8_WAIT_V(n) asm volatile("s_waitcnt vmcnt(" #n ")" ::: "memory")
#define PG8_WAIT_L(n) asm volatile("s_waitcnt lgkmcnt(" #n ")" ::: "memory")
#define PG8_BAR __builtin_amdgcn_s_barrier()
#define PG8_SCHED __builtin_amdgcn_sched_barrier(0)
    Unit cur, nxt; int ui = 0;
    if (!S.next(0, cur)) return;
    f32x4 acc[2][2][4][2];
#pragma unroll
    for (int a = 0; a < 2; ++a)
#pragma unroll
        for (int b = 0; b < 2; ++b)
#pragma unroll
            for (int m = 0; m < 4; ++m)
#pragma unroll
                for (int n = 0; n < 2; ++n) acc[a][b][m][n] = (f32x4){0.f, 0.f, 0.f, 0.f};
    bf16x8 At[4][2], B0[2][2], B1[2][2];
    const char* cA = (const char*)g.A + (size_t)cur.pm * tstep; const char* cB = (const char*)g.Bt + (size_t)cur.pn * tstep;
    S.a_ready(cur);
    if constexpr (SP2) {
        PG8_STAGE(PG8_SB(0, 0), cB, voffB); PG8_STAGE(PG8_SB(0, 1), cB + hstep, voffB); PG8_STAGE(PG8_SA(0, 0), cA, voffA); PG8_STAGE(PG8_SA(0, 1), cA + hstep, voffA);
        if (wr == 1) PG8_BAR;
        PG8_WAIT_V(2); PG8_BAR;
        PG8_STAGE(PG8_SB(1, 0), cB + kstep, voffB); PG8_STAGE(PG8_SA(1, 0), cA + kstep, voffA); PG8_STAGE(PG8_SB(1, 1), cB + hstep + kstep, voffB);
        PG8_WAIT_V(6); PG8_BAR;
    } else {
        PG8_STAGE(PG8_SB(0, 0), cB, voffB); PG8_STAGE(PG8_SA(0, 0), cA, voffA); PG8_STAGE(PG8_SB(0, 1), cB + hstep, voffB); PG8_STAGE(PG8_SA(0, 1), cA + hstep, voffA);
        if (wr == 1) PG8_BAR;
        PG8_WAIT_V(4); PG8_BAR;
        PG8_STAGE(PG8_SB(1, 0), cB + kstep, voffB); PG8_STAGE(PG8_SA(1, 0), cA + kstep, voffA); PG8_STAGE(PG8_SB(1, 1), cB + hstep + kstep, voffB);
        PG8_WAIT_V(6); PG8_BAR;
    }
    for (;;) {
        const bool has_next = S.next(ui + 1, nxt);
        const char* nA = has_next ? (const char*)g.A + (size_t)nxt.pm * tstep : cA; const char* nB = has_next ? (const char*)g.Bt + (size_t)nxt.pn * tstep : cB;
        for (int t = 0; t < nt; t += 2) {
            const bool last = (t == nt - 2);
            const char* a1 = cA + (size_t)(t + 1) * kstep;
            const char* a2 = last ? nA : cA + (size_t)(t + 2) * kstep; const char* b2 = last ? nB : cB + (size_t)(t + 2) * kstep;
            const char* a3 = a2 + kstep; const char* b3 = b2 + kstep;
            if (last && has_next) S.a_ready(nxt);
            if constexpr (SP2) {
            PG8_LDB(B0, 0, 0); PG8_LDB(B1, 0, 1); PG8_SCHED; PG8_LDA(At, 0, 0); PG8_STAGE(PG8_SA(1, 1), a1 + hstep, voffA);
            PG8_WAIT_V(8); PG8_WAIT_L(0); PG8_BAR; PG8_MMA(0, 0, At, B0); PG8_MMA(0, 1, At, B1); PG8_BAR; PG8_SCHED;
            PG8_LDA(At, 0, 1); PG8_STAGE(PG8_SB(0, 0), b2, voffB); PG8_STAGE(PG8_SB(0, 1), b2 + hstep, voffB); PG8_STAGE(PG8_SA(0, 0), a2, voffA);
            PG8_WAIT_V(8); PG8_WAIT_L(0); PG8_BAR; PG8_MMA(1, 0, At, B0); PG8_MMA(1, 1, At, B1); PG8_BAR; PG8_SCHED;
            PG8_LDB(B0, 1, 0); PG8_LDB(B1, 1, 1); PG8_SCHED; PG8_LDA(At, 1, 0); PG8_STAGE(PG8_SA(0, 1), a2 + hstep, voffA);
            PG8_WAIT_V(8); PG8_WAIT_L(0); PG8_BAR; PG8_MMA(0, 0, At, B0); PG8_MMA(0, 1, At, B1); PG8_BAR; PG8_SCHED;
            PG8_LDA(At, 1, 1); PG8_STAGE(PG8_SB(1, 0), b3, voffB); PG8_STAGE(PG8_SB(1, 1), b3 + hstep, voffB); PG8_STAGE(PG8_SA(1, 0), a3, voffA);
            PG8_WAIT_V(8); PG8_WAIT_L(0); PG8_BAR; PG8_MMA(1, 0, At, B0); PG8_MMA(1, 1, At, B1); PG8_BAR; PG8_SCHED;
            } else {
            PG8_LDB(B0, 0, 0); PG8_SCHED; PG8_LDA(At, 0, 0); PG8_STAGE(PG8_SA(1, 1), a1 + hstep, voffA);
            PG8_WAIT_L(8); PG8_BAR; PG8_WAIT_L(0); PG8_MMA(0, 0, At, B0); PG8_BAR; PG8_SCHED;
            PG8_LDB(B1, 0, 1); PG8_STAGE(PG8_SB(0, 0), b2, voffB);
            PG8_BAR; PG8_WAIT_L(0); PG8_MMA(0, 1, At, B1); PG8_BAR;
            PG8_LDA(At, 0, 1); PG8_STAGE(PG8_SA(0, 0), a2, voffA);
            PG8_BAR; PG8_WAIT_L(0); PG8_MMA(1, 0, At, B0); PG8_BAR; PG8_SCHED;
            PG8_STAGE(PG8_SB(0, 1), b2 + hstep, voffB);
            PG8_WAIT_V(6); PG8_BAR; PG8_MMA(1, 1, At, B1); PG8_BAR;
            PG8_LDB(B0, 1, 0); PG8_SCHED; PG8_LDA(At, 1, 0); PG8_STAGE(PG8_SA(0, 1), a2 + hstep, voffA);
            PG8_WAIT_L(8); PG8_BAR; PG8_WAIT_L(0); PG8_MMA(0, 0, At, B0); PG8_BAR; PG8_SCHED;
            PG8_LDB(B1, 1, 1); PG8_STAGE(PG8_SB(1, 0), b3, voffB);
            PG8_BAR; PG8_WAIT_L(0); PG8_MMA(0, 1, At, B1); PG8_BAR;
            PG8_LDA(At, 1, 1); PG8_STAGE(PG8_SA(1, 0), a3, voffA);
            PG8_BAR; PG8_WAIT_L(0); PG8_MMA(1, 0, At, B0); PG8_BAR; PG8_SCHED;
            PG8_STAGE(PG8_SB(1, 1), b3 + hstep, voffB);
            PG8_WAIT_V(6); PG8_BAR; PG8_MMA(1, 1, At, B1); PG8_BAR;
            }
        }
        if constexpr (ALIGN_EPI) { if (wr == 0) PG8_BAR; }
        if constexpr (!Epi::AFTER_DRAIN) { E(acc, cur, wr, wc, fr, fq); S.done(cur); }
        if (!has_next) break;
#pragma unroll
        for (int a = 0; a < 2; ++a)
#pragma unroll
            for (int b = 0; b < 2; ++b)
#pragma unroll
                for (int m = 0; m < 4; ++m)
#pragma unroll
                    for (int n = 0; n < 2; ++n) acc[a][b][m][n] = (f32x4){0.f, 0.f, 0.f, 0.f};
        cur = nxt; cA = nA; cB = nB; ++ui;
        if constexpr (ALIGN_EPI) { if (wr == 1) PG8_BAR; }
    }
    PG8_WAIT_V(0);
    if constexpr (!ALIGN_EPI) { if (wr == 0) PG8_BAR; }
    PG8_BAR;
    if constexpr (Epi::AFTER_DRAIN) { E.fused(acc, cur, wr, wc, fr, fq, lds, wid, lane); S.done(cur); }
#undef PG8_SA
#undef PG8_SB
#undef PG8_STAGE
#undef PG8_LDA
#undef PG8_LDB
#undef PG8_MMA
#undef PG8_WAIT_V
#undef PG8_WAIT_L
#undef PG8_BAR
#undef PG8_SCHED
}
}

constexpr int NB = 32, SEQ = 2048, DM = 1024, NTOK = NB * SEQ;
constexpr int NH = 16, HD = 64, GW = 2048, GG = 8, GC = 128, FF = 2816, FF2 = 5632, DEPTH = 4;
constexpr float LN_EPS = 1e-5f;
constexpr float DN_ALPHA = 1.681792830507429f;
constexpr int HALF_TOK = NTOK / 2;

constexpr size_t MiB = 1u << 20;
constexpr size_t WS_ATTN_IN = 0, WS_ATTN_OUT = 12 * MiB, WS_GMLP_IN = 16 * MiB, WS_GMLP_OUT = 32 * MiB, WS_FFN_UP = 40 * MiB, WS_FFN_DOWN = 84 * MiB, WS_WS = 106 * MiB;
constexpr size_t WS_MS = 110 * MiB;
constexpr size_t WS_CTL = 107 * MiB;
constexpr size_t WS_ST = 108 * MiB;
constexpr size_t WS_HB = 112 * MiB;
constexpr size_t WS_R = 240 * MiB;
constexpr size_t WS_Q = WS_R, WS_K = WS_R + 128 * MiB, WS_V = WS_R + 256 * MiB, WS_O = WS_R + 384 * MiB;
constexpr size_t WS_ZZ = WS_R, WS_GT = WS_R + 512 * MiB;
constexpr size_t WS_HT = WS_R + 400 * MiB;
constexpr size_t WS_G = WS_R;
constexpr size_t WS_VST = 1008 * MiB;
constexpr size_t WS_END = 1012 * MiB;

constexpr int LDS_BYTES = 147456;

#define LAS __attribute__((address_space(3)))
typedef unsigned short bf16;
typedef unsigned u32x4 __attribute__((ext_vector_type(4)));
typedef unsigned u32x2 __attribute__((ext_vector_type(2)));
typedef float f32x4 __attribute__((ext_vector_type(4)));
typedef float f32x16 __attribute__((ext_vector_type(16)));
typedef short bf16x8 __attribute__((ext_vector_type(8)));
typedef short s16x4 __attribute__((ext_vector_type(4)));

__device__ __forceinline__ unsigned pk2(float lo, float hi) { return pg8::cvt_pk_bf16(lo, hi); }
__device__ __forceinline__ float bflo(unsigned w) { return __uint_as_float(w << 16); }
__device__ __forceinline__ float bfhi(unsigned w) { return __uint_as_float(w & 0xffff0000u); }
__device__ __forceinline__ float wave_sum(float v) {
#pragma unroll
    for (int o = 1; o < 64; o <<= 1) v += __shfl_xor(v, o);
    return v;
}
__device__ __forceinline__ s16x4 vtr(LAS const unsigned char* p) { return __builtin_bit_cast(s16x4, __builtin_amdgcn_ds_read_tr16_b64_v4i16((LAS s16x4*)p)); }

__device__ __forceinline__ void transpose_item(const float* W, int K, int N, bf16* WT, int perm, int f16, LAS float* scr, int item, int lane) {
    const int nblk = N / 32, kb = item / nblk, nb = item % nblk, k0 = 64 * kb, n0 = 32 * nb;
    int r0 = n0;
    if (perm) { const int bj = n0 / FF, f0 = n0 - bj * FF; r0 = (f0 >> 7) * 256 + bj * 128 + (f0 & 127); }
#pragma unroll 8
    for (int i = 0; i < 32; ++i) { const int kk = 2 * i + (lane >> 5); scr[kk * 33 + (lane & 31)] = W[(size_t)(k0 + kk) * N + n0 + (lane & 31)]; }
    asm volatile("s_waitcnt lgkmcnt(0)" ::: "memory");
    const int c = lane & 7;
#pragma unroll
    for (int j = 0; j < 4; ++j) { const int n = (lane >> 3) + 8 * j; const LAS float* s = scr + (8 * c) * 33 + n;
        u32x4 o; if (f16) { o.x = pg8::cvt_pk_f16(s[0 * 33], s[1 * 33]); o.y = pg8::cvt_pk_f16(s[2 * 33], s[3 * 33]); o.z = pg8::cvt_pk_f16(s[4 * 33], s[5 * 33]); o.w = pg8::cvt_pk_f16(s[6 * 33], s[7 * 33]); }
        else { o.x = pk2(s[0 * 33], s[1 * 33]); o.y = pk2(s[2 * 33], s[3 * 33]); o.z = pk2(s[4 * 33], s[5 * 33]); o.w = pk2(s[6 * 33], s[7 * 33]); }
        *(u32x4*)(WT + (size_t)(r0 + n) * K + k0 + 8 * c) = o; }
    asm volatile("s_waitcnt lgkmcnt(0)" ::: "memory");
}

struct Args { const float* in[17]; float* out; unsigned char* ws; };

__device__ __forceinline__ void ln_apply(const float* Y, float* Yo, bf16* HB, const float* st, float* ms, const float* gam, const float* bet, int gw, int ngw, int lane) {
    f32x4 g4[4], b4[4];
#pragma unroll
    for (int j = 0; j < 4; ++j) { g4[j] = ((const f32x4*)gam)[lane + 64 * j]; b4[j] = ((const f32x4*)bet)[lane + 64 * j]; }
    for (int m = gw; m < NTOK; m += ngw) {
        const f32x4* yr = (const f32x4*)(Y + (size_t)m * DM) + lane;
        f32x4 v[4];
#pragma unroll
        for (int j = 0; j < 4; ++j) v[j] = yr[64 * j];
        const f32x4 a = *(const f32x4*)(st + (size_t)m * 8), b = *(const f32x4*)(st + (size_t)m * 8 + 4);
        const float s = (a[0] + a[2]) + (b[0] + b[2]), q = (a[1] + a[3]) + (b[1] + b[3]);
        const float mean = s * (1.f / DM), rstd = 1.f / sqrtf(q * (1.f / DM) - mean * mean + LN_EPS);
        if (lane == 0) { ms[(size_t)m * 2] = mean; ms[(size_t)m * 2 + 1] = rstd; }
        u32x2* o8 = (u32x2*)(HB + (size_t)m * DM) + lane;
#pragma unroll
        for (int j = 0; j < 4; ++j) { const f32x4 o = (v[j] - mean) * rstd * g4[j] + b4[j]; if (Yo) ((f32x4*)(Yo + (size_t)m * DM) + lane)[64 * j] = o; u32x2 w; w.x = pk2(o.x, o.y); w.y = pk2(o.z, o.w); o8[64 * j] = w; }
    }
}

__device__ __forceinline__ void ffn_fix_phase(const float* HT, bf16* Gb, const float* cw, const float* cb, int cu, int G, int tid) {
    const int sub = tid >> 6, r = (tid >> 5) & 1, f = (tid & 31) * 4;
    for (int up = cu * 8 + sub; up < 224 * 22; up += G * 8) {
        const int pn = up % 22, pq = up / 22, pm = pq + pq / 7 + 1;
        const float* hc = HT + (size_t)(pm * 22 + pn) * 1024; const float* hp = HT + (size_t)((pm - 1) * 22 + pn) * 1024;
        f32x4 y[2];
#pragma unroll
        for (int hh = 0; hh < 2; ++hh) { const int c = hh * 128 + f; const int F = hh * FF + 128 * pn + f;
            const f32x4 h0 = *(const f32x4*)(hc + c), h1 = *(const f32x4*)(hc + 256 + c), t0 = *(const f32x4*)(hp + 512 + c), t1 = *(const f32x4*)(hp + 768 + c);
            const f32x4 x0 = r ? h1 : h0, xm1 = r ? h0 : t1, xm2 = r ? t1 : t0;
            y[hh] = *(const f32x4*)(cb + F) + *(const f32x4*)(cw + F) * xm2 + *(const f32x4*)(cw + FF2 + F) * xm1 + *(const f32x4*)(cw + 2 * FF2 + F) * x0; }
        float v[4];
#pragma unroll
        for (int e = 0; e < 4; ++e) v[e] = y[0][e] * __builtin_amdgcn_rcpf(1.0f + __builtin_amdgcn_exp2f(-1.4426950408889634f * y[0][e])) * y[1][e];
        u32x2 w; w.x = pk2(v[0], v[1]); w.y = pk2(v[2], v[3]);
        *(u32x2*)(Gb + (size_t)(pm * 256 + r) * FF + 128 * pn + f) = w;
    }
}

__device__ __forceinline__ void attn_phase(LAS unsigned char* lds, const bf16* Q, const bf16* K, const bf16* V, bf16* O, int cu, int G, int rev) {
    const int tid = opaque_tid(), lane = tid & 63, wid = __builtin_amdgcn_readfirstlane(tid >> 6), q32 = lane & 31, hi = lane >> 5, li = lane & 15;
    LAS unsigned char* Ks = lds + wid * 10752;
    LAS unsigned char* Vs = Ks + 4608;
    const int lkey = lane >> 3, lch = lane & 7;
    const float LOG2E = 1.4426950408889634f;
    for (int k = 0; k < 16; ++k) {
        const int idx = cu * 8 + wid + 2048 * (k & 3), b = 4 * (idx & 7) + (rev ? 3 - (k >> 2) : (k >> 2)), h = (idx >> 3) & 15, qb = idx >> 7;
        const size_t rowbase = (size_t)b * SEQ;
        const int q0w = qb * 32;
        bf16x8 qf[4];
        { const bf16* qp = Q + (rowbase + q0w + q32) * DM + h * HD + hi * 8;
#pragma unroll
          for (int ks = 0; ks < 4; ++ks) qf[ks] = *(const bf16x8*)(qp + ks * 16); }
        f32x16 o0, o1;
#pragma unroll
        for (int r = 0; r < 16; ++r) { o0[r] = 0.f; o1[r] = 0.f; }
        float R = 0.f;
        const bf16* kp = K + (rowbase + lkey) * DM + h * HD + lch * 8;
        const bf16* vp = V + (rowbase + lkey) * DM + h * HD + lch * 8;
        u32x4 kr[4], vr[4];
#pragma unroll
        for (int jj = 0; jj < 4; ++jj) { kr[jj] = *(const u32x4*)(kp + (size_t)(q0w + 8 * jj) * DM); vr[jj] = *(const u32x4*)(vp + (size_t)(q0w + 8 * jj) * DM); }
        for (int key0 = q0w; key0 >= 0; key0 -= 32) {
#pragma unroll
            for (int jj = 0; jj < 4; ++jj) { *(LAS u32x4*)(Ks + (lkey + 8 * jj) * 144 + lch * 16) = kr[jj]; *(LAS u32x4*)(Vs + (lkey + 8 * jj) * 192 + lch * 16) = vr[jj]; }
            asm volatile("s_waitcnt lgkmcnt(0)" ::: "memory");
            if (key0 >= 32) {
#pragma unroll
                for (int jj = 0; jj < 4; ++jj) { kr[jj] = *(const u32x4*)(kp + (size_t)(key0 - 32 + 8 * jj) * DM); vr[jj] = *(const u32x4*)(vp + (size_t)(key0 - 32 + 8 * jj) * DM); } }
            const bool diag = (key0 == q0w);
            f32x16 s;
#pragma unroll
            for (int r = 0; r < 16; ++r) s[r] = 0.f;
#pragma unroll
            for (int ks = 0; ks < 4; ++ks) { const bf16x8 kf = *(LAS const bf16x8*)(Ks + q32 * 144 + (16 * ks + 8 * hi) * 2);
                s = __builtin_amdgcn_mfma_f32_32x32x16_bf16(kf, qf[ks], s, 0, 0, 0); }
            float zs[16], l1[16];
#pragma unroll
            for (int r = 0; r < 16; ++r) { const float z = s[r] * LOG2E; const float e = __builtin_amdgcn_exp2f(-__builtin_fabsf(z)); const float t = __builtin_amdgcn_logf(1.0f + e);
                float l = -(__builtin_fmaxf(z, 0.f) + t);
                if (diag) { const int kl = 8 * (r >> 2) + 4 * hi + (r & 3); if (kl >= q32) l = 0.f; }
                zs[r] = z; l1[r] = l; }
            float G0[4], G1[4];
#pragma unroll
            for (int j = 0; j < 4; ++j) { const float gs = (l1[4 * j] + l1[4 * j + 1]) + (l1[4 * j + 2] + l1[4 * j + 3]);
                auto rr = __builtin_amdgcn_permlane32_swap(__float_as_uint(gs), __float_as_uint(gs), false, false); G0[j] = __uint_as_float(rr[0]); G1[j] = __uint_as_float(rr[1]); }
            float p[16]; float run = R;
#pragma unroll
            for (int j = 3; j >= 0; --j) { float sfx = run + (hi == 0 ? G1[j] : 0.f);
#pragma unroll
                for (int e = 3; e >= 0; --e) { const int r = 4 * j + e; float val = __builtin_amdgcn_exp2f(l1[r] + zs[r] + sfx);
                    if (diag) { const int kl = 8 * j + 4 * hi + e; if (kl >= q32) val = 0.f; }
                    p[r] = val; sfx += l1[r]; }
                run += G0[j] + G1[j]; }
            R = run;
#pragma unroll
            for (int ks2 = 0; ks2 < 2; ++ks2) {
                u32x4 pw; pw.x = pk2(p[8 * ks2], p[8 * ks2 + 1]); pw.y = pk2(p[8 * ks2 + 2], p[8 * ks2 + 3]); pw.z = pk2(p[8 * ks2 + 4], p[8 * ks2 + 5]); pw.w = pk2(p[8 * ks2 + 6], p[8 * ks2 + 7]);
                const bf16x8 pb = __builtin_bit_cast(bf16x8, pw);
#pragma unroll
                for (int dh = 0; dh < 2; ++dh) {
                    LAS const unsigned char* va = Vs + (16 * ks2 + 4 * hi + (li >> 2)) * 192 + (32 * dh + 16 * ((lane >> 4) & 1) + 4 * (li & 3)) * 2;
                    const s16x4 lo = vtr(va), hi4 = vtr(va + 8 * 192);
                    const bf16x8 vf = (bf16x8){lo[0], lo[1], lo[2], lo[3], hi4[0], hi4[1], hi4[2], hi4[3]};
                    if (dh == 0) o0 = __builtin_amdgcn_mfma_f32_32x32x16_bf16(vf, pb, o0, 0, 0, 0);
                    else         o1 = __builtin_amdgcn_mfma_f32_32x32x16_bf16(vf, pb, o1, 0, 0, 0);
                }
            }
            asm volatile("s_waitcnt lgkmcnt(0)" ::: "memory");
            if (__all(R < -150.0f)) break;
        }
        bf16* op = O + (rowbase + q0w + q32) * DM + h * HD + 4 * hi;
#pragma unroll
        for (int j = 0; j < 4; ++j) { u32x2 w0, w1; w0.x = pk2(o0[4 * j], o0[4 * j + 1]); w0.y = pk2(o0[4 * j + 2], o0[4 * j + 3]); w1.x = pk2(o1[4 * j], o1[4 * j + 1]); w1.y = pk2(o1[4 * j + 2], o1[4 * j + 3]);
            *(u32x2*)(op + 8 * j) = w0; *(u32x2*)(op + 32 + 8 * j) = w1; }
    }
    __syncthreads();
}

__device__ __forceinline__ void spatial_phase(LAS unsigned char* lds, const bf16* ZZ, bf16* GT, const bf16* Wc, const float* bs, const float* gam, const float* bet, const float* VST, int cu, int G, int rev) {
    const int tid = opaque_tid(), lane = tid & 63, wid = __builtin_amdgcn_readfirstlane(tid >> 6), fr = lane & 15, kg = lane >> 4;
    LAS float* st = (LAS float*)(lds + 69632);
    const int wr = wid >> 2, wc = wid & 3;
    for (int k = 0; k < 2; ++k) {
        const int cls = 2 * k + (cu >> 7); const int chunk = 64 * (cu & 7) + 16 * (rev ? 3 - cls : cls) + ((cu >> 3) & 15);
        const size_t row0 = (size_t)chunk * GC;
        __syncthreads();
        { const int row = tid >> 2, part = tid & 3;
          const f32x4 a = *(const f32x4*)(VST + (row0 + row) * 16 + part * 4);
          float sm = a[0] + a[2], sq = a[1] + a[3];
          sm += __shfl_xor(sm, 1); sm += __shfl_xor(sm, 2); sq += __shfl_xor(sq, 1); sq += __shfl_xor(sq, 2);
          if (part == 0) { const float mean = sm * (1.f / GW); st[2 * row] = mean; st[2 * row + 1] = 1.f / sqrtf(sq * (1.f / GW) - mean * mean + LN_EPS); } }
        const int c8 = tid & 31, srow = tid >> 5;
        LAS unsigned char* const wl = lds + 72704;
        const int wt = tid >> 2, wq = tid & 3;
        u32x4 nv[8], nw[4];
#pragma unroll
        for (int it = 0; it < 8; ++it) nv[it] = *(const u32x4*)(ZZ + (row0 + it * 16 + srow) * 4096 + GW + c8 * 8);
#pragma unroll
        for (int q = 0; q < 4; ++q) nw[q] = *(const u32x4*)(Wc + (size_t)wt * GC + wq * 32 + q * 8);
        for (int g = 0; g < GG; ++g) {
            __syncthreads();
            { const float* gp = gam + g * 256 + c8 * 8; const float* bp = bet + g * 256 + c8 * 8;
              const f32x4 ga = *(const f32x4*)gp, gb = *(const f32x4*)(gp + 4), ba = *(const f32x4*)bp, bb = *(const f32x4*)(bp + 4);
#pragma unroll
              for (int q = 0; q < 4; ++q) *(LAS u32x4*)(wl + wt * 272 + wq * 64 + q * 16) = nw[q];
#pragma unroll
              for (int it = 0; it < 8; ++it) { const int s = it * 16 + srow;
                  const u32x4 w = nv[it];
                  const float mean = st[2 * s], rstd = st[2 * s + 1];
                  u32x4 o;
                  o.x = pk2((bflo(w.x) - mean) * rstd * ga.x + ba.x, (bfhi(w.x) - mean) * rstd * ga.y + ba.y);
                  o.y = pk2((bflo(w.y) - mean) * rstd * ga.z + ba.z, (bfhi(w.y) - mean) * rstd * ga.w + ba.w);
                  o.z = pk2((bflo(w.z) - mean) * rstd * gb.x + bb.x, (bfhi(w.z) - mean) * rstd * gb.y + bb.y);
                  o.w = pk2((bflo(w.w) - mean) * rstd * gb.z + bb.z, (bfhi(w.w) - mean) * rstd * gb.w + bb.w);
                  *(LAS u32x4*)(lds + s * 544 + c8 * 16) = o; } }
            __syncthreads();
            if (g + 1 < GG) {
#pragma unroll
                for (int it = 0; it < 8; ++it) nv[it] = *(const u32x4*)(ZZ + (row0 + it * 16 + srow) * 4096 + GW + (g + 1) * 256 + c8 * 8);
#pragma unroll
                for (int q = 0; q < 4; ++q) nw[q] = *(const u32x4*)(Wc + (size_t)(g + 1) * GC * GC + (size_t)wt * GC + wq * 32 + q * 8); }
            u32x2 uu[4][4];
#pragma unroll
            for (int tb = 0; tb < 4; ++tb)
#pragma unroll
                for (int cb = 0; cb < 4; ++cb) uu[tb][cb] = *(const u32x2*)(ZZ + (row0 + 64 * wr + 16 * tb + fr) * 4096 + g * 256 + 64 * wc + 16 * cb + 4 * kg);
            f32x4 acc[4][4];
#pragma unroll
            for (int a = 0; a < 4; ++a)
#pragma unroll
                for (int b2 = 0; b2 < 4; ++b2) acc[a][b2] = (f32x4){0.f, 0.f, 0.f, 0.f};
#pragma unroll
            for (int ks = 0; ks < 4; ++ks) {
                if (32 * ks <= 64 * wr + 63) {
                    bf16x8 X[4], Y[4];
#pragma unroll
                    for (int tb = 0; tb < 4; ++tb) { LAS const unsigned char* wp = wl + (64 * wr + 16 * tb + fr) * 272 + (32 * ks + 4 * kg) * 2;
                        const u32x2 a = *(LAS const u32x2*)wp, b2 = *(LAS const u32x2*)(wp + 32); const u32x4 w = (u32x4){a.x, a.y, b2.x, b2.y}; Y[tb] = __builtin_bit_cast(bf16x8, w); }
#pragma unroll
                    for (int cb = 0; cb < 4; ++cb) { LAS const unsigned char* xa = lds + (32 * ks + 4 * kg + (fr >> 2)) * 544 + (64 * wc + 16 * cb + 4 * (fr & 3)) * 2;
                        const s16x4 lo = vtr(xa), hi4 = vtr(xa + 16 * 544);
                        X[cb] = (bf16x8){lo[0], lo[1], lo[2], lo[3], hi4[0], hi4[1], hi4[2], hi4[3]}; }
#pragma unroll
                    for (int tb = 0; tb < 4; ++tb)
#pragma unroll
                        for (int cb = 0; cb < 4; ++cb) acc[tb][cb] = __builtin_amdgcn_mfma_f32_16x16x32_bf16(X[cb], Y[tb], acc[tb][cb], 0, 0, 0);
                }
            }
#pragma unroll
            for (int tb = 0; tb < 4; ++tb) { const int t = 64 * wr + 16 * tb + fr; const float bsv = bs[g * GC + t];
#pragma unroll
                for (int cb = 0; cb < 4; ++cb) { const int c = g * 256 + 64 * wc + 16 * cb + 4 * kg;
                    const u32x2 u = uu[tb][cb];
                    u32x2 o; o.x = pk2(bflo(u.x) * (acc[tb][cb][0] + bsv), bfhi(u.x) * (acc[tb][cb][1] + bsv)); o.y = pk2(bflo(u.y) * (acc[tb][cb][2] + bsv), bfhi(u.y) * (acc[tb][cb][3] + bsv));
                    *(u32x2*)(GT + (row0 + t) * GW + c) = o; } }
        }
    }
}

#ifndef PROBE
#define PROBE 0
#endif
#ifndef G2_REV
#define G2_REV 1
#endif
__device__ __forceinline__ void gbar(unsigned* ctr, unsigned target) {
    asm volatile("s_waitcnt vmcnt(0)" ::: "memory");
    __syncthreads();
    if (threadIdx.x == 0) {
        __builtin_amdgcn_fence(__ATOMIC_RELEASE, "agent");
        asm volatile("s_waitcnt vmcnt(0)" ::: "memory");
        __hip_atomic_fetch_add(ctr, 1u, __ATOMIC_RELAXED, __HIP_MEMORY_SCOPE_AGENT);
        while (__hip_atomic_load(ctr, __ATOMIC_RELAXED, __HIP_MEMORY_SCOPE_AGENT) < target) __builtin_amdgcn_s_sleep(1);
        __builtin_amdgcn_fence(__ATOMIC_ACQUIRE, "agent");
        asm volatile("s_waitcnt vmcnt(0)" ::: "memory");
    }
    __syncthreads();
}
#define GSYNC() do { bar_target += (unsigned)G; gbar(bar_ctr, bar_target); if (PROBE == 7) { bar_target += (unsigned)G; gbar(bar_ctr, bar_target); } } while (0)
__global__ void __launch_bounds__(512, 2) fwd_kernel(Args args) {
    extern __shared__ __attribute__((aligned(16))) unsigned char lds_raw[];
    cg::grid_group grid = cg::this_grid();
    LAS unsigned char* lds = (LAS unsigned char*)lds_raw;
    const int G = gridDim.x, cu = blockIdx.x, ngw = G * 8;
    unsigned char* ws = args.ws;
    const float* x = args.in[0];
    float* out = args.out;
    bf16* HB = (bf16*)(ws + WS_HB);
    unsigned* bar_ctr = (unsigned*)(ws + WS_CTL); unsigned bar_target = 0u;
    if (cu == 0 && threadIdx.x < 8) __hip_atomic_store((unsigned*)(ws + WS_CTL + 8192) + 64 * threadIdx.x, 0u, __ATOMIC_RELAXED, __HIP_MEMORY_SCOPE_AGENT);
    if (cu == 0 && threadIdx.x == 0) __hip_atomic_store(bar_ctr, 0u, __ATOMIC_RELAXED, __HIP_MEMORY_SCOPE_AGENT);

    for (int rep = 0; rep < (PROBE == 8 ? 2 : 1); ++rep) {
        const int tid = opaque_tid(), lane = tid & 63, wave = __builtin_amdgcn_readfirstlane(tid >> 6), gw = cu * 8 + wave;
        LAS float* scr = (LAS float*)(lds + wave * 16384);
        for (int mat = 0; mat < 16; ++mat) {
            const float* W; bf16* WT; int K, N, perm = 0;
            if (mat < 2)       { W = args.in[1] + (size_t)mat * DM * 3072;        WT = (bf16*)(ws + WS_ATTN_IN) + (size_t)mat * 3072 * DM;        K = DM; N = 3072; }
            else if (mat < 4)  { W = args.in[2] + (size_t)(mat - 2) * DM * DM;    WT = (bf16*)(ws + WS_ATTN_OUT) + (size_t)(mat - 2) * DM * DM;   K = DM; N = DM; }
            else if (mat < 6)  { W = args.in[3] + (size_t)(mat - 4) * DM * 4096;  WT = (bf16*)(ws + WS_GMLP_IN) + (size_t)(mat - 4) * 4096 * DM;  K = DM; N = 4096; }
            else if (mat < 8)  { W = args.in[8] + (size_t)(mat - 6) * GW * DM;    WT = (bf16*)(ws + WS_GMLP_OUT) + (size_t)(mat - 6) * DM * GW;   K = GW; N = DM; }
            else if (mat < 12) { W = args.in[9] + (size_t)(mat - 8) * DM * FF2;   WT = (bf16*)(ws + WS_FFN_UP) + (size_t)(mat - 8) * FF2 * DM;    K = DM; N = FF2; perm = 1; }
            else               { W = args.in[12] + (size_t)(mat - 12) * FF * DM;  WT = (bf16*)(ws + WS_FFN_DOWN) + (size_t)(mat - 12) * DM * FF;  K = FF; N = DM; }
            const int nitems = (K / 64) * (N / 32);
            for (int it = gw; it < nitems; it += ngw) transpose_item(W, K, N, WT, perm, (mat < 2 || mat == 4 || mat == 5 || (mat >= 8 && mat < 12)) ? 1 : 0, scr, it, lane);
        }
        { const float* wsrc = args.in[6]; bf16* wd = (bf16*)(ws + WS_WS);
          for (int i = cu * 512 + tid; i < 2 * GG * GC * GC; i += G * 512) { const int s = i & 127, t = (i >> 7) & 127; const float v = (s <= t) ? wsrc[i] : 0.f; wd[i] = (bf16)(pk2(v, v) & 0xffffu); } }
        for (int m = gw; m < NTOK; m += ngw) {
            const f32x4* xr = (const f32x4*)(x + (size_t)m * DM) + lane; u32x2* o8 = (u32x2*)(HB + (size_t)m * DM) + lane;
#pragma unroll
            for (int j = 0; j < 4; ++j) { const f32x4 v = xr[64 * j]; u32x2 w; w.x = pg8::cvt_pk_f16(v.x, v.y); w.y = pg8::cvt_pk_f16(v.z, v.w); o8[64 * j] = w; }
        }
    }
    grid.sync();

    int dir = 0;
    for (int layer = 0; layer < DEPTH; ++layer) {
        const int j = layer >> 1, mixer = layer & 1;
        for (int step = 0; step < 2; ++step) {
            if (step == 0) {
                pg8::Gemm g; pg8::EpiBf16 E;
                if (mixer == 0) { g = pg8::Gemm{HB, (const bf16*)(ws + WS_ATTN_IN) + (size_t)j * 3072 * DM, NTOK, 3072, DM};
                    E = pg8::EpiBf16{(bf16*)(ws + WS_Q), DM, 0, DM, (size_t)NTOK * DM, 0.125f, nullptr, nullptr}; }
                else { g = pg8::Gemm{HB, (const bf16*)(ws + WS_GMLP_IN) + (size_t)j * 4096 * DM, NTOK, 4096, DM};
                    E = pg8::EpiBf16{(bf16*)(ws + WS_ZZ), 4096, 1, 0, 0, 1.f, (float*)(ws + WS_VST), (LAS float*)(lds + 131072)}; }
                pg8::StaticOrder S; S.rev = dir; dir ^= 1; S.init(g.M, g.N, G, cu);
                for (int rep = 0; rep < (PROBE == 1 ? 2 : 1); ++rep)
                pg8::gemm_phase<pg8::EpiBf16, pg8::StaticOrder, true, true>(lds, g, S, E);
            } else {
                pg8::Gemm g{HB, (const bf16*)(ws + WS_FFN_UP) + (size_t)layer * FF2 * DM, NTOK, FF2, DM};
                pg8::EpiConv E{(bf16*)(ws + WS_G), args.in[10] + (size_t)layer * 3 * FF2, args.in[11] + (size_t)layer * FF2, lds + 131072, FF, FF2, FF, (float*)(ws + WS_HT)};
                pg8::StaticOrder S; S.rev = dir; dir ^= 1; S.init(g.M, g.N, G, cu);
                for (int rep = 0; rep < (PROBE == 4 ? 2 : 1); ++rep)
                pg8::gemm_phase<pg8::EpiConv, pg8::StaticOrder, true, true>(lds, g, S, E);
                GSYNC();
                ffn_fix_phase((const float*)(ws + WS_HT), (bf16*)(ws + WS_G), args.in[10] + (size_t)layer * 3 * FF2, args.in[11] + (size_t)layer * FF2, cu, G, opaque_tid());
            }
            GSYNC();
            if (step == 0) {
                for (int rep = 0; rep < (((PROBE == 2 && mixer == 0) || (PROBE == 3 && mixer == 1)) ? 2 : 1); ++rep)
                if (mixer == 0) attn_phase(lds, (const bf16*)(ws + WS_Q), (const bf16*)(ws + WS_K), (const bf16*)(ws + WS_V), (bf16*)(ws + WS_O), cu, G, dir);
                else spatial_phase(lds, (const bf16*)(ws + WS_ZZ), (bf16*)(ws + WS_GT), (const bf16*)(ws + WS_WS) + (size_t)j * GG * GC * GC, args.in[7] + j * GG * GC, args.in[4] + j * GW, args.in[5] + j * GW, (const float*)(ws + WS_VST), cu, G, dir); dir ^= 1;
                GSYNC();
            }
            const int lnidx = 2 * layer + step;
            {
                pg8::Gemm g;
                if (step == 0 && mixer == 0) g = pg8::Gemm{(const bf16*)(ws + WS_O), (const bf16*)(ws + WS_ATTN_OUT) + (size_t)j * DM * DM, NTOK, DM, DM};
                else if (step == 0) g = pg8::Gemm{(const bf16*)(ws + WS_GT), (const bf16*)(ws + WS_GMLP_OUT) + (size_t)j * DM * GW, NTOK, DM, GW};
                else g = pg8::Gemm{(const bf16*)(ws + WS_G), (const bf16*)(ws + WS_FFN_DOWN) + (size_t)layer * DM * FF, NTOK, DM, FF};
                const int pl = (lnidx - 1) >> 1;
                const float* pgam = lnidx == 0 ? nullptr : (((lnidx - 1) & 1) ? args.in[15] : args.in[13]) + pl * DM;
                const float* pbet = lnidx == 0 ? nullptr : (((lnidx - 1) & 1) ? args.in[16] : args.in[14]) + pl * DM;
                const float* cgam = (step == 0 ? args.in[13] : args.in[15]) + layer * DM;
                const float* cbet = (step == 0 ? args.in[14] : args.in[16]) + layer * DM;
                const bool lastln = lnidx == 2 * DEPTH - 1;
                pg8::EpiResLn E{(const unsigned short*)HB, 0, out, (float*)(ws + WS_ST), cgam, cbet, HB, (unsigned short*)HB,
                                (unsigned*)(ws + WS_CTL + 8192), 128u * (unsigned)lnidx, lastln ? 1 : 0, lds + 131072, dir};
                pg8::StaticOrder S; S.rev = dir; dir ^= 1; S.init(g.M, g.N, G, cu);
                if (PROBE == 9) { pg8::EpiBf16 E0{(bf16*)(ws + WS_R + (step == 1 ? 512 * MiB : 0)), DM, 0, 0, 0, 1.f};
                    pg8::gemm_phase<pg8::EpiBf16, pg8::StaticOrder, true, true>(lds, g, S, E0); }
                pg8::gemm_phase<pg8::EpiResLn, pg8::StaticOrder, true, true>(lds, g, S, E);
            }
            if (lnidx != 2 * DEPTH - 1) GSYNC();
        }
    }
}

extern "C" void kernel_launch(void* const* d_in, const int* in_sizes, int n_in, void* d_out, int out_size, void* d_ws, size_t ws_size, hipStream_t stream) {
    static int grid = 0;
    if (grid == 0) {
        if (n_in != 17 || out_size != NTOK * DM || ws_size < WS_END) { fprintf(stderr, "kernel_launch: unexpected shapes (n_in %d, out %d, ws %zu)\n", n_in, out_size, ws_size); grid = -1; return; }
        int dev = 0, cus = 0, per_cu = 0;
        hipGetDevice(&dev);
        hipDeviceGetAttribute(&cus, hipDeviceAttributeMultiprocessorCount, dev);
        if (hipFuncSetAttribute((const void*)fwd_kernel, hipFuncAttributeMaxDynamicSharedMemorySize, LDS_BYTES) != hipSuccess) { fprintf(stderr, "kernel_launch: hipFuncSetAttribute failed\n"); grid = -1; return; }
        if (hipOccupancyMaxActiveBlocksPerMultiprocessor(&per_cu, (const void*)fwd_kernel, 512, LDS_BYTES) != hipSuccess || per_cu < 1) { fprintf(stderr, "kernel_launch: occupancy query says %d\n", per_cu); per_cu = 1; }
        (void)hipGetLastError();
        grid = cus * per_cu;
        fprintf(stderr, "kernel_launch: grid %d (cus %d x %d)\n", grid, cus, per_cu);
        if (grid != 256) { fprintf(stderr, "kernel_launch: the fused LayerNorm epilogue's group barrier is laid out for a 256-workgroup grid; nothing launched\n"); grid = -1; return; }
    }
    if (grid < 0) return;
    Args a{};
    for (int i = 0; i < 17; ++i) a.in[i] = (const float*)d_in[i];
    a.out = (float*)d_out; a.ws = (unsigned char*)d_ws;
    void* kargs[] = {&a};
    hipError_t e = hipLaunchCooperativeKernel((const void*)fwd_kernel, dim3(grid), dim3(512), kargs, LDS_BYTES, stream);
    if (e != hipSuccess) fprintf(stderr, "cooperative launch failed: %s (grid %d)\n", hipGetErrorString(e), grid);
}
```

```cpp
#include <hip/hip_runtime.h>
#include <hip/hip_cooperative_groups.h>
#include <cstdio>
#include <cstdint>
namespace cg = cooperative_groups;
__device__ __forceinline__ int opaque_tid() { int t = threadIdx.x; asm volatile("" : "+v"(t)); return t; }
namespace pg8 {
#define PG8_LAS __attribute__((address_space(3)))
typedef unsigned short bf16_t;
typedef short bf16x8 __attribute__((ext_vector_type(8)));
typedef float f32x4 __attribute__((ext_vector_type(4)));
typedef unsigned u32x4 __attribute__((ext_vector_type(4)));
constexpr int BM = 256, BK = 64, HALF = 128, HTB = HALF * BK * 2  , STAGE_BYTES = 8 * HTB, NXCD = 8, WGM = 8;

__host__ __device__ __forceinline__ int lds_byte(int r, int c) { const int st = (r >> 4) * 2 + (c >> 5), rr = r & 15, cc = c & 31, ob = rr * 64 + cc * 2; return st * 1024 + (ob ^ (((ob >> 9) & 1) << 5)); }
__host__ __device__ __forceinline__ void stage_rc(int b, int& R, int& C) { const int st = b / 1024, sb = b % 1024, swz = sb ^ (((sb >> 9) & 1) << 5); R = (st >> 1) * 16 + swz / 64; C = (st & 1) * 32 + (swz % 64) / 2; }
__host__ __device__ __forceinline__ int perm32(int rho) { const int n = rho >> 4, i = rho & 15; return 8 * (i >> 2) + 4 * n + (i & 3); }

struct Unit { int pm, pn; };
struct Gemm { const bf16_t* A; const bf16_t* Bt; int M, N, K; };

struct StaticOrder {
    int nM, nN, nwg, G, c, rev = 0;
    __host__ __device__ void init(int M, int N, int G_, int c_) { nM = M / BM; nN = N / BM; nwg = nM * nN; G = G_; c = c_; }
    __host__ __device__ bool next(int i, Unit& u) const {
        if ((long)i * G + c >= nwg) return false;
        const long L = (long)(rev ? (nwg / G - 1 - i) : i) * G + c;
        int wgid = (int)L; { const int q = nwg / NXCD, r = nwg % NXCD, xcd = wgid % NXCD, off = wgid / NXCD; wgid = (xcd < r ? xcd * (q + 1) : r * (q + 1) + (xcd - r) * q) + off; }
        const int nig = WGM * nN, gid = wgid / nig, fm = gid * WGM, gsz = (nM - fm) < WGM ? (nM - fm) : WGM;
        u.pm = fm + ((wgid % nig) % gsz); u.pn = (wgid % nig) / gsz; return true;
    }
    __device__ __forceinline__ void a_ready(const Unit&) const {}
    __device__ __forceinline__ void done(const Unit&) const {}
};
__device__ __forceinline__ unsigned cvt_pk_bf16(float lo, float hi) { unsigned r; asm volatile("v_cvt_pk_bf16_f32 %0, %1, %2" : "=v"(r) : "v"(lo), "v"(hi)); return r; }
typedef float f32x2 __attribute__((ext_vector_type(2)));
typedef _Float16 f16x8 __attribute__((ext_vector_type(8)));
template <bool F16> __device__ __forceinline__ f32x4 mma16(bf16x8 a, bf16x8 b, f32x4 c) {
    if constexpr (F16) return __builtin_amdgcn_mfma_f32_16x16x32_f16(__builtin_bit_cast(f16x8, a), __builtin_bit_cast(f16x8, b), c, 0, 0, 0);
    else return __builtin_amdgcn_mfma_f32_16x16x32_bf16(a, b, c, 0, 0, 0);
}
__device__ __forceinline__ unsigned cvt_pk_f16(float lo, float hi) { typedef _Float16 h2 __attribute__((ext_vector_type(2))); const h2 v = {(_Float16)lo, (_Float16)hi}; return __builtin_bit_cast(unsigned, v); }
typedef unsigned u32x2e __attribute__((ext_vector_type(2)));
__device__ __forceinline__ float gelu_tanh(float x) {
    const float t = x * (-2.302208198f + (-0.1029432397f) * x * x);
    return x * __builtin_amdgcn_rcpf(1.0f + __builtin_amdgcn_exp2f(t));
}
struct EpiBf16 {
    static constexpr bool PERM = true, AFTER_DRAIN = false, F16 = true;
    bf16_t* O; int ldc; int act; int split_cols; size_t split_stride; float scale0;
    float* vst; PG8_LAS float* sl;
    __device__ __forceinline__ void operator()(const f32x4 (&acc)[2][2][4][2], const Unit& u, int wr, int wc, int fr, int fq) const {
        const int row0 = u.pm * BM + wr * 64 + fr; int colt = u.pn * BM; bf16_t* base = O;
        float sc = 1.f; if (split_cols) { const int t = colt / split_cols; base += (size_t)t * split_stride; colt -= t * split_cols; if (t == 0) sc = scale0; }
        const int col0 = colt + wc * 32 + 8 * fq;
        const bool dost = vst != nullptr && u.pn >= 8;
#pragma unroll
        for (int ai = 0; ai < 2; ++ai)
#pragma unroll
            for (int m = 0; m < 4; ++m) { bf16_t* rowp = base + (size_t)(row0 + ai * HALF + m * 16) * ldc + col0; float rs = 0.f, rq = 0.f;
#pragma unroll
                for (int bj = 0; bj < 2; ++bj) { f32x4 v0 = acc[ai][bj][m][0], v1 = acc[ai][bj][m][1];
                    if (act) { v0 = (f32x4){gelu_tanh(v0[0]), gelu_tanh(v0[1]), gelu_tanh(v0[2]), gelu_tanh(v0[3])};
                               v1 = (f32x4){gelu_tanh(v1[0]), gelu_tanh(v1[1]), gelu_tanh(v1[2]), gelu_tanh(v1[3])}; }
                    if (dost) { rs += ((v0[0] + v0[1]) + (v0[2] + v0[3])) + ((v1[0] + v1[1]) + (v1[2] + v1[3]));
                                rq += ((v0[0] * v0[0] + v0[1] * v0[1]) + (v0[2] * v0[2] + v0[3] * v0[3])) + ((v1[0] * v1[0] + v1[1] * v1[1]) + (v1[2] * v1[2] + v1[3] * v1[3])); }
                    v0 = v0 * sc; v1 = v1 * sc; u32x4 w; w.x = cvt_pk_bf16(v0[0], v0[1]); w.y = cvt_pk_bf16(v0[2], v0[3]); w.z = cvt_pk_bf16(v1[0], v1[1]); w.w = cvt_pk_bf16(v1[2], v1[3]);
                    *(u32x4*)(rowp + bj * HALF) = w; }
                if (dost) { rs += __shfl_xor(rs, 16); rs += __shfl_xor(rs, 32); rq += __shfl_xor(rq, 16); rq += __shfl_xor(rq, 32);
                    const int lrow = ai * HALF + wr * 64 + m * 16 + fr; if (fq == 0) { sl[(lrow * 4 + wc) * 2] = rs; sl[(lrow * 4 + wc) * 2 + 1] = rq; } } }
        if (dost) {
            asm volatile("s_waitcnt lgkmcnt(0)" ::: "memory"); __builtin_amdgcn_s_barrier(); asm volatile("" ::: "memory");
            const int t = opaque_tid();
            if (t < 256) { const f32x4 a = *(PG8_LAS const f32x4*)(sl + t * 8), b = *(PG8_LAS const f32x4*)(sl + t * 8 + 4);
                typedef float f32x2v __attribute__((ext_vector_type(2)));
                *(f32x2v*)(vst + ((size_t)u.pm * BM + t) * 16 + (u.pn - 8) * 2) = (f32x2v){(a[0] + a[2]) + (b[0] + b[2]), (a[1] + a[3]) + (b[1] + b[3])}; }
        }
    }
};
struct EpiRes {
    static constexpr bool PERM = false, AFTER_DRAIN = false, F16 = false;
    const float* base; float* out; int ldc; float alpha;
    __device__ __forceinline__ void operator()(const f32x4 (&acc)[2][2][4][2], const Unit& u, int wr, int wc, int fr, int fq) const {
        const int col0 = u.pn * BM + wc * 32 + 4 * fq;
#pragma unroll
        for (int ai = 0; ai < 2; ++ai)
#pragma unroll
            for (int m = 0; m < 4; ++m) { const size_t off = (size_t)(u.pm * BM + ai * HALF + wr * 64 + m * 16 + fr) * ldc + col0;
#pragma unroll
                for (int bj = 0; bj < 2; ++bj)
#pragma unroll
                    for (int n = 0; n < 2; ++n) { const f32x4 bs = *(const f32x4*)(base + off + bj * HALF + n * 16);
                        *(f32x4*)(out + off + bj * HALF + n * 16) = bs * alpha + acc[ai][bj][m][n]; }
                asm volatile("" ::: "memory"); }
    }
};

template <int CTRL> __device__ __forceinline__ float dpp_mov(float old, float src) {
    return __builtin_bit_cast(float, __builtin_amdgcn_update_dpp(__builtin_bit_cast(int, old), __builtin_bit_cast(int, src), CTRL, 0xf, 0xf, false));
}
struct SeqOrder {
    int G, c;
    __device__ bool next(int i, Unit& u) const { if (i >= 22) return false; int it, step;
        if (i < 16) { it = c + G * (i >> 3); step = i & 7; } else { const int v = 6 * c + (i - 16); it = 512 + (v >> 3); step = v & 7; }
        u.pn = it >> 5; u.pm = 8 * (it & 31) + step; return true; }
    __device__ __forceinline__ void a_ready(const Unit&) const {}
    __device__ __forceinline__ void done(const Unit&) const {}
};
struct EpiConv {
    static constexpr bool PERM = true, AFTER_DRAIN = false, F16 = true;
    bf16_t* O; const float* cw; const float* cb; PG8_LAS unsigned char* hl; int ldo, ncol2, nfeat; float* ht;
    __device__ __forceinline__ void operator()(const f32x4 (&acc)[2][2][4][2], const Unit& u, int wr, int wc, int fr, int fq) const {
        const int lcol = wc * 32 + 8 * fq;
        { const int t = opaque_tid();
          if (t < 256) { const int p = t >> 5, ch = t & 31, pp = p & 3; const float* src = (pp < 3 ? cw + pp * ncol2 : cb) + (p >> 2) * nfeat + 128 * u.pn + 4 * ch;
              *(PG8_LAS f32x4*)(hl + 10240 + (p * 128 + 4 * ch) * 4) = *(const f32x4*)src; } }
        float* const htu = ht + (size_t)(u.pm * 22 + u.pn) * 1024;
        if (fr >= 14) {
#pragma unroll
            for (int ai = 0; ai < 2; ++ai) { const int k = 2 * ai + wr;
                if (k < 3) { PG8_LAS unsigned char* hp = hl + k * 2048 + (fr - 14) * 1024 + lcol * 4;
#pragma unroll
                    for (int bj = 0; bj < 2; ++bj)
#pragma unroll
                        for (int n = 0; n < 2; ++n) *(PG8_LAS f32x4*)(hp + bj * 512 + n * 16) = acc[ai][bj][3][n]; }
                else {
#pragma unroll
                    for (int bj = 0; bj < 2; ++bj)
#pragma unroll
                        for (int n = 0; n < 2; ++n) *(f32x4*)(htu + (2 + fr - 14) * 256 + bj * 128 + lcol + 4 * n) = acc[ai][bj][3][n]; } }
        }
        if (wr == 0 && fr < 2) {
#pragma unroll
            for (int bj = 0; bj < 2; ++bj)
#pragma unroll
                for (int n = 0; n < 2; ++n) *(f32x4*)(htu + fr * 256 + bj * 128 + lcol + 4 * n) = acc[0][bj][0][n];
        }
        asm volatile("s_waitcnt lgkmcnt(0)" ::: "memory"); __builtin_amdgcn_s_barrier(); asm volatile("" ::: "memory");
#pragma unroll
        for (int n = 0; n < 2; ++n) {
            const int f = 128 * u.pn + lcol + 4 * n;
            PG8_LAS const float* const wl = (PG8_LAS const float*)(hl + 10240) + lcol + 4 * n;
            const f32x4 wg0 = *(PG8_LAS const f32x4*)(wl), wg1 = *(PG8_LAS const f32x4*)(wl + 128), wg2 = *(PG8_LAS const f32x4*)(wl + 256), bg = *(PG8_LAS const f32x4*)(wl + 384);
            const f32x4 wv0 = *(PG8_LAS const f32x4*)(wl + 512), wv1 = *(PG8_LAS const f32x4*)(wl + 640), wv2 = *(PG8_LAS const f32x4*)(wl + 768), bv = *(PG8_LAS const f32x4*)(wl + 896);
#pragma unroll
            for (int ai = 0; ai < 2; ++ai) {
                const int k = 2 * ai + wr;
                const int rslot = k > 0 ? k - 1 : 0;
                PG8_LAS const unsigned char* hp = hl + rslot * 2048 + (lcol + 4 * n) * 4;
                f32x4 hg2 = *(PG8_LAS const f32x4*)hp, hv2 = *(PG8_LAS const f32x4*)(hp + 512), hg1 = *(PG8_LAS const f32x4*)(hp + 1024), hv1 = *(PG8_LAS const f32x4*)(hp + 1536);
                if (k == 0) { hg2 = (f32x4){0.f, 0.f, 0.f, 0.f}; hv2 = hg2; hg1 = hg2; hv1 = hg2; }
#pragma unroll
                for (int m = 0; m < 4; ++m) {
                    float r[4];
#pragma unroll
                    for (int e = 0; e < 4; ++e) {
                        const float xg = acc[ai][0][m][n][e], xv = acc[ai][1][m][n][e];
                        float o1g, o2g, o1v, o2v;
                        if (m == 0) { o1g = hg1[e]; o2g = fr == 0 ? hg2[e] : hg1[e]; o1v = hv1[e]; o2v = fr == 0 ? hv2[e] : hv1[e]; }
                        else { const float pgv = acc[ai][0][m > 0 ? m - 1 : 0][n][e], pvv = acc[ai][1][m > 0 ? m - 1 : 0][n][e];
                            o1g = dpp_mov<0x121>(pgv, pgv); o2g = dpp_mov<0x122>(pgv, pgv); o1v = dpp_mov<0x121>(pvv, pvv); o2v = dpp_mov<0x122>(pvv, pvv); }
                        const float p1g = dpp_mov<0x111>(o1g, xg), p2g = dpp_mov<0x112>(o2g, xg), p1v = dpp_mov<0x111>(o1v, xv), p2v = dpp_mov<0x112>(o2v, xv);
                        const float yg = bg[e] + wg2[e] * xg + wg1[e] * p1g + wg0[e] * p2g;
                        const float yv = bv[e] + wv2[e] * xv + wv1[e] * p1v + wv0[e] * p2v;
                        r[e] = yg * __builtin_amdgcn_rcpf(1.0f + __builtin_amdgcn_exp2f(-1.4426950408889634f * yg)) * yv;
                    }
                    u32x2e w; w.x = cvt_pk_bf16(r[0], r[1]); w.y = cvt_pk_bf16(r[2], r[3]);
                    *(u32x2e*)(O + (size_t)(u.pm * BM + ai * HALF + wr * 64 + m * 16 + fr) * ldo + f) = w;
                }
            }
        }
    }
};

struct EpiResLn {
    static constexpr bool PERM = true, AFTER_DRAIN = false, F16 = false;
    const unsigned short* base16; int isbf; float* out; float* st; const float* cg; const float* cbeta; bf16_t* hb; unsigned short* hf; unsigned* gcnt; unsigned tgt0; int last; PG8_LAS unsigned char* xl; int rev;
    static constexpr int ldc = 1024; static constexpr float alpha = 1.681792830507429f, eps = 1e-5f;
    typedef _Float16 h16x2 __attribute__((ext_vector_type(2)));
    __device__ __forceinline__ f32x4 dec(u32x2e w) const {
        if (isbf) return (f32x4){__uint_as_float(w.x << 16), __uint_as_float(w.x & 0xffff0000u), __uint_as_float(w.y << 16), __uint_as_float(w.y & 0xffff0000u)};
        const float f0 = (float)__builtin_bit_cast(_Float16, (unsigned short)(w.x & 0xffffu)), f1 = (float)__builtin_bit_cast(_Float16, (unsigned short)(w.x >> 16));
        const float f2 = (float)__builtin_bit_cast(_Float16, (unsigned short)(w.y & 0xffffu)), f3 = (float)__builtin_bit_cast(_Float16, (unsigned short)(w.y >> 16));
        return (f32x4){f0, f1, f2, f3}; }
    __device__ __forceinline__ void operator()(f32x4 (&acc)[2][2][4][2], const Unit& u, int wr, int wc, int fr, int fq) const {
        asm volatile("" : "+v"(fr), "+v"(fq));
        typedef float f32x2s __attribute__((ext_vector_type(2)));
        PG8_LAS float* const sl = (PG8_LAS float*)xl; PG8_LAS float* const gl = (PG8_LAS float*)(xl + 8192);
        const int col0 = u.pn * BM + wc * 32 + 8 * fq, lc0 = wc * 32 + 8 * fq;
        { const int t = opaque_tid();
          if (t < 128) { const int which = t >> 6, c4 = 4 * (t & 63); *(PG8_LAS f32x4*)(gl + which * 256 + c4) = *(const f32x4*)((which ? cbeta : cg) + u.pn * BM + c4); } }
        u32x4 nb[2];
        { const size_t off = ((size_t)u.pm * BM + wr * 64 + fr) * ldc + col0;
#pragma unroll
          for (int bj = 0; bj < 2; ++bj) nb[bj] = *(const u32x4*)(base16 + off + bj * HALF); }
#pragma unroll
        for (int i = 0; i < 8; ++i) { const int ai = i >> 2, m = i & 3; const int lrow = ai * HALF + wr * 64 + m * 16 + fr;
            u32x4 cur[2];
#pragma unroll
            for (int bj = 0; bj < 2; ++bj) cur[bj] = nb[bj];
            if (i < 7) { const int lr2 = ((i + 1) >> 2) * HALF + wr * 64 + ((i + 1) & 3) * 16 + fr; const size_t off2 = ((size_t)u.pm * BM + lr2) * ldc + col0;
#pragma unroll
                for (int bj = 0; bj < 2; ++bj) nb[bj] = *(const u32x4*)(base16 + off2 + bj * HALF); }
            asm volatile("" ::: "memory");
            float rsum = 0.f, rq = 0.f;
#pragma unroll
            for (int q = 0; q < 4; ++q) { const int bj = q >> 1, n = q & 1;
                const f32x4 y = dec(n ? (u32x2e){cur[bj].z, cur[bj].w} : (u32x2e){cur[bj].x, cur[bj].y}) * alpha + acc[ai][bj][m][n];
                acc[ai][bj][m][n] = y;
                rsum += (y[0] + y[1]) + (y[2] + y[3]); rq += (y[0] * y[0] + y[1] * y[1]) + (y[2] * y[2] + y[3] * y[3]); }
            rsum += __shfl_xor(rsum, 16); rsum += __shfl_xor(rsum, 32); rq += __shfl_xor(rq, 16); rq += __shfl_xor(rq, 32);
            if (fq == 0) { sl[(lrow * 4 + wc) * 2] = rsum; sl[(lrow * 4 + wc) * 2 + 1] = rq; }
            asm volatile("" ::: "memory"); }
        asm volatile("s_waitcnt lgkmcnt(0)" ::: "memory"); __builtin_amdgcn_s_barrier(); asm volatile("" ::: "memory");
        const int t = opaque_tid();
        if (t < 256) { const f32x4 a = *(PG8_LAS const f32x4*)(sl + t * 8), b = *(PG8_LAS const f32x4*)(sl + t * 8 + 4);
            const float ssum = (a[0] + a[2]) + (b[0] + b[2]), ssq = (a[1] + a[3]) + (b[1] + b[3]);
            __hip_atomic_store((unsigned long long*)(st + ((size_t)u.pm * BM + t) * 8 + u.pn * 2), ((unsigned long long)__float_as_uint(ssq) << 32) | __float_as_uint(ssum), __ATOMIC_RELAXED, __HIP_MEMORY_SCOPE_AGENT); }
        asm volatile("s_waitcnt vmcnt(0) lgkmcnt(0)" ::: "memory"); __builtin_amdgcn_s_barrier(); asm volatile("" ::: "memory");
        if (t == 0) {
            unsigned* const ctr = gcnt + 64 * (blockIdx.x & 7); const unsigned target = tgt0 + 32u * (unsigned)((rev ? 3 - ((u.pm >> 3) & 3) : ((u.pm >> 3) & 3)) + 1);
            __hip_atomic_fetch_add(ctr, 1u, __ATOMIC_RELAXED, __HIP_MEMORY_SCOPE_AGENT);
            while (__hip_atomic_load(ctr, __ATOMIC_RELAXED, __HIP_MEMORY_SCOPE_AGENT) < target) __builtin_amdgcn_s_sleep(1);
        }
        __builtin_amdgcn_s_barrier(); asm volatile("" ::: "memory");
        if (t < 256) { const size_t row = (size_t)u.pm * BM + t;
            float s = 0.f, q = 0.f;
#pragma unroll
            for (int k4 = 0; k4 < 4; ++k4) { const unsigned long long w = __hip_atomic_load((const unsigned long long*)(st + row * 8 + 2 * k4), __ATOMIC_RELAXED, __HIP_MEMORY_SCOPE_AGENT);
                s += __uint_as_float((unsigned)w); q += __uint_as_float((unsigned)(w >> 32)); }
            const float mean = s * (1.f / 1024.f), rstd = 1.f / sqrtf(q * (1.f / 1024.f) - mean * mean + eps);
            *(PG8_LAS f32x2s*)(sl + 2 * t) = (f32x2s){mean, rstd}; }
        asm volatile("s_waitcnt lgkmcnt(0)" ::: "memory"); __builtin_amdgcn_s_barrier(); asm volatile("" ::: "memory");
#pragma unroll
        for (int i = 0; i < 8; ++i) { const int ai = i >> 2, m = i & 3; const int lrow = ai * HALF + wr * 64 + m * 16 + fr; const size_t off = ((size_t)u.pm * BM + lrow) * ldc + col0;
            const f32x2s mr = *(PG8_LAS const f32x2s*)(sl + 2 * lrow); u32x4 pw;
#pragma unroll
            for (int q = 0; q < 4; ++q) { const int bj = q >> 1, n = q & 1;
                const f32x4 g4 = *(PG8_LAS const f32x4*)(gl + lc0 + bj * HALF + n * 4), b4 = *(PG8_LAS const f32x4*)(gl + 256 + lc0 + bj * HALF + n * 4);
                const f32x4 o = (acc[ai][bj][m][n] - mr.x) * mr.y * g4 + b4;
                if (last) *(f32x4*)(out + off + bj * HALF + n * 4) = o;
                else { if (n == 0) { pw.x = cvt_pk_f16(o[0], o[1]); pw.y = cvt_pk_f16(o[2], o[3]); } else { pw.z = cvt_pk_f16(o[0], o[1]); pw.w = cvt_pk_f16(o[2], o[3]); *(u32x4*)(hf + off + bj * HALF) = pw; } } }
            asm volatile("" ::: "memory"); }
    }
};

template <class Epi, class Sched, bool ALIGN_EPI = false, bool SP2 = false>
__device__ __forceinline__ void gemm_phase(PG8_LAS unsigned char* lds, const Gemm g, const Sched& S, const Epi& E) {
    const int tid = opaque_tid(), wid = __builtin_amdgcn_readfirstlane(tid >> 6), lane = tid & 63, wr = wid >> 2, wc = wid & 3, fr = lane & 15, fq = lane >> 4;
    const int K = g.K, nt = K / BK;
    unsigned voffA[2], voffB[2];
#pragma unroll
    for (int i = 0; i < 2; ++i) { int R, C; stage_rc(tid * 16 + i * 8192, R, C); const int Rb = Epi::PERM ? ((R & ~31) + perm32(R & 31)) : R;
        voffA[i] = (unsigned)(R * K + C) * 2u; voffB[i] = (unsigned)(Rb * K + C) * 2u; }
    const size_t kstep = (size_t)(BK * 2);
    const size_t hstep = (size_t)HALF * K * 2;
    const size_t tstep = 2 * hstep;
    const unsigned ldsw = (unsigned)wid * 1024u;
    const int aoff = lds_byte(wr * 64 + fr, fq * 8), boff = lds_byte(wc * 32 + fr, fq * 8);
#define PG8_SA(b, h) (((b) * 2 + (h)) * HTB)
#define PG8_SB(b, h) ((4 + (b) * 2 + (h)) * HTB)
#define PG8_STAGE(bufoff, gbase, voff) do { _Pragma("unroll") for (int _i = 0; _i < 2; ++_i) \
        __builtin_amdgcn_global_load_lds((const unsigned*)((const char*)(gbase) + (voff)[_i]), (PG8_LAS unsigned*)(lds + (bufoff) + ldsw + _i * 8192), 16, 0, 0); } while (0)
#define PG8_LDA(dst, b, h) do { _Pragma("unroll") for (int m = 0; m < 4; ++m) _Pragma("unroll") for (int k = 0; k < 2; ++k) dst[m][k] = *(const PG8_LAS bf16x8*)(lds + PG8_SA(b, h) + aoff + m * 2048 + k * 1024); } while (0)
#define PG8_LDB(dst, b, h) do { _Pragma("unroll") for (int n = 0; n < 2; ++n) _Pragma("unroll") for (int k = 0; k < 2; ++k) dst[n][k] = *(const PG8_LAS bf16x8*)(lds + PG8_SB(b, h) + boff + n * 2048 + k * 1024); } while (0)
#define PG8_MMA(ai, bj, At, Bt) do { __builtin_amdgcn_s_setprio(1); _Pragma("unroll") for (int m = 0; m < 4; ++m) _Pragma("unroll") for (int n = 0; n < 2; ++n) _Pragma("unroll") for (int k = 0; k < 2; ++k) \
        acc[ai][bj][m][n] = mma16<Epi::F16>(Bt[n][k], At[m][k], acc[ai][bj][m][n]); __builtin_amdgcn_s_setprio(0); } while (0)
#define PG8_WAIT_V(n) asm volatile("s_waitcnt vmcnt(" #n ")" ::: "memory")
#define PG8_WAIT_L(n) asm volatile("s_waitcnt lgkmcnt(" #n ")" ::: "memory")
#define PG8_BAR __builtin_amdgcn_s_barrier()
#define PG8_SCHED __builtin_amdgcn_sched_barrier(0)
    Unit cur, nxt; int ui = 0;
    if (!S.next(0, cur)) return;
    f32x4 acc[2][2][4][2];
#pragma unroll
    for (int a = 0; a < 2; ++a)
#pragma unroll
        for (int b = 0; b < 2; ++b)
#pragma unroll
            for (int m = 0; m < 4; ++m)
#pragma unroll
                for (int n = 0; n < 2; ++n) acc[a][b][m][n] = (f32x4){0.f, 0.f, 0.f, 0.f};
    bf16x8 At[4][2], B0[2][2], B1[2][2];
    const char* cA = (const char*)g.A + (size_t)cur.pm * tstep; const char* cB = (const char*)g.Bt + (size_t)cur.pn * tstep;
    S.a_ready(cur);
    if constexpr (SP2) {
        PG8_STAGE(PG8_SB(0, 0), cB, voffB); PG8_STAGE(PG8_SB(0, 1), cB + hstep, voffB); PG8_STAGE(PG8_SA(0, 0), cA, voffA); PG8_STAGE(PG8_SA(0, 1), cA + hstep, voffA);
        if (wr == 1) PG8_BAR;
        PG8_WAIT_V(2); PG8_BAR;
        PG8_STAGE(PG8_SB(1, 0), cB + kstep, voffB); PG8_STAGE(PG8_SA(1, 0), cA + kstep, voffA); PG8_STAGE(PG8_SB(1, 1), cB + hstep + kstep, voffB);
        PG8_WAIT_V(6); PG8_BAR;
    } else {
        PG8_STAGE(PG8_SB(0, 0), cB, voffB); PG8_STAGE(PG8_SA(0, 0), cA, voffA); PG8_STAGE(PG8_SB(0, 1), cB + hstep, voffB); PG8_STAGE(PG8_SA(0, 1), cA + hstep, voffA);
        if (wr == 1) PG8_BAR;
        PG8_WAIT_V(4); PG8_BAR;
        PG8_STAGE(PG8_SB(1, 0), cB + kstep, voffB); PG8_STAGE(PG8_SA(1, 0), cA + kstep, voffA); PG8_STAGE(PG8_SB(1, 1), cB + hstep + kstep, voffB);
        PG8_WAIT_V(6); PG8_BAR;
    }
    for (;;) {
        const bool has_next = S.next(ui + 1, nxt);
        const char* nA = has_next ? (const char*)g.A + (size_t)nxt.pm * tstep : cA; const char* nB = has_next ? (const char*)g.Bt + (size_t)nxt.pn * tstep : cB;
        for (int t = 0; t < nt; t += 2) {
            const bool last = (t == nt - 2);
            const char* a1 = cA + (size_t)(t + 1) * kstep;
            const char* a2 = last ? nA : cA + (size_t)(t + 2) * kstep; const char* b2 = last ? nB : cB + (size_t)(t + 2) * kstep;
            const char* a3 = a2 + kstep; const char* b3 = b2 + kstep;
            if (last && has_next) S.a_ready(nxt);
            if constexpr (SP2) {
            PG8_LDB(B0, 0, 0); PG8_LDB(B1, 0, 1); PG8_SCHED; PG8_LDA(At, 0, 0); PG8_STAGE(PG8_SA(1, 1), a1 + hstep, voffA);
            PG8_WAIT_V(8); PG8_WAIT_L(0); PG8_BAR; PG8_MMA(0, 0, At, B0); PG8_MMA(0, 1, At, B1); PG8_BAR; PG8_SCHED;
            PG8_LDA(At, 0, 1); PG8_STAGE(PG8_SB(0, 0), b2, voffB); PG8_STAGE(PG8_SB(0, 1), b2 + hstep, voffB); PG8_STAGE(PG8_SA(0, 0), a2, voffA);
            PG8_WAIT_V(8); PG8_WAIT_L(0); PG8_BAR; PG8_MMA(1, 0, At, B0); PG8_MMA(1, 1, At, B1); PG8_BAR; PG8_SCHED;
            PG8_LDB(B0, 1, 0); PG8_LDB(B1, 1, 1); PG8_SCHED; PG8_LDA(At, 1, 0); PG8_STAGE(PG8_SA(0, 1), a2 + hstep, voffA);
            PG8_WAIT_V(8); PG8_WAIT_L(0); PG8_BAR; PG8_MMA(0, 0, At, B0); PG8_MMA(0, 1, At, B1); PG8_BAR; PG8_SCHED;
            PG8_LDA(At, 1, 1); PG8_STAGE(PG8_SB(1, 0), b3, voffB); PG8_STAGE(PG8_SB(1, 1), b3 + hstep, voffB); PG8_STAGE(PG8_SA(1, 0), a3, voffA);
            PG8_WAIT_V(8); PG8_WAIT_L(0); PG8_BAR; PG8_MMA(1, 0, At, B0); PG8_MMA(1, 1, At, B1); PG8_BAR; PG8_SCHED;
            } else {
            PG8_LDB(B0, 0, 0); PG8_SCHED; PG8_LDA(At, 0, 0); PG8_STAGE(PG8_SA(1, 1), a1 + hstep, voffA);
            PG8_WAIT_L(8); PG8_BAR; PG8_WAIT_L(0); PG8_MMA(0, 0, At, B0); PG8_BAR; PG8_SCHED;
            PG8_LDB(B1, 0, 1); PG8_STAGE(PG8_SB(0, 0), b2, voffB);
            PG8_BAR; PG8_WAIT_L(0); PG8_MMA(0, 1, At, B1); PG8_BAR;
            PG8_LDA(At, 0, 1); PG8_STAGE(PG8_SA(0, 0), a2, voffA);
            PG8_BAR; PG8_WAIT_L(0); PG8_MMA(1, 0, At, B0); PG8_BAR; PG8_SCHED;
            PG8_STAGE(PG8_SB(0, 1), b2 + hstep, voffB);
            PG8_WAIT_V(6); PG8_BAR; PG8_MMA(1, 1, At, B1); PG8_BAR;
            PG8_LDB(B0, 1, 0); PG8_SCHED; PG8_LDA(At, 1, 0); PG8_STAGE(PG8_SA(0, 1), a2 + hstep, voffA);
            PG8_WAIT_L(8); PG8_BAR; PG8_WAIT_L(0); PG8_MMA(0, 0, At, B0); PG8_BAR; PG8_SCHED;
            PG8_LDB(B1, 1, 1); PG8_STAGE(PG8_SB(1, 0), b3, voffB);
            PG8_BAR; PG8_WAIT_L(0); PG8_MMA(0, 1, At, B1); PG8_BAR;
            PG8_LDA(At, 1, 1); PG8_STAGE(PG8_SA(1, 0), a3, voffA);
            PG8_BAR; PG8_WAIT_L(0); PG8_MMA(1, 0, At, B0); PG8_BAR; PG8_SCHED;
            PG8_STAGE(PG8_SB(1, 1), b3 + hstep, voffB);
            PG8_WAIT_V(6); PG8_BAR; PG8_MMA(1, 1, At, B1); PG8_BAR;
            }
        }
        if constexpr (ALIGN_EPI) { if (wr == 0) PG8_BAR; }
        if constexpr (!Epi::AFTER_DRAIN) { E(acc, cur, wr, wc, fr, fq); S.done(cur); }
        if (!has_next) break;
#pragma unroll
        for (int a = 0; a < 2; ++a)
#pragma unroll
            for (int b = 0; b < 2; ++b)
#pragma unroll
                for (int m = 0; m < 4; ++m)
#pragma unroll
                    for (int n = 0; n < 2; ++n) acc[a][b][m][n] = (f32x4){0.f, 0.f, 0.f, 0.f};
        cur = nxt; cA = nA; cB = nB; ++ui;
        if constexpr (ALIGN_EPI) { if (wr == 1) PG8_BAR; }
    }
    PG8_WAIT_V(0);
    if constexpr (!ALIGN_EPI) { if (wr == 0) PG8_BAR; }
    PG8_BAR;
    if constexpr (Epi::AFTER_DRAIN) { E.fused(acc, cur, wr, wc, fr, fq, lds, wid, lane); S.done(cur); }
#undef PG8_SA
#undef PG8_SB
#undef PG8_STAGE
#undef PG8_LDA
#undef PG8_LDB
#undef PG8_MMA
#undef PG8_WAIT_V
#undef PG8_WAIT_L
#undef PG8_BAR
#undef PG8_SCHED
}
}

constexpr int NB = 32, SEQ = 2048, DM = 1024, NTOK = NB * SEQ;
constexpr int NH = 16, HD = 64, GW = 2048, GG = 8, GC = 128, FF = 2816, FF2 = 5632, DEPTH = 4;
constexpr float LN_EPS = 1e-5f;
constexpr float DN_ALPHA = 1.681792830507429f;
constexpr int HALF_TOK = NTOK / 2;

constexpr size_t MiB = 1u << 20;
constexpr size_t WS_ATTN_IN = 0, WS_ATTN_OUT = 12 * MiB, WS_GMLP_IN = 16 * MiB, WS_GMLP_OUT = 32 * MiB, WS_FFN_UP = 40 * MiB, WS_FFN_DOWN = 84 * MiB, WS_WS = 106 * MiB;
constexpr size_t WS_MS = 110 * MiB;
constexpr size_t WS_CTL = 107 * MiB;
constexpr size_t WS_ST = 108 * MiB;
constexpr size_t WS_HB = 112 * MiB;
constexpr size_t WS_R = 240 * MiB;
constexpr size_t WS_Q = WS_R, WS_K = WS_R + 128 * MiB, WS_V = WS_R + 256 * MiB, WS_O = WS_R + 384 * MiB;
constexpr size_t WS_ZZ = WS_R, WS_GT = WS_R + 512 * MiB;
constexpr size_t WS_HT = WS_R + 400 * MiB;
constexpr size_t WS_G = WS_R;
constexpr size_t WS_VST = 1008 * MiB;
constexpr size_t WS_END = 1012 * MiB;

constexpr int LDS_BYTES = 147456;

#define LAS __attribute__((address_space(3)))
typedef unsigned short bf16;
typedef unsigned u32x4 __attribute__((ext_vector_type(4)));
typedef unsigned u32x2 __attribute__((ext_vector_type(2)));
typedef float f32x4 __attribute__((ext_vector_type(4)));
typedef float f32x16 __attribute__((ext_vector_type(16)));
typedef short bf16x8 __attribute__((ext_vector_type(8)));
typedef short s16x4 __attribute__((ext_vector_type(4)));

__device__ __forceinline__ unsigned pk2(float lo, float hi) { return pg8::cvt_pk_bf16(lo, hi); }
__device__ __forceinline__ float bflo(unsigned w) { return __uint_as_float(w << 16); }
__device__ __forceinline__ float bfhi(unsigned w) { return __uint_as_float(w & 0xffff0000u); }
__device__ __forceinline__ float wave_sum(float v) {
#pragma unroll
    for (int o = 1; o < 64; o <<= 1) v += __shfl_xor(v, o);
    return v;
}
__device__ __forceinline__ s16x4 vtr(LAS const unsigned char* p) { return __builtin_bit_cast(s16x4, __builtin_amdgcn_ds_read_tr16_b64_v4i16((LAS s16x4*)p)); }

__device__ __forceinline__ void transpose_item(const float* W, int K, int N, bf16* WT, int perm, int f16, LAS float* scr, int item, int lane) {
    const int nblk = N / 32, kb = item / nblk, nb = item % nblk, k0 = 64 * kb, n0 = 32 * nb;
    int r0 = n0;
    if (perm) { const int bj = n0 / FF, f0 = n0 - bj * FF; r0 = (f0 >> 7) * 256 + bj * 128 + (f0 & 127); }
#pragma unroll 8
    for (int i = 0; i < 32; ++i) { const int kk = 2 * i + (lane >> 5); scr[kk * 33 + (lane & 31)] = W[(size_t)(k0 + kk) * N + n0 + (lane & 31)]; }
    asm volatile("s_waitcnt lgkmcnt(0)" ::: "memory");
    const int c = lane & 7;
#pragma unroll
    for (int j = 0; j < 4; ++j) { const int n = (lane >> 3) + 8 * j; const LAS float* s = scr + (8 * c) * 33 + n;
        u32x4 o; if (f16) { o.x = pg8::cvt_pk_f16(s[0 * 33], s[1 * 33]); o.y = pg8::cvt_pk_f16(s[2 * 33], s[3 * 33]); o.z = pg8::cvt_pk_f16(s[4 * 33], s[5 * 33]); o.w = pg8::cvt_pk_f16(s[6 * 33], s[7 * 33]); }
        else { o.x = pk2(s[0 * 33], s[1 * 33]); o.y = pk2(s[2 * 33], s[3 * 33]); o.z = pk2(s[4 * 33], s[5 * 33]); o.w = pk2(s[6 * 33], s[7 * 33]); }
        *(u32x4*)(WT + (size_t)(r0 + n) * K + k0 + 8 * c) = o; }
    asm volatile("s_waitcnt lgkmcnt(0)" ::: "memory");
}

struct Args { const float* in[17]; float* out; unsigned char* ws; };

__device__ __forceinline__ void ln_apply(const float* Y, float* Yo, bf16* HB, const float* st, float* ms, const float* gam, const float* bet, int gw, int ngw, int lane) {
    f32x4 g4[4], b4[4];
#pragma unroll
    for (int j = 0; j < 4; ++j) { g4[j] = ((const f32x4*)gam)[lane + 64 * j]; b4[j] = ((const f32x4*)bet)[lane + 64 * j]; }
    for (int m = gw; m < NTOK; m += ngw) {
        const f32x4* yr = (const f32x4*)(Y + (size_t)m * DM) + lane;
        f32x4 v[4];
#pragma unroll
        for (int j = 0; j < 4; ++j) v[j] = yr[64 * j];
        const f32x4 a = *(const f32x4*)(st + (size_t)m * 8), b = *(const f32x4*)(st + (size_t)m * 8 + 4);
        const float s = (a[0] + a[2]) + (b[0] + b[2]), q = (a[1] + a[3]) + (b[1] + b[3]);
        const float mean = s * (1.f / DM), rstd = 1.f / sqrtf(q * (1.f / DM) - mean * mean + LN_EPS);
        if (lane == 0) { ms[(size_t)m * 2] = mean; ms[(size_t)m * 2 + 1] = rstd; }
        u32x2* o8 = (u32x2*)(HB + (size_t)m * DM) + lane;
#pragma unroll
        for (int j = 0; j < 4; ++j) { const f32x4 o = (v[j] - mean) * rstd * g4[j] + b4[j]; if (Yo) ((f32x4*)(Yo + (size_t)m * DM) + lane)[64 * j] = o; u32x2 w; w.x = pk2(o.x, o.y); w.y = pk2(o.z, o.w); o8[64 * j] = w; }
    }
}

__device__ __forceinline__ void ffn_fix_phase(const float* HT, bf16* Gb, const float* cw, const float* cb, int cu, int G, int tid) {
    const int sub = tid >> 6, r = (tid >> 5) & 1, f = (tid & 31) * 4;
    for (int up = cu * 8 + sub; up < 224 * 22; up += G * 8) {
        const int pn = up % 22, pq = up / 22, pm = pq + pq / 7 + 1;
        const float* hc = HT + (size_t)(pm * 22 + pn) * 1024; const float* hp = HT + (size_t)((pm - 1) * 22 + pn) * 1024;
        f32x4 y[2];
#pragma unroll
        for (int hh = 0; hh < 2; ++hh) { const int c = hh * 128 + f; const int F = hh * FF + 128 * pn + f;
            const f32x4 h0 = *(const f32x4*)(hc + c), h1 = *(const f32x4*)(hc + 256 + c), t0 = *(const f32x4*)(hp + 512 + c), t1 = *(const f32x4*)(hp + 768 + c);
            const f32x4 x0 = r ? h1 : h0, xm1 = r ? h0 : t1, xm2 = r ? t1 : t0;
            y[hh] = *(const f32x4*)(cb + F) + *(const f32x4*)(cw + F) * xm2 + *(const f32x4*)(cw + FF2 + F) * xm1 + *(const f32x4*)(cw + 2 * FF2 + F) * x0; }
        float v[4];
#pragma unroll
        for (int e = 0; e < 4; ++e) v[e] = y[0][e] * __builtin_amdgcn_rcpf(1.0f + __builtin_amdgcn_exp2f(-1.4426950408889634f * y[0][e])) * y[1][e];
        u32x2 w; w.x = pk2(v[0], v[1]); w.y = pk2(v[2], v[3]);
        *(u32x2*)(Gb + (size_t)(pm * 256 + r) * FF + 128 * pn + f) = w;
    }
}

__device__ __forceinline__ void attn_phase(LAS unsigned char* lds, const bf16* Q, const bf16* K, const bf16* V, bf16* O, int cu, int G, int rev) {
    const int tid = opaque_tid(), lane = tid & 63, wid = __builtin_amdgcn_readfirstlane(tid >> 6), q32 = lane & 31, hi = lane >> 5, li = lane & 15;
    LAS unsigned char* Ks = lds + wid * 10752;
    LAS unsigned char* Vs = Ks + 4608;
    const int lkey = lane >> 3, lch = lane & 7;
    const float LOG2E = 1.4426950408889634f;
    for (int k = 0; k < 16; ++k) {
        const int idx = cu * 8 + wid + 2048 * (k & 3), b = 4 * (idx & 7) + (rev ? 3 - (k >> 2) : (k >> 2)), h = (idx >> 3) & 15, qb = idx >> 7;
        const size_t rowbase = (size_t)b * SEQ;
        const int q0w = qb * 32;
        bf16x8 qf[4];
        { const bf16* qp = Q + (rowbase + q0w + q32) * DM + h * HD + hi * 8;
#pragma unroll
          for (int ks = 0; ks < 4; ++ks) qf[ks] = *(const bf16x8*)(qp + ks * 16); }
        f32x16 o0, o1;
#pragma unroll
        for (int r = 0; r < 16; ++r) { o0[r] = 0.f; o1[r] = 0.f; }
        float R = 0.f;
        const bf16* kp = K + (rowbase + lkey) * DM + h * HD + lch * 8;
        const bf16* vp = V + (rowbase + lkey) * DM + h * HD + lch * 8;
        u32x4 kr[4], vr[4];
#pragma unroll
        for (int jj = 0; jj < 4; ++jj) { kr[jj] = *(const u32x4*)(kp + (size_t)(q0w + 8 * jj) * DM); vr[jj] = *(const u32x4*)(vp + (size_t)(q0w + 8 * jj) * DM); }
        for (int key0 = q0w; key0 >= 0; key0 -= 32) {
#pragma unroll
            for (int jj = 0; jj < 4; ++jj) { *(LAS u32x4*)(Ks + (lkey + 8 * jj) * 144 + lch * 16) = kr[jj]; *(LAS u32x4*)(Vs + (lkey + 8 * jj) * 192 + lch * 16) = vr[jj]; }
            asm volatile("s_waitcnt lgkmcnt(0)" ::: "memory");
            if (key0 >= 32) {
#pragma unroll
                for (int jj = 0; jj < 4; ++jj) { kr[jj] = *(const u32x4*)(kp + (size_t)(key0 - 32 + 8 * jj) * DM); vr[jj] = *(const u32x4*)(vp + (size_t)(key0 - 32 + 8 * jj) * DM); } }
            const bool diag = (key0 == q0w);
            f32x16 s;
#pragma unroll
            for (int r = 0; r < 16; ++r) s[r] = 0.f;
#pragma unroll
            for (int ks = 0; ks < 4; ++ks) { const bf16x8 kf = *(LAS const bf16x8*)(Ks + q32 * 144 + (16 * ks + 8 * hi) * 2);
                s = __builtin_amdgcn_mfma_f32_32x32x16_bf16(kf, qf[ks], s, 0, 0, 0); }
            float zs[16], l1[16];
#pragma unroll
            for (int r = 0; r < 16; ++r) { const float z = s[r] * LOG2E; const float e = __builtin_amdgcn_exp2f(-__builtin_fabsf(z)); const float t = __builtin_amdgcn_logf(1.0f + e);
                float l = -(__builtin_fmaxf(z, 0.f) + t);
                if (diag) { const int kl = 8 * (r >> 2) + 4 * hi + (r & 3); if (kl >= q32) l = 0.f; }
                zs[r] = z; l1[r] = l; }
            float G0[4], G1[4];
#pragma unroll
            for (int j = 0; j < 4; ++j) { const float gs = (l1[4 * j] + l1[4 * j + 1]) + (l1[4 * j + 2] + l1[4 * j + 3]);
                auto rr = __builtin_amdgcn_permlane32_swap(__float_as_uint(gs), __float_as_uint(gs), false, false); G0[j] = __uint_as_float(rr[0]); G1[j] = __uint_as_float(rr[1]); }
            float p[16]; float run = R;
#pragma unroll
            for (int j = 3; j >= 0; --j) { float sfx = run + (hi == 0 ? G1[j] : 0.f);
#pragma unroll
                for (int e = 3; e >= 0; --e) { const int r = 4 * j + e; float val = __builtin_amdgcn_exp2f(l1[r] + zs[r] + sfx);
                    if (diag) { const int kl = 8 * j + 4 * hi + e; if (kl >= q32) val = 0.f; }
                    p[r] = val; sfx += l1[r]; }
                run += G0[j] + G1[j]; }
            R = run;
#pragma unroll
            for (int ks2 = 0; ks2 < 2; ++ks2) {
                u32x4 pw; pw.x = pk2(p[8 * ks2], p[8 * ks2 + 1]); pw.y = pk2(p[8 * ks2 + 2], p[8 * ks2 + 3]); pw.z = pk2(p[8 * ks2 + 4], p[8 * ks2 + 5]); pw.w = pk2(p[8 * ks2 + 6], p[8 * ks2 + 7]);
                const bf16x8 pb = __builtin_bit_cast(bf16x8, pw);
#pragma unroll
                for (int dh = 0; dh < 2; ++dh) {
                    LAS const unsigned char* va = Vs + (16 * ks2 + 4 * hi + (li >> 2)) * 192 + (32 * dh + 16 * ((lane >> 4) & 1) + 4 * (li & 3)) * 2;
                    const s16x4 lo = vtr(va), hi4 = vtr(va + 8 * 192);
                    const bf16x8 vf = (bf16x8){lo[0], lo[1], lo[2], lo[3], hi4[0], hi4[1], hi4[2], hi4[3]};
                    if (dh == 0) o0 = __builtin_amdgcn_mfma_f32_32x32x16_bf16(vf, pb, o0, 0, 0, 0);
                    else         o1 = __builtin_amdgcn_mfma_f32_32x32x16_bf16(vf, pb, o1, 0, 0, 0);
                }
            }
            asm volatile("s_waitcnt lgkmcnt(0)" ::: "memory");
            if (__all(R < -150.0f)) break;
        }
        bf16* op = O + (rowbase + q0w + q32) * DM + h * HD + 4 * hi;
#pragma unroll
        for (int j = 0; j < 4; ++j) { u32x2 w0, w1; w0.x = pk2(o0[4 * j], o0[4 * j + 1]); w0.y = pk2(o0[4 * j + 2], o0[4 * j + 3]); w1.x = pk2(o1[4 * j], o1[4 * j + 1]); w1.y = pk2(o1[4 * j + 2], o1[4 * j + 3]);
            *(u32x2*)(op + 8 * j) = w0; *(u32x2*)(op + 32 + 8 * j) = w1; }
    }
    __syncthreads();
}

__device__ __forceinline__ void spatial_phase(LAS unsigned char* lds, const bf16* ZZ, bf16* GT, const bf16* Wc, const float* bs, const float* gam, const float* bet, const float* VST, int cu, int G, int rev) {
    const int tid = opaque_tid(), lane = tid & 63, wid = __builtin_amdgcn_readfirstlane(tid >> 6), fr = lane & 15, kg = lane >> 4;
    LAS float* st = (LAS float*)(lds + 69632);
    const int wr = wid >> 2, wc = wid & 3;
    for (int k = 0; k < 2; ++k) {
        const int cls = 2 * k + (cu >> 7); const int chunk = 64 * (cu & 7) + 16 * (rev ? 3 - cls : cls) + ((cu >> 3) & 15);
        const size_t row0 = (size_t)chunk * GC;
        __syncthreads();
        { const int row = tid >> 2, part = tid & 3;
          const f32x4 a = *(const f32x4*)(VST + (row0 + row) * 16 + part * 4);
          float sm = a[0] + a[2], sq = a[1] + a[3];
          sm += __shfl_xor(sm, 1); sm += __shfl_xor(sm, 2); sq += __shfl_xor(sq, 1); sq += __shfl_xor(sq, 2);
          if (part == 0) { const float mean = sm * (1.f / GW); st[2 * row] = mean; st[2 * row + 1] = 1.f / sqrtf(sq * (1.f / GW) - mean * mean + LN_EPS); } }
        const int c8 = tid & 31, srow = tid >> 5;
        LAS unsigned char* const wl = lds + 72704;
        const int wt = tid >> 2, wq = tid & 3;
        u32x4 nv[8], nw[4];
#pragma unroll
        for (int it = 0; it < 8; ++it) nv[it] = *(const u32x4*)(ZZ + (row0 + it * 16 + srow) * 4096 + GW + c8 * 8);
#pragma unroll
        for (int q = 0; q < 4; ++q) nw[q] = *(const u32x4*)(Wc + (size_t)wt * GC + wq * 32 + q * 8);
        for (int g = 0; g < GG; ++g) {
            __syncthreads();
            { const float* gp = gam + g * 256 + c8 * 8; const float* bp = bet + g * 256 + c8 * 8;
              const f32x4 ga = *(const f32x4*)gp, gb = *(const f32x4*)(gp + 4), ba = *(const f32x4*)bp, bb = *(const f32x4*)(bp + 4);
#pragma unroll
              for (int q = 0; q < 4; ++q) *(LAS u32x4*)(wl + wt * 272 + wq * 64 + q * 16) = nw[q];
#pragma unroll
              for (int it = 0; it < 8; ++it) { const int s = it * 16 + srow;
                  const u32x4 w = nv[it];
                  const float mean = st[2 * s], rstd = st[2 * s + 1];
                  u32x4 o;
                  o.x = pk2((bflo(w.x) - mean) * rstd * ga.x + ba.x, (bfhi(w.x) - mean) * rstd * ga.y + ba.y);
                  o.y = pk2((bflo(w.y) - mean) * rstd * ga.z + ba.z, (bfhi(w.y) - mean) * rstd * ga.w + ba.w);
                  o.z = pk2((bflo(w.z) - mean) * rstd * gb.x + bb.x, (bfhi(w.z) - mean) * rstd * gb.y + bb.y);
                  o.w = pk2((bflo(w.w) - mean) * rstd * gb.z + bb.z, (bfhi(w.w) - mean) * rstd * gb.w + bb.w);
                  *(LAS u32x4*)(lds + s * 544 + c8 * 16) = o; } }
            __syncthreads();
            if (g + 1 < GG) {
#pragma unroll
                for (int it = 0; it < 8; ++it) nv[it] = *(const u32x4*)(ZZ + (row0 + it * 16 + srow) * 4096 + GW + (g + 1) * 256 + c8 * 8);
#pragma unroll
                for (int q = 0; q < 4; ++q) nw[q] = *(const u32x4*)(Wc + (size_t)(g + 1) * GC * GC + (size_t)wt * GC + wq * 32 + q * 8); }
            u32x2 uu[4][4];
#pragma unroll
            for (int tb = 0; tb < 4; ++tb)
#pragma unroll
                for (int cb = 0; cb < 4; ++cb) uu[tb][cb] = *(const u32x2*)(ZZ + (row0 + 64 * wr + 16 * tb + fr) * 4096 + g * 256 + 64 * wc + 16 * cb + 4 * kg);
            f32x4 acc[4][4];
#pragma unroll
            for (int a = 0; a < 4; ++a)
#pragma unroll
                for (int b2 = 0; b2 < 4; ++b2) acc[a][b2] = (f32x4){0.f, 0.f, 0.f, 0.f};
#pragma unroll
            for (int ks = 0; ks < 4; ++ks) {
                if (32 * ks <= 64 * wr + 63) {
                    bf16x8 X[4], Y[4];
#pragma unroll
                    for (int tb = 0; tb < 4; ++tb) { LAS const unsigned char* wp = wl + (64 * wr + 16 * tb + fr) * 272 + (32 * ks + 4 * kg) * 2;
                        const u32x2 a = *(LAS const u32x2*)wp, b2 = *(LAS const u32x2*)(wp + 32); const u32x4 w = (u32x4){a.x, a.y, b2.x, b2.y}; Y[tb] = __builtin_bit_cast(bf16x8, w); }
#pragma unroll
                    for (int cb = 0; cb < 4; ++cb) { LAS const unsigned char* xa = lds + (32 * ks + 4 * kg + (fr >> 2)) * 544 + (64 * wc + 16 * cb + 4 * (fr & 3)) * 2;
                        const s16x4 lo = vtr(xa), hi4 = vtr(xa + 16 * 544);
                        X[cb] = (bf16x8){lo[0], lo[1], lo[2], lo[3], hi4[0], hi4[1], hi4[2], hi4[3]}; }
#pragma unroll
                    for (int tb = 0; tb < 4; ++tb)
#pragma unroll
                        for (int cb = 0; cb < 4; ++cb) acc[tb][cb] = __builtin_amdgcn_mfma_f32_16x16x32_bf16(X[cb], Y[tb], acc[tb][cb], 0, 0, 0);
                }
            }
#pragma unroll
            for (int tb = 0; tb < 4; ++tb) { const int t = 64 * wr + 16 * tb + fr; const float bsv = bs[g * GC + t];
#pragma unroll
                for (int cb = 0; cb < 4; ++cb) { const int c = g * 256 + 64 * wc + 16 * cb + 4 * kg;
                    const u32x2 u = uu[tb][cb];
                    u32x2 o; o.x = pk2(bflo(u.x) * (acc[tb][cb][0] + bsv), bfhi(u.x) * (acc[tb][cb][1] + bsv)); o.y = pk2(bflo(u.y) * (acc[tb][cb][2] + bsv), bfhi(u.y) * (acc[tb][cb][3] + bsv));
                    *(u32x2*)(GT + (row0 + t) * GW + c) = o; } }
        }
    }
}

#ifndef PROBE
#define PROBE 0
#endif
#ifndef G2_REV
#define G2_REV 1
#endif
__device__ __forceinline__ void gbar(unsigned* ctr, unsigned target) {
    asm volatile("s_waitcnt vmcnt(0)" ::: "memory");
    __syncthreads();
    if (threadIdx.x == 0) {
        __builtin_amdgcn_fence(__ATOMIC_RELEASE, "agent");
        asm volatile("s_waitcnt vmcnt(0)" ::: "memory");
        __hip_atomic_fetch_add(ctr, 1u, __ATOMIC_RELAXED, __HIP_MEMORY_SCOPE_AGENT);
        while (__hip_atomic_load(ctr, __ATOMIC_RELAXED, __HIP_MEMORY_SCOPE_AGENT) < target) __builtin_amdgcn_s_sleep(1);
        __builtin_amdgcn_fence(__ATOMIC_ACQUIRE, "agent");
        asm volatile("s_waitcnt vmcnt(0)" ::: "memory");
    }
    __syncthreads();
}
#define GSYNC() do { bar_target += (unsigned)G; gbar(bar_ctr, bar_target); if (PROBE == 7) { bar_target += (unsigned)G; gbar(bar_ctr, bar_target); } } while (0)
__global__ void __launch_bounds__(512, 2) fwd_kernel(Args args) {
    extern __shared__ __attribute__((aligned(16))) unsigned char lds_raw[];
    cg::grid_group grid = cg::this_grid();
    LAS unsigned char* lds = (LAS unsigned char*)lds_raw;
    const int G = gridDim.x, cu = blockIdx.x, ngw = G * 8;
    unsigned char* ws = args.ws;
    const float* x = args.in[0];
    float* out = args.out;
    bf16* HB = (bf16*)(ws + WS_HB);
    unsigned* bar_ctr = (unsigned*)(ws + WS_CTL); unsigned bar_target = 0u;
    if (cu == 0 && threadIdx.x < 8) __hip_atomic_store((unsigned*)(ws + WS_CTL + 8192) + 64 * threadIdx.x, 0u, __ATOMIC_RELAXED, __HIP_MEMORY_SCOPE_AGENT);
    if (cu == 0 && threadIdx.x == 0) __hip_atomic_store(bar_ctr, 0u, __ATOMIC_RELAXED, __HIP_MEMORY_SCOPE_AGENT);

    for (int rep = 0; rep < (PROBE == 8 ? 2 : 1); ++rep) {
        const int tid = opaque_tid(), lane = tid & 63, wave = __builtin_amdgcn_readfirstlane(tid >> 6), gw = cu * 8 + wave;
        LAS float* scr = (LAS float*)(lds + wave * 16384);
        for (int mat = 0; mat < 16; ++mat) {
            const float* W; bf16* WT; int K, N, perm = 0;
            if (mat < 2)       { W = args.in[1] + (size_t)mat * DM * 3072;        WT = (bf16*)(ws + WS_ATTN_IN) + (size_t)mat * 3072 * DM;        K = DM; N = 3072; }
            else if (mat < 4)  { W = args.in[2] + (size_t)(mat - 2) * DM * DM;    WT = (bf16*)(ws + WS_ATTN_OUT) + (size_t)(mat - 2) * DM * DM;   K = DM; N = DM; }
            else if (mat < 6)  { W = args.in[3] + (size_t)(mat - 4) * DM * 4096;  WT = (bf16*)(ws + WS_GMLP_IN) + (size_t)(mat - 4) * 4096 * DM;  K = DM; N = 4096; }
            else if (mat < 8)  { W = args.in[8] + (size_t)(mat - 6) * GW * DM;    WT = (bf16*)(ws + WS_GMLP_OUT) + (size_t)(mat - 6) * DM * GW;   K = GW; N = DM; }
            else if (mat < 12) { W = args.in[9] + (size_t)(mat - 8) * DM * FF2;   WT = (bf16*)(ws + WS_FFN_UP) + (size_t)(mat - 8) * FF2 * DM;    K = DM; N = FF2; perm = 1; }
            else               { W = args.in[12] + (size_t)(mat - 12) * FF * DM;  WT = (bf16*)(ws + WS_FFN_DOWN) + (size_t)(mat - 12) * DM * FF;  K = FF; N = DM; }
            const int nitems = (K / 64) * (N / 32);
            for (int it = gw; it < nitems; it += ngw) transpose_item(W, K, N, WT, perm, (mat < 2 || mat == 4 || mat == 5 || (mat >= 8 && mat < 12)) ? 1 : 0, scr, it, lane);
        }
        { const float* wsrc = args.in[6]; bf16* wd = (bf16*)(ws + WS_WS);
          for (int i = cu * 512 + tid; i < 2 * GG * GC * GC; i += G * 512) { const int s = i & 127, t = (i >> 7) & 127; const float v = (s <= t) ? wsrc[i] : 0.f; wd[i] = (bf16)(pk2(v, v) & 0xffffu); } }
        for (int m = gw; m < NTOK; m += ngw) {
            const f32x4* xr = (const f32x4*)(x + (size_t)m * DM) + lane; u32x2* o8 = (u32x2*)(HB + (size_t)m * DM) + lane;
#pragma unroll
            for (int j = 0; j < 4; ++j) { const f32x4 v = xr[64 * j]; u32x2 w; w.x = pg8::cvt_pk_f16(v.x, v.y); w.y = pg8::cvt_pk_f16(v.z, v.w); o8[64 * j] = w; }
        }
    }
    grid.sync();

    int dir = 0;
    for (int layer = 0; layer < DEPTH; ++layer) {
        const int j = layer >> 1, mixer = layer & 1;
        for (int step = 0; step < 2; ++step) {
            if (step == 0) {
                pg8::Gemm g; pg8::EpiBf16 E;
                if (mixer == 0) { g = pg8::Gemm{HB, (const bf16*)(ws + WS_ATTN_IN) + (size_t)j * 3072 * DM, NTOK, 3072, DM};
                    E = pg8::EpiBf16{(bf16*)(ws + WS_Q), DM, 0, DM, (size_t)NTOK * DM, 0.125f, nullptr, nullptr}; }
                else { g = pg8::Gemm{HB, (const bf16*)(ws + WS_GMLP_IN) + (size_t)j * 4096 * DM, NTOK, 4096, DM};
                    E = pg8::EpiBf16{(bf16*)(ws + WS_ZZ), 4096, 1, 0, 0, 1.f, (float*)(ws + WS_VST), (LAS float*)(lds + 131072)}; }
                pg8::StaticOrder S; S.rev = dir; dir ^= 1; S.init(g.M, g.N, G, cu);
                for (int rep = 0; rep < (PROBE == 1 ? 2 : 1); ++rep)
                pg8::gemm_phase<pg8::EpiBf16, pg8::StaticOrder, true, true>(lds, g, S, E);
            } else {
                pg8::Gemm g{HB, (const bf16*)(ws + WS_FFN_UP) + (size_t)layer * FF2 * DM, NTOK, FF2, DM};
                pg8::EpiConv E{(bf16*)(ws + WS_G), args.in[10] + (size_t)layer * 3 * FF2, args.in[11] + (size_t)layer * FF2, lds + 131072, FF, FF2, FF, (float*)(ws + WS_HT)};
                pg8::StaticOrder S; S.rev = dir; dir ^= 1; S.init(g.M, g.N, G, cu);
                for (int rep = 0; rep < (PROBE == 4 ? 2 : 1); ++rep)
                pg8::gemm_phase<pg8::EpiConv, pg8::StaticOrder, true, true>(lds, g, S, E);
                GSYNC();
                ffn_fix_phase((const float*)(ws + WS_HT), (bf16*)(ws + WS_G), args.in[10] + (size_t)layer * 3 * FF2, args.in[11] + (size_t)layer * FF2, cu, G, opaque_tid());
            }
            GSYNC();
            if (step == 0) {
                for (int rep = 0; rep < (((PROBE == 2 && mixer == 0) || (PROBE == 3 && mixer == 1)) ? 2 : 1); ++rep)
                if (mixer == 0) attn_phase(lds, (const bf16*)(ws + WS_Q), (const bf16*)(ws + WS_K), (const bf16*)(ws + WS_V), (bf16*)(ws + WS_O), cu, G, dir);
                else spatial_phase(lds, (const bf16*)(ws + WS_ZZ), (bf16*)(ws + WS_GT), (const bf16*)(ws + WS_WS) + (size_t)j * GG * GC * GC, args.in[7] + j * GG * GC, args.in[4] + j * GW, args.in[5] + j * GW, (const float*)(ws + WS_VST), cu, G, dir); dir ^= 1;
                GSYNC();
            }
            const int lnidx = 2 * layer + step;
            {
                pg8::Gemm g;
                if (step == 0 && mixer == 0) g = pg8::Gemm{(const bf16*)(ws + WS_O), (const bf16*)(ws + WS_ATTN_OUT) + (size_t)j * DM * DM, NTOK, DM, DM};
                else if (step == 0) g = pg8::Gemm{(const bf16*)(ws + WS_GT), (const bf16*)(ws + WS_GMLP_OUT) + (size_t)j * DM * GW, NTOK, DM, GW};
                else g = pg8::Gemm{(const bf16*)(ws + WS_G), (const bf16*)(ws + WS_FFN_DOWN) + (size_t)layer * DM * FF, NTOK, DM, FF};
                const int pl = (lnidx - 1) >> 1;
                const float* pgam = lnidx == 0 ? nullptr : (((lnidx - 1) & 1) ? args.in[15] : args.in[13]) + pl * DM;
                const float* pbet = lnidx == 0 ? nullptr : (((lnidx - 1) & 1) ? args.in[16] : args.in[14]) + pl * DM;
                const float* cgam = (step == 0 ? args.in[13] : args.in[15]) + layer * DM;
                const float* cbet = (step == 0 ? args.in[14] : args.in[16]) + layer * DM;
                const bool lastln = lnidx == 2 * DEPTH - 1;
                pg8::EpiResLn E{(const unsigned short*)HB, 0, out, (float*)(ws + WS_ST), cgam, cbet, HB, (unsigned short*)HB,
                                (unsigned*)(ws + WS_CTL + 8192), 128u * (unsigned)lnidx, lastln ? 1 : 0, lds + 131072, dir};
                pg8::StaticOrder S; S.rev = dir; dir ^= 1; S.init(g.M, g.N, G, cu);
                if (PROBE == 9) { pg8::EpiBf16 E0{(bf16*)(ws + WS_R + (step == 1 ? 512 * MiB : 0)), DM, 0, 0, 0, 1.f};
                    pg8::gemm_phase<pg8::EpiBf16, pg8::StaticOrder, true, true>(lds, g, S, E0); }
                pg8::gemm_phase<pg8::EpiResLn, pg8::StaticOrder, true, true>(lds, g, S, E);
            }
            if (lnidx != 2 * DEPTH - 1) GSYNC();
        }
    }
}

extern "C" void kernel_launch(void* const* d_in, const int* in_sizes, int n_in, void* d_out, int out_size, void* d_ws, size_t ws_size, hipStream_t stream) {
    static int grid = 0;
    if (grid == 0) {
        if (n_in != 17 || out_size != NTOK * DM || ws_size < WS_END) { fprintf(stderr, "kernel_launch: unexpected shapes (n_in %d, out %d, ws %zu)\n", n_in, out_size, ws_size); grid = -1; return; }
        int dev = 0, cus = 0, per_cu = 0;
        hipGetDevice(&dev);
        hipDeviceGetAttribute(&cus, hipDeviceAttributeMultiprocessorCount, dev);
        if (hipFuncSetAttribute((const void*)fwd_kernel, hipFuncAttributeMaxDynamicSharedMemorySize, LDS_BYTES) != hipSuccess) { fprintf(stderr, "kernel_launch: hipFuncSetAttribute failed\n"); grid = -1; return; }
        if (hipOccupancyMaxActiveBlocksPerMultiprocessor(&per_cu, (const void*)fwd_kernel, 512, LDS_BYTES) != hipSuccess || per_cu < 1) { fprintf(stderr, "kernel_launch: occupancy query says %d\n", per_cu); per_cu = 1; }
        (void)hipGetLastError();
        grid = cus * per_cu;
        fprintf(stderr, "kernel_launch: grid %d (cus %d x %d)\n", grid, cus, per_cu);
        if (grid != 256) { fprintf(stderr, "kernel_launch: the fused LayerNorm epilogue's group barrier is laid out for a 256-workgroup grid; nothing launched\n"); grid = -1; return; }
    }
    if (grid < 0) return;
    Args a{};
    for (int i = 0; i < 17; ++i) a.in[i] = (const float*)d_in[i];
    a.out = (float*)d_out; a.ws = (unsigned char*)d_ws;
    void* kargs[] = {&a};
    hipError_t e = hipLaunchCooperativeKernel((const void*)fwd_kernel, dim3(grid), dim3(512), kargs, LDS_BYTES, stream);
    if (e != hipSuccess) fprintf(stderr, "cooperative launch failed: %s (grid %d)\n", hipGetErrorString(e), grid);
}
```

```cpp
#include <hip/hip_runtime.h>
#include <hip/hip_cooperative_groups.h>
#include <cstdio>
#include <cstdint>
namespace cg = cooperative_groups;
__device__ __forceinline__ int opaque_tid() { int t = threadIdx.x; asm volatile("" : "+v"(t)); return t; }
namespace pg8 {
#define PG8_LAS __attribute__((address_space(3)))
typedef unsigned short bf16_t;
typedef short bf16x8 __attribute__((ext_vector_type(8)));
typedef float f32x4 __attribute__((ext_vector_type(4)));
typedef unsigned u32x4 __attribute__((ext_vector_type(4)));
constexpr int BM = 256, BK = 64, HALF = 128, HTB = HALF * BK * 2  , STAGE_BYTES = 8 * HTB, NXCD = 8, WGM = 8;

__host__ __device__ __forceinline__ int lds_byte(int r, int c) { const int st = (r >> 4) * 2 + (c >> 5), rr = r & 15, cc = c & 31, ob = rr * 64 + cc * 2; return st * 1024 + (ob ^ (((ob >> 9) & 1) << 5)); }
__host__ __device__ __forceinline__ void stage_rc(int b, int& R, int& C) { const int st = b / 1024, sb = b % 1024, swz = sb ^ (((sb >> 9) & 1) << 5); R = (st >> 1) * 16 + swz / 64; C = (st & 1) * 32 + (swz % 64) / 2; }
__host__ __device__ __forceinline__ int perm32(int rho) { const int n = rho >> 4, i = rho & 15; return 8 * (i >> 2) + 4 * n + (i & 3); }

struct Unit { int pm, pn; };
struct Gemm { const bf16_t* A; const bf16_t* Bt; int M, N, K; };

struct StaticOrder {
    int nM, nN, nwg, G, c, rev = 0;
    __host__ __device__ void init(int M, int N, int G_, int c_) { nM = M / BM; nN = N / BM; nwg = nM * nN; G = G_; c = c_; }
    __host__ __device__ bool next(int i, Unit& u) const {
        if ((long)i * G + c >= nwg) return false;
        const long L = (long)(rev ? (nwg / G - 1 - i) : i) * G + c;
        int wgid = (int)L; { const int q = nwg / NXCD, r = nwg % NXCD, xcd = wgid % NXCD, off = wgid / NXCD; wgid = (xcd < r ? xcd * (q + 1) : r * (q + 1) + (xcd - r) * q) + off; }
        const int nig = WGM * nN, gid = wgid / nig, fm = gid * WGM, gsz = (nM - fm) < WGM ? (nM - fm) : WGM;
        u.pm = fm + ((wgid % nig) % gsz); u.pn = (wgid % nig) / gsz; return true;
    }
    __device__ __forceinline__ void a_ready(const Unit&) const {}
    __device__ __forceinline__ void done(const Unit&) const {}
};
__device__ __forceinline__ unsigned cvt_pk_bf16(float lo, float hi) { unsigned r; asm volatile("v_cvt_pk_bf16_f32 %0, %1, %2" : "=v"(r) : "v"(lo), "v"(hi)); return r; }
typedef float f32x2 __attribute__((ext_vector_type(2)));
typedef _Float16 f16x8 __attribute__((ext_vector_type(8)));
template <bool F16> __device__ __forceinline__ f32x4 mma16(bf16x8 a, bf16x8 b, f32x4 c) {
    if constexpr (F16) return __builtin_amdgcn_mfma_f32_16x16x32_f16(__builtin_bit_cast(f16x8, a), __builtin_bit_cast(f16x8, b), c, 0, 0, 0);
    else return __builtin_amdgcn_mfma_f32_16x16x32_bf16(a, b, c, 0, 0, 0);
}
__device__ __forceinline__ unsigned cvt_pk_f16(float lo, float hi) { typedef _Float16 h2 __attribute__((ext_vector_type(2))); const h2 v = {(_Float16)lo, (_Float16)hi}; return __builtin_bit_cast(unsigned, v); }
typedef unsigned u32x2e __attribute__((ext_vector_type(2)));
__device__ __forceinline__ float gelu_tanh(float x) {
    const float t = x * (-2.302208198f + (-0.1029432397f) * x * x);
    return x * __builtin_amdgcn_rcpf(1.0f + __builtin_amdgcn_exp2f(t));
}
struct EpiBf16 {
    static constexpr bool PERM = true, AFTER_DRAIN = false, F16 = true;
    bf16_t* O; int ldc; int act; int split_cols; size_t split_stride; float scale0;
    float* vst; PG8_LAS float* sl;
    __device__ __forceinline__ void operator()(const f32x4 (&acc)[2][2][4][2], const Unit& u, int wr, int wc, int fr, int fq) const {
        const int row0 = u.pm * BM + wr * 64 + fr; int colt = u.pn * BM; bf16_t* base = O;
        float sc = 1.f; if (split_cols) { const int t = colt / split_cols; base += (size_t)t * split_stride; colt -= t * split_cols; if (t == 0) sc = scale0; }
        const int col0 = colt + wc * 32 + 8 * fq;
        const bool dost = vst != nullptr && u.pn >= 8;
#pragma unroll
        for (int ai = 0; ai < 2; ++ai)
#pragma unroll
            for (int m = 0; m < 4; ++m) { bf16_t* rowp = base + (size_t)(row0 + ai * HALF + m * 16) * ldc + col0; float rs = 0.f, rq = 0.f;
#pragma unroll
                for (int bj = 0; bj < 2; ++bj) { f32x4 v0 = acc[ai][bj][m][0], v1 = acc[ai][bj][m][1];
                    if (act) { v0 = (f32x4){gelu_tanh(v0[0]), gelu_tanh(v0[1]), gelu_tanh(v0[2]), gelu_tanh(v0[3])};
                               v1 = (f32x4){gelu_tanh(v1[0]), gelu_tanh(v1[1]), gelu_tanh(v1[2]), gelu_tanh(v1[3])}; }
                    if (dost) { rs += ((v0[0] + v0[1]) + (v0[2] + v0[3])) + ((v1[0] + v1[1]) + (v1[2] + v1[3]));
                                rq += ((v0[0] * v0[0] + v0[1] * v0[1]) + (v0[2] * v0[2] + v0[3] * v0[3])) + ((v1[0] * v1[0] + v1[1] * v1[1]) + (v1[2] * v1[2] + v1[3] * v1[3])); }
                    v0 = v0 * sc; v1 = v1 * sc; u32x4 w; w.x = cvt_pk_bf16(v0[0], v0[1]); w.y = cvt_pk_bf16(v0[2], v0[3]); w.z = cvt_pk_bf16(v1[0], v1[1]); w.w = cvt_pk_bf16(v1[2], v1[3]);
                    *(u32x4*)(rowp + bj * HALF) = w; }
                if (dost) { rs += __shfl_xor(rs, 16); rs += __shfl_xor(rs, 32); rq += __shfl_xor(rq, 16); rq += __shfl_xor(rq, 32);
                    const int lrow = ai * HALF + wr * 64 + m * 16 + fr; if (fq == 0) { sl[(lrow * 4 + wc) * 2] = rs; sl[(lrow * 4 + wc) * 2 + 1] = rq; } } }
        if (dost) {
            asm volatile("s_waitcnt lgkmcnt(0)" ::: "memory"); __builtin_amdgcn_s_barrier(); asm volatile("" ::: "memory");
            const int t = opaque_tid();
            if (t < 256) { const f32x4 a = *(PG8_LAS const f32x4*)(sl + t * 8), b = *(PG8_LAS const f32x4*)(sl + t * 8 + 4);
                typedef float f32x2v __attribute__((ext_vector_type(2)));
                *(f32x2v*)(vst + ((size_t)u.pm * BM + t) * 16 + (u.pn - 8) * 2) = (f32x2v){(a[0] + a[2]) + (b[0] + b[2]), (a[1] + a[3]) + (b[1] + b[3])}; }
        }
    }
};
struct EpiRes {
    static constexpr bool PERM = false, AFTER_DRAIN = false, F16 = false;
    const float* base; float* out; int ldc; float alpha;
    __device__ __forceinline__ void operator()(const f32x4 (&acc)[2][2][4][2], const Unit& u, int wr, int wc, int fr, int fq) const {
        const int col0 = u.pn * BM + wc * 32 + 4 * fq;
#pragma unroll
        for (int ai = 0; ai < 2; ++ai)
#pragma unroll
            for (int m = 0; m < 4; ++m) { const size_t off = (size_t)(u.pm * BM + ai * HALF + wr * 64 + m * 16 + fr) * ldc + col0;
#pragma unroll
                for (int bj = 0; bj < 2; ++bj)
#pragma unroll
                    for (int n = 0; n < 2; ++n) { const f32x4 bs = *(const f32x4*)(base + off + bj * HALF + n * 16);
                        *(f32x4*)(out + off + bj * HALF + n * 16) = bs * alpha + acc[ai][bj][m][n]; }
                asm volatile("" ::: "memory"); }
    }
};

template <int CTRL> __device__ __forceinline__ float dpp_mov(float old, float src) {
    return __builtin_bit_cast(float, __builtin_amdgcn_update_dpp(__builtin_bit_cast(int, old), __builtin_bit_cast(int, src), CTRL, 0xf, 0xf, false));
}
struct SeqOrder {
    int G, c;
    __device__ bool next(int i, Unit& u) const { if (i >= 22) return false; int it, step;
        if (i < 16) { it = c + G * (i >> 3); step = i & 7; } else { const int v = 6 * c + (i - 16); it = 512 + (v >> 3); step = v & 7; }
        u.pn = it >> 5; u.pm = 8 * (it & 31) + step; return true; }
    __device__ __forceinline__ void a_ready(const Unit&) const {}
    __device__ __forceinline__ void done(const Unit&) const {}
};
struct EpiConv {
    static constexpr bool PERM = true, AFTER_DRAIN = false, F16 = true;
    bf16_t* O; const float* cw; const float* cb; PG8_LAS unsigned char* hl; int ldo, ncol2, nfeat; float* ht;
    __device__ __forceinline__ void operator()(const f32x4 (&acc)[2][2][4][2], const Unit& u, int wr, int wc, int fr, int fq) const {
        const int lcol = wc * 32 + 8 * fq;
        { const int t = opaque_tid();
          if (t < 256) { const int p = t >> 5, ch = t & 31, pp = p & 3; const float* src = (pp < 3 ? cw + pp * ncol2 : cb) + (p >> 2) * nfeat + 128 * u.pn + 4 * ch;
              *(PG8_LAS f32x4*)(hl + 10240 + (p * 128 + 4 * ch) * 4) = *(const f32x4*)src; } }
        float* const htu = ht + (size_t)(u.pm * 22 + u.pn) * 1024;
        if (fr >= 14) {
#pragma unroll
            for (int ai = 0; ai < 2; ++ai) { const int k = 2 * ai + wr;
                if (k < 3) { PG8_LAS unsigned char* hp = hl + k * 2048 + (fr - 14) * 1024 + lcol * 4;
#pragma unroll
                    for (int bj = 0; bj < 2; ++bj)
#pragma unroll
                        for (int n = 0; n < 2; ++n) *(PG8_LAS f32x4*)(hp + bj * 512 + n * 16) = acc[ai][bj][3][n]; }
                else {
#pragma unroll
                    for (int bj = 0; bj < 2; ++bj)
#pragma unroll
                        for (int n = 0; n < 2; ++n) *(f32x4*)(htu + (2 + fr - 14) * 256 + bj * 128 + lcol + 4 * n) = acc[ai][bj][3][n]; } }
        }
        if (wr == 0 && fr < 2) {
#pragma unroll
            for (int bj = 0; bj < 2; ++bj)
#pragma unroll
                for (int n = 0; n < 2; ++n) *(f32x4*)(htu + fr * 256 + bj * 128 + lcol + 4 * n) = acc[0][bj][0][n];
        }
        asm volatile("s_waitcnt lgkmcnt(0)" ::: "memory"); __builtin_amdgcn_s_barrier(); asm volatile("" ::: "memory");
        u32x2e keep[2][4];
#pragma unroll
        for (int n = 0; n < 2; ++n) {
            const int f = 128 * u.pn + lcol + 4 * n;
            PG8_LAS const float* const wl = (PG8_LAS const float*)(hl + 10240) + lcol + 4 * n;
            const f32x4 wg0 = *(PG8_LAS const f32x4*)(wl), wg1 = *(PG8_LAS const f32x4*)(wl + 128), wg2 = *(PG8_LAS const f32x4*)(wl + 256), bg = *(PG8_LAS const f32x4*)(wl + 384);
            const f32x4 wv0 = *(PG8_LAS const f32x4*)(wl + 512), wv1 = *(PG8_LAS const f32x4*)(wl + 640), wv2 = *(PG8_LAS const f32x4*)(wl + 768), bv = *(PG8_LAS const f32x4*)(wl + 896);
#pragma unroll
            for (int ai = 0; ai < 2; ++ai) {
                const int k = 2 * ai + wr;
                const int rslot = k > 0 ? k - 1 : 0;
                PG8_LAS const unsigned char* hp = hl + rslot * 2048 + (lcol + 4 * n) * 4;
                f32x4 hg2 = *(PG8_LAS const f32x4*)hp, hv2 = *(PG8_LAS const f32x4*)(hp + 512), hg1 = *(PG8_LAS const f32x4*)(hp + 1024), hv1 = *(PG8_LAS const f32x4*)(hp + 1536);
                if (k == 0) { hg2 = (f32x4){0.f, 0.f, 0.f, 0.f}; hv2 = hg2; hg1 = hg2; hv1 = hg2; }
#pragma unroll
                for (int m = 0; m < 4; ++m) {
                    float r[4];
#pragma unroll
                    for (int e = 0; e < 4; ++e) {
                        const float xg = acc[ai][0][m][n][e], xv = acc[ai][1][m][n][e];
                        float o1g, o2g, o1v, o2v;
                        if (m == 0) { o1g = hg1[e]; o2g = fr == 0 ? hg2[e] : hg1[e]; o1v = hv1[e]; o2v = fr == 0 ? hv2[e] : hv1[e]; }
                        else { const float pgv = acc[ai][0][m > 0 ? m - 1 : 0][n][e], pvv = acc[ai][1][m > 0 ? m - 1 : 0][n][e];
                            o1g = dpp_mov<0x121>(pgv, pgv); o2g = dpp_mov<0x122>(pgv, pgv); o1v = dpp_mov<0x121>(pvv, pvv); o2v = dpp_mov<0x122>(pvv, pvv); }
                        const float p1g = dpp_mov<0x111>(o1g, xg), p2g = dpp_mov<0x112>(o2g, xg), p1v = dpp_mov<0x111>(o1v, xv), p2v = dpp_mov<0x112>(o2v, xv);
                        const float yg = bg[e] + wg2[e] * xg + wg1[e] * p1g + wg0[e] * p2g;
                        const float yv = bv[e] + wv2[e] * xv + wv1[e] * p1v + wv0[e] * p2v;
                        r[e] = yg * __builtin_amdgcn_rcpf(1.0f + __builtin_amdgcn_exp2f(-1.4426950408889634f * yg)) * yv;
                    }
                    u32x2e w; w.x = cvt_pk_bf16(r[0], r[1]); w.y = cvt_pk_bf16(r[2], r[3]);
                    if (n == 0) keep[ai][m] = w;
                    else { const u32x4 w4 = (u32x4){keep[ai][m].x, keep[ai][m].y, w.x, w.y}; *(u32x4*)(O + (size_t)(u.pm * BM + ai * HALF + wr * 64 + m * 16 + fr) * ldo + f - 4) = w4; }
                }
            }
        }
    }
};

struct EpiResLn {
    static constexpr bool PERM = true, AFTER_DRAIN = false, F16 = false;
    const unsigned short* base16; int isbf; float* out; float* st; const float* cg; const float* cbeta; bf16_t* hb; unsigned short* hf; unsigned* gcnt; unsigned tgt0; int last; PG8_LAS unsigned char* xl; int rev;
    static constexpr int ldc = 1024; static constexpr float alpha = 1.681792830507429f, eps = 1e-5f;
    typedef _Float16 h16x2 __attribute__((ext_vector_type(2)));
    __device__ __forceinline__ f32x4 dec(u32x2e w) const {
        if (isbf) return (f32x4){__uint_as_float(w.x << 16), __uint_as_float(w.x & 0xffff0000u), __uint_as_float(w.y << 16), __uint_as_float(w.y & 0xffff0000u)};
        const float f0 = (float)__builtin_bit_cast(_Float16, (unsigned short)(w.x & 0xffffu)), f1 = (float)__builtin_bit_cast(_Float16, (unsigned short)(w.x >> 16));
        const float f2 = (float)__builtin_bit_cast(_Float16, (unsigned short)(w.y & 0xffffu)), f3 = (float)__builtin_bit_cast(_Float16, (unsigned short)(w.y >> 16));
        return (f32x4){f0, f1, f2, f3}; }
    __device__ __forceinline__ void operator()(f32x4 (&acc)[2][2][4][2], const Unit& u, int wr, int wc, int fr, int fq) const {
        asm volatile("" : "+v"(fr), "+v"(fq));
        typedef float f32x2s __attribute__((ext_vector_type(2)));
        PG8_LAS float* const sl = (PG8_LAS float*)xl; PG8_LAS float* const gl = (PG8_LAS float*)(xl + 8192);
        const int col0 = u.pn * BM + wc * 32 + 8 * fq, lc0 = wc * 32 + 8 * fq;
        { const int t = opaque_tid();
          if (t < 128) { const int which = t >> 6, c4 = 4 * (t & 63); *(PG8_LAS f32x4*)(gl + which * 256 + c4) = *(const f32x4*)((which ? cbeta : cg) + u.pn * BM + c4); } }
        u32x4 nb[2];
        { const size_t off = ((size_t)u.pm * BM + wr * 64 + fr) * ldc + col0;
#pragma unroll
          for (int bj = 0; bj < 2; ++bj) nb[bj] = *(const u32x4*)(base16 + off + bj * HALF); }
#pragma unroll
        for (int i = 0; i < 8; ++i) { const int ai = i >> 2, m = i & 3; const int lrow = ai * HALF + wr * 64 + m * 16 + fr;
            u32x4 cur[2];
#pragma unroll
            for (int bj = 0; bj < 2; ++bj) cur[bj] = nb[bj];
            if (i < 7) { const int lr2 = ((i + 1) >> 2) * HALF + wr * 64 + ((i + 1) & 3) * 16 + fr; const size_t off2 = ((size_t)u.pm * BM + lr2) * ldc + col0;
#pragma unroll
                for (int bj = 0; bj < 2; ++bj) nb[bj] = *(const u32x4*)(base16 + off2 + bj * HALF); }
            asm volatile("" ::: "memory");
            float rsum = 0.f, rq = 0.f;
#pragma unroll
            for (int q = 0; q < 4; ++q) { const int bj = q >> 1, n = q & 1;
                const f32x4 y = dec(n ? (u32x2e){cur[bj].z, cur[bj].w} : (u32x2e){cur[bj].x, cur[bj].y}) * alpha + acc[ai][bj][m][n];
                acc[ai][bj][m][n] = y;
                rsum += (y[0] + y[1]) + (y[2] + y[3]); rq += (y[0] * y[0] + y[1] * y[1]) + (y[2] * y[2] + y[3] * y[3]); }
            rsum += __shfl_xor(rsum, 16); rsum += __shfl_xor(rsum, 32); rq += __shfl_xor(rq, 16); rq += __shfl_xor(rq, 32);
            if (fq == 0) { sl[(lrow * 4 + wc) * 2] = rsum; sl[(lrow * 4 + wc) * 2 + 1] = rq; }
            asm volatile("" ::: "memory"); }
        asm volatile("s_waitcnt lgkmcnt(0)" ::: "memory"); __builtin_amdgcn_s_barrier(); asm volatile("" ::: "memory");
        const int t = opaque_tid();
        if (t < 256) { const f32x4 a = *(PG8_LAS const f32x4*)(sl + t * 8), b = *(PG8_LAS const f32x4*)(sl + t * 8 + 4);
            const float ssum = (a[0] + a[2]) + (b[0] + b[2]), ssq = (a[1] + a[3]) + (b[1] + b[3]);
            __hip_atomic_store((unsigned long long*)(st + ((size_t)u.pm * BM + t) * 8 + u.pn * 2), ((unsigned long long)__float_as_uint(ssq) << 32) | __float_as_uint(ssum), __ATOMIC_RELAXED, __HIP_MEMORY_SCOPE_AGENT); }
        asm volatile("s_waitcnt vmcnt(0) lgkmcnt(0)" ::: "memory"); __builtin_amdgcn_s_barrier(); asm volatile("" ::: "memory");
        if (t == 0) {
            unsigned* const ctr = gcnt + 64 * (blockIdx.x & 7); const unsigned target = tgt0 + 32u * (unsigned)((rev ? 3 - ((u.pm >> 3) & 3) : ((u.pm >> 3) & 3)) + 1);
            __hip_atomic_fetch_add(ctr, 1u, __ATOMIC_RELAXED, __HIP_MEMORY_SCOPE_AGENT);
            while (__hip_atomic_load(ctr, __ATOMIC_RELAXED, __HIP_MEMORY_SCOPE_AGENT) < target) __builtin_amdgcn_s_sleep(1);
        }
        __builtin_amdgcn_s_barrier(); asm volatile("" ::: "memory");
        if (t < 256) { const size_t row = (size_t)u.pm * BM + t;
            float s = 0.f, q = 0.f;
#pragma unroll
            for (int k4 = 0; k4 < 4; ++k4) { const unsigned long long w = __hip_atomic_load((const unsigned long long*)(st + row * 8 + 2 * k4), __ATOMIC_RELAXED, __HIP_MEMORY_SCOPE_AGENT);
                s += __uint_as_float((unsigned)w); q += __uint_as_float((unsigned)(w >> 32)); }
            const float mean = s * (1.f / 1024.f), rstd = 1.f / sqrtf(q * (1.f / 1024.f) - mean * mean + eps);
            *(PG8_LAS f32x2s*)(sl + 2 * t) = (f32x2s){mean, rstd}; }
        asm volatile("s_waitcnt lgkmcnt(0)" ::: "memory"); __builtin_amdgcn_s_barrier(); asm volatile("" ::: "memory");
#pragma unroll
        for (int i = 0; i < 8; ++i) { const int ai = i >> 2, m = i & 3; const int lrow = ai * HALF + wr * 64 + m * 16 + fr; const size_t off = ((size_t)u.pm * BM + lrow) * ldc + col0;
            const f32x2s mr = *(PG8_LAS const f32x2s*)(sl + 2 * lrow); u32x4 pw;
#pragma unroll
            for (int q = 0; q < 4; ++q) { const int bj = q >> 1, n = q & 1;
                const f32x4 g4 = *(PG8_LAS const f32x4*)(gl + lc0 + bj * HALF + n * 4), b4 = *(PG8_LAS const f32x4*)(gl + 256 + lc0 + bj * HALF + n * 4);
                const f32x4 o = (acc[ai][bj][m][n] - mr.x) * mr.y * g4 + b4;
                if (last) *(f32x4*)(out + off + bj * HALF + n * 4) = o;
                else { if (n == 0) { pw.x = cvt_pk_f16(o[0], o[1]); pw.y = cvt_pk_f16(o[2], o[3]); } else { pw.z = cvt_pk_f16(o[0], o[1]); pw.w = cvt_pk_f16(o[2], o[3]); *(u32x4*)(hf + off + bj * HALF) = pw; } } }
            asm volatile("" ::: "memory"); }
    }
};

template <class Epi, class Sched, bool ALIGN_EPI = false, bool SP2 = false>
__device__ __forceinline__ void gemm_phase(PG8_LAS unsigned char* lds, const Gemm g, const Sched& S, const Epi& E) {
    const int tid = opaque_tid(), wid = __builtin_amdgcn_readfirstlane(tid >> 6), lane = tid & 63, wr = wid >> 2, wc = wid & 3, fr = lane & 15, fq = lane >> 4;
    const int K = g.K, nt = K / BK;
    unsigned voffA[2], voffB[2];
#pragma unroll
    for (int i = 0; i < 2; ++i) { int R, C; stage_rc(tid * 16 + i * 8192, R, C); const int Rb = Epi::PERM ? ((R & ~31) + perm32(R & 31)) : R;
        voffA[i] = (unsigned)(R * K + C) * 2u; voffB[i] = (unsigned)(Rb * K + C) * 2u; }
    const size_t kstep = (size_t)(BK * 2);
    const size_t hstep = (size_t)HALF * K * 2;
    const size_t tstep = 2 * hstep;
    const unsigned ldsw = (unsigned)wid * 1024u;
    const int aoff = lds_byte(wr * 64 + fr, fq * 8), boff = lds_byte(wc * 32 + fr, fq * 8);
#define PG8_SA(b, h) (((b) * 2 + (h)) * HTB)
#define PG8_SB(b, h) ((4 + (b) * 2 + (h)) * HTB)
#define PG8_STAGE(bufoff, gbase, voff) do { _Pragma("unroll") for (int _i = 0; _i < 2; ++_i) \
        __builtin_amdgcn_global_load_lds((const unsigned*)((const char*)(gbase) + (voff)[_i]), (PG8_LAS unsigned*)(lds + (bufoff) + ldsw + _i * 8192), 16, 0, 0); } while (0)
#define PG8_LDA(dst, b, h) do { _Pragma("unroll") for (int m = 0; m < 4; ++m) _Pragma("unroll") for (int k = 0; k < 2; ++k) dst[m][k] = *(const PG8_LAS bf16x8*)(lds + PG8_SA(b, h) + aoff + m * 2048 + k * 1024); } while (0)
#define PG8_LDB(dst, b, h) do { _Pragma("unroll") for (int n = 0; n < 2; ++n) _Pragma("unroll") for (int k = 0; k < 2; ++k) dst[n][k] = *(const PG8_LAS bf16x8*)(lds + PG8_SB(b, h) + boff + n * 2048 + k * 1024); } while (0)
#define PG8_MMA(ai, bj, At, Bt) do { __builtin_amdgcn_s_setprio(1); _Pragma("unroll") for (int m = 0; m < 4; ++m) _Pragma("unroll") for (int n = 0; n < 2; ++n) _Pragma("unroll") for (int k = 0; k < 2; ++k) \
        acc[ai][bj][m][n] = mma16<Epi::F16>(Bt[n][k], At[m][k], acc[ai][bj][m][n]); __builtin_amdgcn_s_setprio(0); } while (0)
#define PG8_WAIT_V(n) asm volatile("s_waitcnt vmcnt(" #n ")" ::: "memory")
#define PG8_WAIT_L(n) asm volatile("s_waitcnt lgkmcnt(" #n ")" ::: "memory")
#define PG8_BAR __builtin_amdgcn_s_barrier()
#define PG8_SCHED __builtin_amdgcn_sched_barrier(0)
    Unit cur, nxt; int ui = 0;
    if (!S.next(0, cur)) return;
    f32x4 acc[2][2][4][2];
#pragma unroll
    for (int a = 0; a < 2; ++a)
#pragma unroll
        for (int b = 0; b < 2; ++b)
#pragma unroll
            for (int m = 0; m < 4; ++m)
#pragma unroll
                for (int n = 0; n < 2; ++n) acc[a][b][m][n] = (f32x4){0.f, 0.f, 0.f, 0.f};
    bf16x8 At[4][2], B0[2][2], B1[2][2];
    const char* cA = (const char*)g.A + (size_t)cur.pm * tstep; const char* cB = (const char*)g.Bt + (size_t)cur.pn * tstep;
    S.a_ready(cur);
    if constexpr (SP2) {
        PG8_STAGE(PG8_SB(0, 0), cB, voffB); PG8_STAGE(PG8_SB(0, 1), cB + hstep, voffB); PG8_STAGE(PG8_SA(0, 0), cA, voffA); PG8_STAGE(PG8_SA(0, 1), cA + hstep, voffA);
        if (wr == 1) PG8_BAR;
        PG8_WAIT_V(2); PG8_BAR;
        PG8_STAGE(PG8_SB(1, 0), cB + kstep, voffB); PG8_STAGE(PG8_SA(1, 0), cA + kstep, voffA); PG8_STAGE(PG8_SB(1, 1), cB + hstep + kstep, voffB);
        PG8_WAIT_V(6); PG8_BAR;
    } else {
        PG8_STAGE(PG8_SB(0, 0), cB, voffB); PG8_STAGE(PG8_SA(0, 0), cA, voffA); PG8_STAGE(PG8_SB(0, 1), cB + hstep, voffB); PG8_STAGE(PG8_SA(0, 1), cA + hstep, voffA);
        if (wr == 1) PG8_BAR;
        PG8_WAIT_V(4); PG8_BAR;
        PG8_STAGE(PG8_SB(1, 0), cB + kstep, voffB); PG8_STAGE(PG8_SA(1, 0), cA + kstep, voffA); PG8_STAGE(PG8_SB(1, 1), cB + hstep + kstep, voffB);
        PG8_WAIT_V(6); PG8_BAR;
    }
    for (;;) {
        const bool has_next = S.next(ui + 1, nxt);
        const char* nA = has_next ? (const char*)g.A + (size_t)nxt.pm * tstep : cA; const char* nB = has_next ? (const char*)g.Bt + (size_t)nxt.pn * tstep : cB;
        for (int t = 0; t < nt; t += 2) {
            const bool last = (t == nt - 2);
            const char* a1 = cA + (size_t)(t + 1) * kstep;
            const char* a2 = last ? nA : cA + (size_t)(t + 2) * kstep; const char* b2 = last ? nB : cB + (size_t)(t + 2) * kstep;
            const char* a3 = a2 + kstep; const char* b3 = b2 + kstep;
            if (last && has_next) S.a_ready(nxt);
            if constexpr (SP2) {
            PG8_LDB(B0, 0, 0); PG8_LDB(B1, 0, 1); PG8_SCHED; PG8_LDA(At, 0, 0); PG8_STAGE(PG8_SA(1, 1), a1 + hstep, voffA);
            PG8_WAIT_V(8); PG8_WAIT_L(0); PG8_BAR; PG8_MMA(0, 0, At, B0); PG8_MMA(0, 1, At, B1); PG8_BAR; PG8_SCHED;
            PG8_LDA(At, 0, 1); PG8_STAGE(PG8_SB(0, 0), b2, voffB); PG8_STAGE(PG8_SB(0, 1), b2 + hstep, voffB); PG8_STAGE(PG8_SA(0, 0), a2, voffA);
            PG8_WAIT_V(8); PG8_WAIT_L(0); PG8_BAR; PG8_MMA(1, 0, At, B0); PG8_MMA(1, 1, At, B1); PG8_BAR; PG8_SCHED;
            PG8_LDB(B0, 1, 0); PG8_LDB(B1, 1, 1); PG8_SCHED; PG8_LDA(At, 1, 0); PG8_STAGE(PG8_SA(0, 1), a2 + hstep, voffA);
            PG8_WAIT_V(8); PG8_WAIT_L(0); PG8_BAR; PG8_MMA(0, 0, At, B0); PG8_MMA(0, 1, At, B1); PG8_BAR; PG8_SCHED;
            PG8_LDA(At, 1, 1); PG8_STAGE(PG8_SB(1, 0), b3, voffB); PG8_STAGE(PG8_SB(1, 1), b3 + hstep, voffB); PG8_STAGE(PG8_SA(1, 0), a3, voffA);
            PG8_WAIT_V(8); PG8_WAIT_L(0); PG8_BAR; PG8_MMA(1, 0, At, B0); PG8_MMA(1, 1, At, B1); PG8_BAR; PG8_SCHED;
            } else {
            PG8_LDB(B0, 0, 0); PG8_SCHED; PG8_LDA(At, 0, 0); PG8_STAGE(PG8_SA(1, 1), a1 + hstep, voffA);
            PG8_WAIT_L(8); PG8_BAR; PG8_WAIT_L(0); PG8_MMA(0, 0, At, B0); PG8_BAR; PG8_SCHED;
            PG8_LDB(B1, 0, 1); PG8_STAGE(PG8_SB(0, 0), b2, voffB);
            PG8_BAR; PG8_WAIT_L(0); PG8_MMA(0, 1, At, B1); PG8_BAR;
            PG8_LDA(At, 0, 1); PG8_STAGE(PG8_SA(0, 0), a2, voffA);
            PG8_BAR; PG8_WAIT_L(0); PG8_MMA(1, 0, At, B0); PG8_BAR; PG8_SCHED;
            PG8_STAGE(PG8_SB(0, 1), b2 + hstep, voffB);
            PG8_WAIT_V(6); PG8_BAR; PG8_MMA(1, 1, At, B1); PG8_BAR;
            PG8_LDB(B0, 1, 0); PG8_SCHED; PG8_LDA(At, 1, 0); PG8_STAGE(PG8_SA(0, 1), a2 + hstep, voffA);
            PG8_WAIT_L(8); PG8_BAR; PG8_WAIT_L(0); PG8_MMA(0, 0, At, B0); PG8_BAR; PG8_SCHED;
            PG8_LDB(B1, 1, 1); PG8_STAGE(PG8_SB(1, 0), b3, voffB);
            PG8_BAR; PG8_WAIT_L(0); PG8_MMA(0, 1, At, B1); PG8_BAR;
            PG8_LDA(At, 1, 1); PG8_STAGE(PG8_SA(1, 0), a3, voffA);
            PG8_BAR; PG8_WAIT_L(0); PG8_MMA(1, 0, At, B0); PG8_BAR; PG8_SCHED;
            PG8_STAGE(PG8_SB(1, 1), b3 + hstep, voffB);
            PG8_WAIT_V(6); PG8_BAR; PG8_MMA(1, 1, At, B1); PG8_BAR;
            }
        }
        if constexpr (ALIGN_EPI) { if (wr == 0) PG8_BAR; }
        if constexpr (!Epi::AFTER_DRAIN) { E(acc, cur, wr, wc, fr, fq); S.done(cur); }
        if (!has_next) break;
#pragma unroll
        for (int a = 0; a < 2; ++a)
#pragma unroll
            for (int b = 0; b < 2; ++b)
#pragma unroll
                for (int m = 0; m < 4; ++m)
#pragma unroll
                    for (int n = 0; n < 2; ++n) acc[a][b][m][n] = (f32x4){0.f, 0.f, 0.f, 0.f};
        cur = nxt; cA = nA; cB = nB; ++ui;
        if constexpr (ALIGN_EPI) { if (wr == 1) PG8_BAR; }
    }
    PG8_WAIT_V(0);
    if constexpr (!ALIGN_EPI) { if (wr == 0) PG8_BAR; }
    PG8_BAR;
    if constexpr (Epi::AFTER_DRAIN) { E.fused(acc, cur, wr, wc, fr, fq, lds, wid, lane); S.done(cur); }
#undef PG8_SA
#undef PG8_SB
#undef PG8_STAGE
#undef PG8_LDA
#undef PG8_LDB
#undef PG8_MMA
#undef PG8_WAIT_V
#undef PG8_WAIT_L
#undef PG8_BAR
#undef PG8_SCHED
}
}

constexpr int NB = 32, SEQ = 2048, DM = 1024, NTOK = NB * SEQ;
constexpr int NH = 16, HD = 64, GW = 2048, GG = 8, GC = 128, FF = 2816, FF2 = 5632, DEPTH = 4;
constexpr float LN_EPS = 1e-5f;
constexpr float DN_ALPHA = 1.681792830507429f;
constexpr int HALF_TOK = NTOK / 2;

constexpr size_t MiB = 1u << 20;
constexpr size_t WS_ATTN_IN = 0, WS_ATTN_OUT = 12 * MiB, WS_GMLP_IN = 16 * MiB, WS_GMLP_OUT = 32 * MiB, WS_FFN_UP = 40 * MiB, WS_FFN_DOWN = 84 * MiB, WS_WS = 106 * MiB;
constexpr size_t WS_MS = 110 * MiB;
constexpr size_t WS_CTL = 107 * MiB;
constexpr size_t WS_ST = 108 * MiB;
constexpr size_t WS_HB = 112 * MiB;
constexpr size_t WS_R = 240 * MiB;
constexpr size_t WS_Q = WS_R, WS_K = WS_R + 128 * MiB, WS_V = WS_R + 256 * MiB, WS_O = WS_R + 384 * MiB;
constexpr size_t WS_ZZ = WS_R, WS_GT = WS_R + 512 * MiB;
constexpr size_t WS_HT = WS_R + 400 * MiB;
constexpr size_t WS_G = WS_R;
constexpr size_t WS_VST = 1008 * MiB;
constexpr size_t WS_END = 1012 * MiB;

constexpr int LDS_BYTES = 147456;

#define LAS __attribute__((address_space(3)))
typedef unsigned short bf16;
typedef unsigned u32x4 __attribute__((ext_vector_type(4)));
typedef unsigned u32x2 __attribute__((ext_vector_type(2)));
typedef float f32x4 __attribute__((ext_vector_type(4)));
typedef float f32x16 __attribute__((ext_vector_type(16)));
typedef short bf16x8 __attribute__((ext_vector_type(8)));
typedef short s16x4 __attribute__((ext_vector_type(4)));

__device__ __forceinline__ unsigned pk2(float lo, float hi) { return pg8::cvt_pk_bf16(lo, hi); }
__device__ __forceinline__ float bflo(unsigned w) { return __uint_as_float(w << 16); }
__device__ __forceinline__ float bfhi(unsigned w) { return __uint_as_float(w & 0xffff0000u); }
__device__ __forceinline__ float wave_sum(float v) {
#pragma unroll
    for (int o = 1; o < 64; o <<= 1) v += __shfl_xor(v, o);
    return v;
}
__device__ __forceinline__ s16x4 vtr(LAS const unsigned char* p) { return __builtin_bit_cast(s16x4, __builtin_amdgcn_ds_read_tr16_b64_v4i16((LAS s16x4*)p)); }

__device__ __forceinline__ void transpose_item(const float* W, int K, int N, bf16* WT, int perm, int f16, LAS float* scr, int item, int lane) {
    const int nblk = N / 32, kb = item / nblk, nb = item % nblk, k0 = 64 * kb, n0 = 32 * nb;
    int r0 = n0;
    if (perm) { const int bj = n0 / FF, f0 = n0 - bj * FF; r0 = (f0 >> 7) * 256 + bj * 128 + (f0 & 127); }
#pragma unroll 8
    for (int i = 0; i < 32; ++i) { const int kk = 2 * i + (lane >> 5); scr[kk * 33 + (lane & 31)] = W[(size_t)(k0 + kk) * N + n0 + (lane & 31)]; }
    asm volatile("s_waitcnt lgkmcnt(0)" ::: "memory");
    const int c = lane & 7;
#pragma unroll
    for (int j = 0; j < 4; ++j) { const int n = (lane >> 3) + 8 * j; const LAS float* s = scr + (8 * c) * 33 + n;
        u32x4 o; if (f16) { o.x = pg8::cvt_pk_f16(s[0 * 33], s[1 * 33]); o.y = pg8::cvt_pk_f16(s[2 * 33], s[3 * 33]); o.z = pg8::cvt_pk_f16(s[4 * 33], s[5 * 33]); o.w = pg8::cvt_pk_f16(s[6 * 33], s[7 * 33]); }
        else { o.x = pk2(s[0 * 33], s[1 * 33]); o.y = pk2(s[2 * 33], s[3 * 33]); o.z = pk2(s[4 * 33], s[5 * 33]); o.w = pk2(s[6 * 33], s[7 * 33]); }
        *(u32x4*)(WT + (size_t)(r0 + n) * K + k0 + 8 * c) = o; }
    asm volatile("s_waitcnt lgkmcnt(0)" ::: "memory");
}

struct Args { const float* in[17]; float* out; unsigned char* ws; };

__device__ __forceinline__ void ln_apply(const float* Y, float* Yo, bf16* HB, const float* st, float* ms, const float* gam, const float* bet, int gw, int ngw, int lane) {
    f32x4 g4[4], b4[4];
#pragma unroll
    for (int j = 0; j < 4; ++j) { g4[j] = ((const f32x4*)gam)[lane + 64 * j]; b4[j] = ((const f32x4*)bet)[lane + 64 * j]; }
    for (int m = gw; m < NTOK; m += ngw) {
        const f32x4* yr = (const f32x4*)(Y + (size_t)m * DM) + lane;
        f32x4 v[4];
#pragma unroll
        for (int j = 0; j < 4; ++j) v[j] = yr[64 * j];
        const f32x4 a = *(const f32x4*)(st + (size_t)m * 8), b = *(const f32x4*)(st + (size_t)m * 8 + 4);
        const float s = (a[0] + a[2]) + (b[0] + b[2]), q = (a[1] + a[3]) + (b[1] + b[3]);
        const float mean = s * (1.f / DM), rstd = 1.f / sqrtf(q * (1.f / DM) - mean * mean + LN_EPS);
        if (lane == 0) { ms[(size_t)m * 2] = mean; ms[(size_t)m * 2 + 1] = rstd; }
        u32x2* o8 = (u32x2*)(HB + (size_t)m * DM) + lane;
#pragma unroll
        for (int j = 0; j < 4; ++j) { const f32x4 o = (v[j] - mean) * rstd * g4[j] + b4[j]; if (Yo) ((f32x4*)(Yo + (size_t)m * DM) + lane)[64 * j] = o; u32x2 w; w.x = pk2(o.x, o.y); w.y = pk2(o.z, o.w); o8[64 * j] = w; }
    }
}

__device__ __forceinline__ void ffn_fix_phase(const float* HT, bf16* Gb, const float* cw, const float* cb, int cu, int G, int tid) {
    const int sub = tid >> 6, r = (tid >> 5) & 1, f = (tid & 31) * 4;
    for (int up = cu * 8 + sub; up < 224 * 22; up += G * 8) {
        const int pn = up % 22, pq = up / 22, pm = pq + pq / 7 + 1;
        const float* hc = HT + (size_t)(pm * 22 + pn) * 1024; const float* hp = HT + (size_t)((pm - 1) * 22 + pn) * 1024;
        f32x4 y[2];
#pragma unroll
        for (int hh = 0; hh < 2; ++hh) { const int c = hh * 128 + f; const int F = hh * FF + 128 * pn + f;
            const f32x4 h0 = *(const f32x4*)(hc + c), h1 = *(const f32x4*)(hc + 256 + c), t0 = *(const f32x4*)(hp + 512 + c), t1 = *(const f32x4*)(hp + 768 + c);
            const f32x4 x0 = r ? h1 : h0, xm1 = r ? h0 : t1, xm2 = r ? t1 : t0;
            y[hh] = *(const f32x4*)(cb + F) + *(const f32x4*)(cw + F) * xm2 + *(const f32x4*)(cw + FF2 + F) * xm1 + *(const f32x4*)(cw + 2 * FF2 + F) * x0; }
        float v[4];
#pragma unroll
        for (int e = 0; e < 4; ++e) v[e] = y[0][e] * __builtin_amdgcn_rcpf(1.0f + __builtin_amdgcn_exp2f(-1.4426950408889634f * y[0][e])) * y[1][e];
        u32x2 w; w.x = pk2(v[0], v[1]); w.y = pk2(v[2], v[3]);
        *(u32x2*)(Gb + (size_t)(pm * 256 + r) * FF + 128 * pn + f) = w;
    }
}

__device__ __forceinline__ void attn_phase(LAS unsigned char* lds, const bf16* Q, const bf16* K, const bf16* V, bf16* O, int cu, int G, int rev) {
    const int tid = opaque_tid(), lane = tid & 63, wid = __builtin_amdgcn_readfirstlane(tid >> 6), q32 = lane & 31, hi = lane >> 5, li = lane & 15;
    LAS unsigned char* Ks = lds + wid * 10752;
    LAS unsigned char* Vs = Ks + 4608;
    const int lkey = lane >> 3, lch = lane & 7;
    const float LOG2E = 1.4426950408889634f;
    for (int k = 0; k < 16; ++k) {
        const int idx = cu * 8 + wid + 2048 * (k & 3), b = 4 * (idx & 7) + (rev ? 3 - (k >> 2) : (k >> 2)), h = (idx >> 3) & 15, qb = idx >> 7;
        const size_t rowbase = (size_t)b * SEQ;
        const int q0w = qb * 32;
        bf16x8 qf[4];
        { const bf16* qp = Q + (rowbase + q0w + q32) * DM + h * HD + hi * 8;
#pragma unroll
          for (int ks = 0; ks < 4; ++ks) qf[ks] = *(const bf16x8*)(qp + ks * 16); }
        f32x16 o0, o1;
#pragma unroll
        for (int r = 0; r < 16; ++r) { o0[r] = 0.f; o1[r] = 0.f; }
        float R = 0.f;
        const bf16* kp = K + (rowbase + lkey) * DM + h * HD + lch * 8;
        const bf16* vp = V + (rowbase + lkey) * DM + h * HD + lch * 8;
        u32x4 kr[4], vr[4];
#pragma unroll
        for (int jj = 0; jj < 4; ++jj) { kr[jj] = *(const u32x4*)(kp + (size_t)(q0w + 8 * jj) * DM); vr[jj] = *(const u32x4*)(vp + (size_t)(q0w + 8 * jj) * DM); }
        for (int key0 = q0w; key0 >= 0; key0 -= 32) {
#pragma unroll
            for (int jj = 0; jj < 4; ++jj) { *(LAS u32x4*)(Ks + (lkey + 8 * jj) * 144 + lch * 16) = kr[jj]; *(LAS u32x4*)(Vs + (lkey + 8 * jj) * 192 + lch * 16) = vr[jj]; }
            asm volatile("s_waitcnt lgkmcnt(0)" ::: "memory");
            if (key0 >= 32) {
#pragma unroll
                for (int jj = 0; jj < 4; ++jj) { kr[jj] = *(const u32x4*)(kp + (size_t)(key0 - 32 + 8 * jj) * DM); vr[jj] = *(const u32x4*)(vp + (size_t)(key0 - 32 + 8 * jj) * DM); } }
            const bool diag = (key0 == q0w);
            f32x16 s;
#pragma unroll
            for (int r = 0; r < 16; ++r) s[r] = 0.f;
#pragma unroll
            for (int ks = 0; ks < 4; ++ks) { const bf16x8 kf = *(LAS const bf16x8*)(Ks + q32 * 144 + (16 * ks + 8 * hi) * 2);
                s = __builtin_amdgcn_mfma_f32_32x32x16_bf16(kf, qf[ks], s, 0, 0, 0); }
            float zs[16], l1[16];
#pragma unroll
            for (int r = 0; r < 16; ++r) { const float z = s[r] * LOG2E; const float e = __builtin_amdgcn_exp2f(-__builtin_fabsf(z)); const float t = __builtin_amdgcn_logf(1.0f + e);
                float l = -(__builtin_fmaxf(z, 0.f) + t);
                if (diag) { const int kl = 8 * (r >> 2) + 4 * hi + (r & 3); if (kl >= q32) l = 0.f; }
                zs[r] = z; l1[r] = l; }
            float G0[4], G1[4];
#pragma unroll
            for (int j = 0; j < 4; ++j) { const float gs = (l1[4 * j] + l1[4 * j + 1]) + (l1[4 * j + 2] + l1[4 * j + 3]);
                auto rr = __builtin_amdgcn_permlane32_swap(__float_as_uint(gs), __float_as_uint(gs), false, false); G0[j] = __uint_as_float(rr[0]); G1[j] = __uint_as_float(rr[1]); }
            float p[16]; float run = R;
#pragma unroll
            for (int j = 3; j >= 0; --j) { float sfx = run + (hi == 0 ? G1[j] : 0.f);
#pragma unroll
                for (int e = 3; e >= 0; --e) { const int r = 4 * j + e; float val = __builtin_amdgcn_exp2f(l1[r] + zs[r] + sfx);
                    if (diag) { const int kl = 8 * j + 4 * hi + e; if (kl >= q32) val = 0.f; }
                    p[r] = val; sfx += l1[r]; }
                run += G0[j] + G1[j]; }
            R = run;
#pragma unroll
            for (int ks2 = 0; ks2 < 2; ++ks2) {
                u32x4 pw; pw.x = pk2(p[8 * ks2], p[8 * ks2 + 1]); pw.y = pk2(p[8 * ks2 + 2], p[8 * ks2 + 3]); pw.z = pk2(p[8 * ks2 + 4], p[8 * ks2 + 5]); pw.w = pk2(p[8 * ks2 + 6], p[8 * ks2 + 7]);
                const bf16x8 pb = __builtin_bit_cast(bf16x8, pw);
#pragma unroll
                for (int dh = 0; dh < 2; ++dh) {
                    LAS const unsigned char* va = Vs + (16 * ks2 + 4 * hi + (li >> 2)) * 192 + (32 * dh + 16 * ((lane >> 4) & 1) + 4 * (li & 3)) * 2;
                    const s16x4 lo = vtr(va), hi4 = vtr(va + 8 * 192);
                    const bf16x8 vf = (bf16x8){lo[0], lo[1], lo[2], lo[3], hi4[0], hi4[1], hi4[2], hi4[3]};
                    if (dh == 0) o0 = __builtin_amdgcn_mfma_f32_32x32x16_bf16(vf, pb, o0, 0, 0, 0);
                    else         o1 = __builtin_amdgcn_mfma_f32_32x32x16_bf16(vf, pb, o1, 0, 0, 0);
                }
            }
            asm volatile("s_waitcnt lgkmcnt(0)" ::: "memory");
            if (__all(R < -150.0f)) break;
        }
        bf16* op = O + (rowbase + q0w + q32) * DM + h * HD + 4 * hi;
#pragma unroll
        for (int j = 0; j < 4; ++j) { u32x2 w0, w1; w0.x = pk2(o0[4 * j], o0[4 * j + 1]); w0.y = pk2(o0[4 * j + 2], o0[4 * j + 3]); w1.x = pk2(o1[4 * j], o1[4 * j + 1]); w1.y = pk2(o1[4 * j + 2], o1[4 * j + 3]);
            *(u32x2*)(op + 8 * j) = w0; *(u32x2*)(op + 32 + 8 * j) = w1; }
    }
    __syncthreads();
}

__device__ __forceinline__ void spatial_phase(LAS unsigned char* lds, const bf16* ZZ, bf16* GT, const bf16* Wc, const float* bs, const float* gam, const float* bet, const float* VST, int cu, int G, int rev) {
    const int tid = opaque_tid(), lane = tid & 63, wid = __builtin_amdgcn_readfirstlane(tid >> 6), fr = lane & 15, kg = lane >> 4;
    LAS float* st = (LAS float*)(lds + 69632);
    const int wr = wid >> 2, wc = wid & 3;
    for (int k = 0; k < 2; ++k) {
        const int cls = 2 * k + (cu >> 7); const int chunk = 64 * (cu & 7) + 16 * (rev ? 3 - cls : cls) + ((cu >> 3) & 15);
        const size_t row0 = (size_t)chunk * GC;
        __syncthreads();
        { const int row = tid >> 2, part = tid & 3;
          const f32x4 a = *(const f32x4*)(VST + (row0 + row) * 16 + part * 4);
          float sm = a[0] + a[2], sq = a[1] + a[3];
          sm += __shfl_xor(sm, 1); sm += __shfl_xor(sm, 2); sq += __shfl_xor(sq, 1); sq += __shfl_xor(sq, 2);
          if (part == 0) { const float mean = sm * (1.f / GW); st[2 * row] = mean; st[2 * row + 1] = 1.f / sqrtf(sq * (1.f / GW) - mean * mean + LN_EPS); } }
        const int c8 = tid & 31, srow = tid >> 5;
        LAS unsigned char* const wl = lds + 72704;
        const int wt = tid >> 2, wq = tid & 3;
        u32x4 nv[8], nw[4];
#pragma unroll
        for (int it = 0; it < 8; ++it) nv[it] = *(const u32x4*)(ZZ + (row0 + it * 16 + srow) * 4096 + GW + c8 * 8);
#pragma unroll
        for (int q = 0; q < 4; ++q) nw[q] = *(const u32x4*)(Wc + (size_t)wt * GC + wq * 32 + q * 8);
        for (int g = 0; g < GG; ++g) {
            __syncthreads();
            { const float* gp = gam + g * 256 + c8 * 8; const float* bp = bet + g * 256 + c8 * 8;
              const f32x4 ga = *(const f32x4*)gp, gb = *(const f32x4*)(gp + 4), ba = *(const f32x4*)bp, bb = *(const f32x4*)(bp + 4);
#pragma unroll
              for (int q = 0; q < 4; ++q) *(LAS u32x4*)(wl + wt * 272 + wq * 64 + q * 16) = nw[q];
#pragma unroll
              for (int it = 0; it < 8; ++it) { const int s = it * 16 + srow;
                  const u32x4 w = nv[it];
                  const float mean = st[2 * s], rstd = st[2 * s + 1];
                  u32x4 o;
                  o.x = pk2((bflo(w.x) - mean) * rstd * ga.x + ba.x, (bfhi(w.x) - mean) * rstd * ga.y + ba.y);
                  o.y = pk2((bflo(w.y) - mean) * rstd * ga.z + ba.z, (bfhi(w.y) - mean) * rstd * ga.w + ba.w);
                  o.z = pk2((bflo(w.z) - mean) * rstd * gb.x + bb.x, (bfhi(w.z) - mean) * rstd * gb.y + bb.y);
                  o.w = pk2((bflo(w.w) - mean) * rstd * gb.z + bb.z, (bfhi(w.w) - mean) * rstd * gb.w + bb.w);
                  *(LAS u32x4*)(lds + s * 544 + c8 * 16) = o; } }
            __syncthreads();
            if (g + 1 < GG) {
#pragma unroll
                for (int it = 0; it < 8; ++it) nv[it] = *(const u32x4*)(ZZ + (row0 + it * 16 + srow) * 4096 + GW + (g + 1) * 256 + c8 * 8);
#pragma unroll
                for (int q = 0; q < 4; ++q) nw[q] = *(const u32x4*)(Wc + (size_t)(g + 1) * GC * GC + (size_t)wt * GC + wq * 32 + q * 8); }
            u32x2 uu[4][4];
#pragma unroll
            for (int tb = 0; tb < 4; ++tb)
#pragma unroll
                for (int cb = 0; cb < 4; ++cb) uu[tb][cb] = *(const u32x2*)(ZZ + (row0 + 64 * wr + 16 * tb + fr) * 4096 + g * 256 + 64 * wc + 16 * cb + 4 * kg);
            f32x4 acc[4][4];
#pragma unroll
            for (int a = 0; a < 4; ++a)
#pragma unroll
                for (int b2 = 0; b2 < 4; ++b2) acc[a][b2] = (f32x4){0.f, 0.f, 0.f, 0.f};
#pragma unroll
            for (int ks = 0; ks < 4; ++ks) {
                if (32 * ks <= 64 * wr + 63) {
                    bf16x8 X[4], Y[4];
#pragma unroll
                    for (int tb = 0; tb < 4; ++tb) { LAS const unsigned char* wp = wl + (64 * wr + 16 * tb + fr) * 272 + (32 * ks + 4 * kg) * 2;
                        const u32x2 a = *(LAS const u32x2*)wp, b2 = *(LAS const u32x2*)(wp + 32); const u32x4 w = (u32x4){a.x, a.y, b2.x, b2.y}; Y[tb] = __builtin_bit_cast(bf16x8, w); }
#pragma unroll
                    for (int cb = 0; cb < 4; ++cb) { LAS const unsigned char* xa = lds + (32 * ks + 4 * kg + (fr >> 2)) * 544 + (64 * wc + 16 * cb + 4 * (fr & 3)) * 2;
                        const s16x4 lo = vtr(xa), hi4 = vtr(xa + 16 * 544);
                        X[cb] = (bf16x8){lo[0], lo[1], lo[2], lo[3], hi4[0], hi4[1], hi4[2], hi4[3]}; }
#pragma unroll
                    for (int tb = 0; tb < 4; ++tb)
#pragma unroll
                        for (int cb = 0; cb < 4; ++cb) acc[tb][cb] = __builtin_amdgcn_mfma_f32_16x16x32_bf16(X[cb], Y[tb], acc[tb][cb], 0, 0, 0);
                }
            }
#pragma unroll
            for (int tb = 0; tb < 4; ++tb) { const int t = 64 * wr + 16 * tb + fr; const float bsv = bs[g * GC + t];
#pragma unroll
                for (int cb = 0; cb < 4; ++cb) { const int c = g * 256 + 64 * wc + 16 * cb + 4 * kg;
                    const u32x2 u = uu[tb][cb];
                    u32x2 o; o.x = pk2(bflo(u.x) * (acc[tb][cb][0] + bsv), bfhi(u.x) * (acc[tb][cb][1] + bsv)); o.y = pk2(bflo(u.y) * (acc[tb][cb][2] + bsv), bfhi(u.y) * (acc[tb][cb][3] + bsv));
                    *(u32x2*)(GT + (row0 + t) * GW + c) = o; } }
        }
    }
}

#ifndef PROBE
#define PROBE 0
#endif
#ifndef G2_REV
#define G2_REV 1
#endif
__device__ __forceinline__ void gbar(unsigned* ctr, unsigned target) {
    asm volatile("s_waitcnt vmcnt(0)" ::: "memory");
    __syncthreads();
    if (threadIdx.x == 0) {
        __builtin_amdgcn_fence(__ATOMIC_RELEASE, "agent");
        asm volatile("s_waitcnt vmcnt(0)" ::: "memory");
        __hip_atomic_fetch_add(ctr, 1u, __ATOMIC_RELAXED, __HIP_MEMORY_SCOPE_AGENT);
        while (__hip_atomic_load(ctr, __ATOMIC_RELAXED, __HIP_MEMORY_SCOPE_AGENT) < target) __builtin_amdgcn_s_sleep(1);
        __builtin_amdgcn_fence(__ATOMIC_ACQUIRE, "agent");
        asm volatile("s_waitcnt vmcnt(0)" ::: "memory");
    }
    __syncthreads();
}
#define GSYNC() do { bar_target += (unsigned)G; gbar(bar_ctr, bar_target); if (PROBE == 7) { bar_target += (unsigned)G; gbar(bar_ctr, bar_target); } } while (0)
__global__ void __launch_bounds__(512, 2) fwd_kernel(Args args) {
    extern __shared__ __attribute__((aligned(16))) unsigned char lds_raw[];
    cg::grid_group grid = cg::this_grid();
    LAS unsigned char* lds = (LAS unsigned char*)lds_raw;
    const int G = gridDim.x, cu = blockIdx.x, ngw = G * 8;
    unsigned char* ws = args.ws;
    const float* x = args.in[0];
    float* out = args.out;
    bf16* HB = (bf16*)(ws + WS_HB);
    unsigned* bar_ctr = (unsigned*)(ws + WS_CTL); unsigned bar_target = 0u;
    if (cu == 0 && threadIdx.x < 8) __hip_atomic_store((unsigned*)(ws + WS_CTL + 8192) + 64 * threadIdx.x, 0u, __ATOMIC_RELAXED, __HIP_MEMORY_SCOPE_AGENT);
    if (cu == 0 && threadIdx.x == 0) __hip_atomic_store(bar_ctr, 0u, __ATOMIC_RELAXED, __HIP_MEMORY_SCOPE_AGENT);

    for (int rep = 0; rep < (PROBE == 8 ? 2 : 1); ++rep) {
        const int tid = opaque_tid(), lane = tid & 63, wave = __builtin_amdgcn_readfirstlane(tid >> 6), gw = cu * 8 + wave;
        LAS float* scr = (LAS float*)(lds + wave * 16384);
        for (int mat = 0; mat < 16; ++mat) {
            const float* W; bf16* WT; int K, N, perm = 0;
            if (mat < 2)       { W = args.in[1] + (size_t)mat * DM * 3072;        WT = (bf16*)(ws + WS_ATTN_IN) + (size_t)mat * 3072 * DM;        K = DM; N = 3072; }
            else if (mat < 4)  { W = args.in[2] + (size_t)(mat - 2) * DM * DM;    WT = (bf16*)(ws + WS_ATTN_OUT) + (size_t)(mat - 2) * DM * DM;   K = DM; N = DM; }
            else if (mat < 6)  { W = args.in[3] + (size_t)(mat - 4) * DM * 4096;  WT = (bf16*)(ws + WS_GMLP_IN) + (size_t)(mat - 4) * 4096 * DM;  K = DM; N = 4096; }
            else if (mat < 8)  { W = args.in[8] + (size_t)(mat - 6) * GW * DM;    WT = (bf16*)(ws + WS_GMLP_OUT) + (size_t)(mat - 6) * DM * GW;   K = GW; N = DM; }
            else if (mat < 12) { W = args.in[9] + (size_t)(mat - 8) * DM * FF2;   WT = (bf16*)(ws + WS_FFN_UP) + (size_t)(mat - 8) * FF2 * DM;    K = DM; N = FF2; perm = 1; }
            else               { W = args.in[12] + (size_t)(mat - 12) * FF * DM;  WT = (bf16*)(ws + WS_FFN_DOWN) + (size_t)(mat - 12) * DM * FF;  K = FF; N = DM; }
            const int nitems = (K / 64) * (N / 32);
            for (int it = gw; it < nitems; it += ngw) transpose_item(W, K, N, WT, perm, (mat < 2 || mat == 4 || mat == 5 || (mat >= 8 && mat < 12)) ? 1 : 0, scr, it, lane);
        }
        { const float* wsrc = args.in[6]; bf16* wd = (bf16*)(ws + WS_WS);
          for (int i = cu * 512 + tid; i < 2 * GG * GC * GC; i += G * 512) { const int s = i & 127, t = (i >> 7) & 127; const float v = (s <= t) ? wsrc[i] : 0.f; wd[i] = (bf16)(pk2(v, v) & 0xffffu); } }
        for (int m = gw; m < NTOK; m += ngw) {
            const f32x4* xr = (const f32x4*)(x + (size_t)m * DM) + lane; u32x2* o8 = (u32x2*)(HB + (size_t)m * DM) + lane;
#pragma unroll
            for (int j = 0; j < 4; ++j) { const f32x4 v = xr[64 * j]; u32x2 w; w.x = pg8::cvt_pk_f16(v.x, v.y); w.y = pg8::cvt_pk_f16(v.z, v.w); o8[64 * j] = w; }
        }
    }
    grid.sync();

    int dir = 0;
    for (int layer = 0; layer < DEPTH; ++layer) {
        const int j = layer >> 1, mixer = layer & 1;
        for (int step = 0; step < 2; ++step) {
            if (step == 0) {
                pg8::Gemm g; pg8::EpiBf16 E;
                if (mixer == 0) { g = pg8::Gemm{HB, (const bf16*)(ws + WS_ATTN_IN) + (size_t)j * 3072 * DM, NTOK, 3072, DM};
                    E = pg8::EpiBf16{(bf16*)(ws + WS_Q), DM, 0, DM, (size_t)NTOK * DM, 0.125f, nullptr, nullptr}; }
                else { g = pg8::Gemm{HB, (const bf16*)(ws + WS_GMLP_IN) + (size_t)j * 4096 * DM, NTOK, 4096, DM};
                    E = pg8::EpiBf16{(bf16*)(ws + WS_ZZ), 4096, 1, 0, 0, 1.f, (float*)(ws + WS_VST), (LAS float*)(lds + 131072)}; }
                pg8::StaticOrder S; S.rev = dir; dir ^= 1; S.init(g.M, g.N, G, cu);
                for (int rep = 0; rep < (PROBE == 1 ? 2 : 1); ++rep)
                pg8::gemm_phase<pg8::EpiBf16, pg8::StaticOrder, true, true>(lds, g, S, E);
            } else {
                pg8::Gemm g{HB, (const bf16*)(ws + WS_FFN_UP) + (size_t)layer * FF2 * DM, NTOK, FF2, DM};
                pg8::EpiConv E{(bf16*)(ws + WS_G), args.in[10] + (size_t)layer * 3 * FF2, args.in[11] + (size_t)layer * FF2, lds + 131072, FF, FF2, FF, (float*)(ws + WS_HT)};
                pg8::StaticOrder S; S.rev = dir; dir ^= 1; S.init(g.M, g.N, G, cu);
                for (int rep = 0; rep < (PROBE == 4 ? 2 : 1); ++rep)
                pg8::gemm_phase<pg8::EpiConv, pg8::StaticOrder, true, true>(lds, g, S, E);
                GSYNC();
                ffn_fix_phase((const float*)(ws + WS_HT), (bf16*)(ws + WS_G), args.in[10] + (size_t)layer * 3 * FF2, args.in[11] + (size_t)layer * FF2, cu, G, opaque_tid());
            }
            GSYNC();
            if (step == 0) {
                for (int rep = 0; rep < (((PROBE == 2 && mixer == 0) || (PROBE == 3 && mixer == 1)) ? 2 : 1); ++rep)
                if (mixer == 0) attn_phase(lds, (const bf16*)(ws + WS_Q), (const bf16*)(ws + WS_K), (const bf16*)(ws + WS_V), (bf16*)(ws + WS_O), cu, G, dir);
                else spatial_phase(lds, (const bf16*)(ws + WS_ZZ), (bf16*)(ws + WS_GT), (const bf16*)(ws + WS_WS) + (size_t)j * GG * GC * GC, args.in[7] + j * GG * GC, args.in[4] + j * GW, args.in[5] + j * GW, (const float*)(ws + WS_VST), cu, G, dir); dir ^= 1;
                GSYNC();
            }
            const int lnidx = 2 * layer + step;
            {
                pg8::Gemm g;
                if (step == 0 && mixer == 0) g = pg8::Gemm{(const bf16*)(ws + WS_O), (const bf16*)(ws + WS_ATTN_OUT) + (size_t)j * DM * DM, NTOK, DM, DM};
                else if (step == 0) g = pg8::Gemm{(const bf16*)(ws + WS_GT), (const bf16*)(ws + WS_GMLP_OUT) + (size_t)j * DM * GW, NTOK, DM, GW};
                else g = pg8::Gemm{(const bf16*)(ws + WS_G), (const bf16*)(ws + WS_FFN_DOWN) + (size_t)layer * DM * FF, NTOK, DM, FF};
                const int pl = (lnidx - 1) >> 1;
                const float* pgam = lnidx == 0 ? nullptr : (((lnidx - 1) & 1) ? args.in[15] : args.in[13]) + pl * DM;
                const float* pbet = lnidx == 0 ? nullptr : (((lnidx - 1) & 1) ? args.in[16] : args.in[14]) + pl * DM;
                const float* cgam = (step == 0 ? args.in[13] : args.in[15]) + layer * DM;
                const float* cbet = (step == 0 ? args.in[14] : args.in[16]) + layer * DM;
                const bool lastln = lnidx == 2 * DEPTH - 1;
                pg8::EpiResLn E{(const unsigned short*)HB, 0, out, (float*)(ws + WS_ST), cgam, cbet, HB, (unsigned short*)HB,
                                (unsigned*)(ws + WS_CTL + 8192), 128u * (unsigned)lnidx, lastln ? 1 : 0, lds + 131072, dir};
                pg8::StaticOrder S; S.rev = dir; dir ^= 1; S.init(g.M, g.N, G, cu);
                if (PROBE == 9) { pg8::EpiBf16 E0{(bf16*)(ws + WS_R + (step == 1 ? 512 * MiB : 0)), DM, 0, 0, 0, 1.f};
                    pg8::gemm_phase<pg8::EpiBf16, pg8::StaticOrder, true, true>(lds, g, S, E0); }
                pg8::gemm_phase<pg8::EpiResLn, pg8::StaticOrder, true, true>(lds, g, S, E);
            }
            if (lnidx != 2 * DEPTH - 1) GSYNC();
        }
    }
}

extern "C" void kernel_launch(void* const* d_in, const int* in_sizes, int n_in, void* d_out, int out_size, void* d_ws, size_t ws_size, hipStream_t stream) {
    static int grid = 0;
    if (grid == 0) {
        if (n_in != 17 || out_size != NTOK * DM || ws_size < WS_END) { fprintf(stderr, "kernel_launch: unexpected shapes (n_in %d, out %d, ws %zu)\n", n_in, out_size, ws_size); grid = -1; return; }
        int dev = 0, cus = 0, per_cu = 0;
        hipGetDevice(&dev);
        hipDeviceGetAttribute(&cus, hipDeviceAttributeMultiprocessorCount, dev);
        if (hipFuncSetAttribute((const void*)fwd_kernel, hipFuncAttributeMaxDynamicSharedMemorySize, LDS_BYTES) != hipSuccess) { fprintf(stderr, "kernel_launch: hipFuncSetAttribute failed\n"); grid = -1; return; }
        if (hipOccupancyMaxActiveBlocksPerMultiprocessor(&per_cu, (const void*)fwd_kernel, 512, LDS_BYTES) != hipSuccess || per_cu < 1) { fprintf(stderr, "kernel_launch: occupancy query says %d\n", per_cu); per_cu = 1; }
        (void)hipGetLastError();
        grid = cus * per_cu;
        fprintf(stderr, "kernel_launch: grid %d (cus %d x %d)\n", grid, cus, per_cu);
        if (grid != 256) { fprintf(stderr, "kernel_launch: the fused LayerNorm epilogue's group barrier is laid out for a 256-workgroup grid; nothing launched\n"); grid = -1; return; }
    }
    if (grid < 0) return;
    Args a{};
    for (int i = 0; i < 17; ++i) a.in[i] = (const float*)d_in[i];
    a.out = (float*)d_out; a.ws = (unsigned char*)d_ws;
    void* kargs[] = {&a};
    hipError_t e = hipLaunchCooperativeKernel((const void*)fwd_kernel, dim3(grid), dim3(512), kargs, LDS_BYTES, stream);
    if (e != hipSuccess) fprintf(stderr, "cooperative launch failed: %s (grid %d)\n", hipGetErrorString(e), grid);
}
```

```cpp
#include <hip/hip_runtime.h>
#include <hip/hip_cooperative_groups.h>
#include <cstdio>
#include <cstdint>
namespace cg = cooperative_groups;
__device__ __forceinline__ int opaque_tid() { int t = threadIdx.x; asm volatile("" : "+v"(t)); return t; }
namespace pg8 {
#define PG8_LAS __attribute__((address_space(3)))
typedef unsigned short bf16_t;
typedef short bf16x8 __attribute__((ext_vector_type(8)));
typedef float f32x4 __attribute__((ext_vector_type(4)));
typedef unsigned u32x4 __attribute__((ext_vector_type(4)));
constexpr int BM = 256, BK = 64, HALF = 128, HTB = HALF * BK * 2  , STAGE_BYTES = 8 * HTB, NXCD = 8, WGM = 8;

__host__ __device__ __forceinline__ int lds_byte(int r, int c) { const int st = (r >> 4) * 2 + (c >> 5), rr = r & 15, cc = c & 31, ob = rr * 64 + cc * 2; return st * 1024 + (ob ^ (((ob >> 9) & 1) << 5)); }
__host__ __device__ __forceinline__ void stage_rc(int b, int& R, int& C) { const int st = b / 1024, sb = b % 1024, swz = sb ^ (((sb >> 9) & 1) << 5); R = (st >> 1) * 16 + swz / 64; C = (st & 1) * 32 + (swz % 64) / 2; }
__host__ __device__ __forceinline__ int perm32(int rho) { const int n = rho >> 4, i = rho & 15; return 8 * (i >> 2) + 4 * n + (i & 3); }

struct Unit { int pm, pn; };
struct Gemm { const bf16_t* A; const bf16_t* Bt; int M, N, K; };

struct StaticOrder {
    int nM, nN, nwg, G, c, rev = 0;
    __host__ __device__ void init(int M, int N, int G_, int c_) { nM = M / BM; nN = N / BM; nwg = nM * nN; G = G_; c = c_; }
    __host__ __device__ bool next(int i, Unit& u) const {
        if ((long)i * G + c >= nwg) return false;
        const long L = (long)(rev ? (nwg / G - 1 - i) : i) * G + c;
        int wgid = (int)L; { const int q = nwg / NXCD, r = nwg % NXCD, xcd = wgid % NXCD, off = wgid / NXCD; wgid = (xcd < r ? xcd * (q + 1) : r * (q + 1) + (xcd - r) * q) + off; }
        const int nig = WGM * nN, gid = wgid / nig, fm = gid * WGM, gsz = (nM - fm) < WGM ? (nM - fm) : WGM;
        u.pm = fm + ((wgid % nig) % gsz); u.pn = (wgid % nig) / gsz; return true;
    }
    __device__ __forceinline__ void a_ready(const Unit&) const {}
    __device__ __forceinline__ void done(const Unit&) const {}
};
__device__ __forceinline__ unsigned cvt_pk_bf16(float lo, float hi) { unsigned r; asm volatile("v_cvt_pk_bf16_f32 %0, %1, %2" : "=v"(r) : "v"(lo), "v"(hi)); return r; }
typedef float f32x2 __attribute__((ext_vector_type(2)));
typedef _Float16 f16x8 __attribute__((ext_vector_type(8)));
template <bool F16> __device__ __forceinline__ f32x4 mma16(bf16x8 a, bf16x8 b, f32x4 c) {
    if constexpr (F16) return __builtin_amdgcn_mfma_f32_16x16x32_f16(__builtin_bit_cast(f16x8, a), __builtin_bit_cast(f16x8, b), c, 0, 0, 0);
    else return __builtin_amdgcn_mfma_f32_16x16x32_bf16(a, b, c, 0, 0, 0);
}
__device__ __forceinline__ unsigned cvt_pk_f16(float lo, float hi) { typedef _Float16 h2 __attribute__((ext_vector_type(2))); const h2 v = {(_Float16)lo, (_Float16)hi}; return __builtin_bit_cast(unsigned, v); }
typedef unsigned u32x2e __attribute__((ext_vector_type(2)));
__device__ __forceinline__ float gelu_tanh(float x) {
    const float t = x * (-2.302208198f + (-0.1029432397f) * x * x);
    return x * __builtin_amdgcn_rcpf(1.0f + __builtin_amdgcn_exp2f(t));
}
struct EpiBf16 {
    static constexpr bool PERM = true, AFTER_DRAIN = false, F16 = true;
    bf16_t* O; int ldc; int act; int split_cols; size_t split_stride; float scale0;
    float* vst; PG8_LAS float* sl;
    __device__ __forceinline__ void operator()(const f32x4 (&acc)[2][2][4][2], const Unit& u, int wr, int wc, int fr, int fq) const {
        const int row0 = u.pm * BM + wr * 64 + fr; int colt = u.pn * BM; bf16_t* base = O;
        float sc = 1.f; if (split_cols) { const int t = colt / split_cols; base += (size_t)t * split_stride; colt -= t * split_cols; if (t == 0) sc = scale0; }
        const int col0 = colt + wc * 32 + 8 * fq;
        const bool dost = vst != nullptr && u.pn >= 8;
#pragma unroll
        for (int ai = 0; ai < 2; ++ai)
#pragma unroll
            for (int m = 0; m < 4; ++m) { bf16_t* rowp = base + (size_t)(row0 + ai * HALF + m * 16) * ldc + col0; float rs = 0.f, rq = 0.f;
#pragma unroll
                for (int bj = 0; bj < 2; ++bj) { f32x4 v0 = acc[ai][bj][m][0], v1 = acc[ai][bj][m][1];
                    if (act) { v0 = (f32x4){gelu_tanh(v0[0]), gelu_tanh(v0[1]), gelu_tanh(v0[2]), gelu_tanh(v0[3])};
                               v1 = (f32x4){gelu_tanh(v1[0]), gelu_tanh(v1[1]), gelu_tanh(v1[2]), gelu_tanh(v1[3])}; }
                    if (dost) { rs += ((v0[0] + v0[1]) + (v0[2] + v0[3])) + ((v1[0] + v1[1]) + (v1[2] + v1[3]));
                                rq += ((v0[0] * v0[0] + v0[1] * v0[1]) + (v0[2] * v0[2] + v0[3] * v0[3])) + ((v1[0] * v1[0] + v1[1] * v1[1]) + (v1[2] * v1[2] + v1[3] * v1[3])); }
                    v0 = v0 * sc; v1 = v1 * sc; u32x4 w; w.x = cvt_pk_bf16(v0[0], v0[1]); w.y = cvt_pk_bf16(v0[2], v0[3]); w.z = cvt_pk_bf16(v1[0], v1[1]); w.w = cvt_pk_bf16(v1[2], v1[3]);
                    *(u32x4*)(rowp + bj * HALF) = w; }
                if (dost) { rs += __shfl_xor(rs, 16); rs += __shfl_xor(rs, 32); rq += __shfl_xor(rq, 16); rq += __shfl_xor(rq, 32);
                    const int lrow = ai * HALF + wr * 64 + m * 16 + fr; if (fq == 0) { sl[(lrow * 4 + wc) * 2] = rs; sl[(lrow * 4 + wc) * 2 + 1] = rq; } } }
        if (dost) {
            asm volatile("s_waitcnt lgkmcnt(0)" ::: "memory"); __builtin_amdgcn_s_barrier(); asm volatile("" ::: "memory");
            const int t = opaque_tid();
            if (t < 256) { const f32x4 a = *(PG8_LAS const f32x4*)(sl + t * 8), b = *(PG8_LAS const f32x4*)(sl + t * 8 + 4);
                typedef float f32x2v __attribute__((ext_vector_type(2)));
                *(f32x2v*)(vst + ((size_t)u.pm * BM + t) * 16 + (u.pn - 8) * 2) = (f32x2v){(a[0] + a[2]) + (b[0] + b[2]), (a[1] + a[3]) + (b[1] + b[3])}; }
        }
    }
};
struct EpiRes {
    static constexpr bool PERM = false, AFTER_DRAIN = false, F16 = false;
    const float* base; float* out; int ldc; float alpha;
    __device__ __forceinline__ void operator()(const f32x4 (&acc)[2][2][4][2], const Unit& u, int wr, int wc, int fr, int fq) const {
        const int col0 = u.pn * BM + wc * 32 + 4 * fq;
#pragma unroll
        for (int ai = 0; ai < 2; ++ai)
#pragma unroll
            for (int m = 0; m < 4; ++m) { const size_t off = (size_t)(u.pm * BM + ai * HALF + wr * 64 + m * 16 + fr) * ldc + col0;
#pragma unroll
                for (int bj = 0; bj < 2; ++bj)
#pragma unroll
                    for (int n = 0; n < 2; ++n) { const f32x4 bs = *(const f32x4*)(base + off + bj * HALF + n * 16);
                        *(f32x4*)(out + off + bj * HALF + n * 16) = bs * alpha + acc[ai][bj][m][n]; }
                asm volatile("" ::: "memory"); }
    }
};

template <int CTRL> __device__ __forceinline__ float dpp_mov(float old, float src) {
    return __builtin_bit_cast(float, __builtin_amdgcn_update_dpp(__builtin_bit_cast(int, old), __builtin_bit_cast(int, src), CTRL, 0xf, 0xf, false));
}
struct SeqOrder {
    int G, c;
    __device__ bool next(int i, Unit& u) const { if (i >= 22) return false; int it, step;
        if (i < 16) { it = c + G * (i >> 3); step = i & 7; } else { const int v = 6 * c + (i - 16); it = 512 + (v >> 3); step = v & 7; }
        u.pn = it >> 5; u.pm = 8 * (it & 31) + step; return true; }
    __device__ __forceinline__ void a_ready(const Unit&) const {}
    __device__ __forceinline__ void done(const Unit&) const {}
};
struct EpiConv {
    static constexpr bool PERM = true, AFTER_DRAIN = false, F16 = true;
    bf16_t* O; const float* cw; const float* cb; PG8_LAS unsigned char* hl; int ldo, ncol2, nfeat; float* ht;
    __device__ __forceinline__ void operator()(const f32x4 (&acc)[2][2][4][2], const Unit& u, int wr, int wc, int fr, int fq) const {
        const int lcol = wc * 32 + 8 * fq;
        { const int t = opaque_tid();
          if (t < 256) { const int p = t >> 5, ch = t & 31, pp = p & 3; const float* src = (pp < 3 ? cw + pp * ncol2 : cb) + (p >> 2) * nfeat + 128 * u.pn + 4 * ch;
              *(PG8_LAS f32x4*)(hl + 10240 + (p * 128 + 4 * ch) * 4) = *(const f32x4*)src; } }
        float* const htu = ht + (size_t)(u.pm * 22 + u.pn) * 1024;
        if (fr >= 14) {
#pragma unroll
            for (int ai = 0; ai < 2; ++ai) { const int k = 2 * ai + wr;
                if (k < 3) { PG8_LAS unsigned char* hp = hl + k * 2048 + (fr - 14) * 1024 + lcol * 4;
#pragma unroll
                    for (int bj = 0; bj < 2; ++bj)
#pragma unroll
                        for (int n = 0; n < 2; ++n) *(PG8_LAS f32x4*)(hp + bj * 512 + n * 16) = acc[ai][bj][3][n]; }
                else {
#pragma unroll
                    for (int bj = 0; bj < 2; ++bj)
#pragma unroll
                        for (int n = 0; n < 2; ++n) *(f32x4*)(htu + (2 + fr - 14) * 256 + bj * 128 + lcol + 4 * n) = acc[ai][bj][3][n]; } }
        }
        if (wr == 0 && fr < 2) {
#pragma unroll
            for (int bj = 0; bj < 2; ++bj)
#pragma unroll
                for (int n = 0; n < 2; ++n) *(f32x4*)(htu + fr * 256 + bj * 128 + lcol + 4 * n) = acc[0][bj][0][n];
        }
        asm volatile("s_waitcnt lgkmcnt(0)" ::: "memory"); __builtin_amdgcn_s_barrier(); asm volatile("" ::: "memory");
        u32x2e keep[2][4];
#pragma unroll
        for (int n = 0; n < 2; ++n) {
            const int f = 128 * u.pn + lcol + 4 * n;
            PG8_LAS const float* const wl = (PG8_LAS const float*)(hl + 10240) + lcol + 4 * n;
            const f32x4 wg0 = *(PG8_LAS const f32x4*)(wl), wg1 = *(PG8_LAS const f32x4*)(wl + 128), wg2 = *(PG8_LAS const f32x4*)(wl + 256), bg = *(PG8_LAS const f32x4*)(wl + 384);
            const f32x4 wv0 = *(PG8_LAS const f32x4*)(wl + 512), wv1 = *(PG8_LAS const f32x4*)(wl + 640), wv2 = *(PG8_LAS const f32x4*)(wl + 768), bv = *(PG8_LAS const f32x4*)(wl + 896);
#pragma unroll
            for (int ai = 0; ai < 2; ++ai) {
                const int k = 2 * ai + wr;
                const int rslot = k > 0 ? k - 1 : 0;
                PG8_LAS const unsigned char* hp = hl + rslot * 2048 + (lcol + 4 * n) * 4;
                f32x4 hg2 = *(PG8_LAS const f32x4*)hp, hv2 = *(PG8_LAS const f32x4*)(hp + 512), hg1 = *(PG8_LAS const f32x4*)(hp + 1024), hv1 = *(PG8_LAS const f32x4*)(hp + 1536);
                if (k == 0) { hg2 = (f32x4){0.f, 0.f, 0.f, 0.f}; hv2 = hg2; hg1 = hg2; hv1 = hg2; }
#pragma unroll
                for (int m = 0; m < 4; ++m) {
                    float r[4];
#pragma unroll
                    for (int e = 0; e < 4; ++e) {
                        const float xg = acc[ai][0][m][n][e], xv = acc[ai][1][m][n][e];
                        float o1g, o2g, o1v, o2v;
                        if (m == 0) { o1g = hg1[e]; o2g = fr == 0 ? hg2[e] : hg1[e]; o1v = hv1[e]; o2v = fr == 0 ? hv2[e] : hv1[e]; }
                        else { const float pgv = acc[ai][0][m > 0 ? m - 1 : 0][n][e], pvv = acc[ai][1][m > 0 ? m - 1 : 0][n][e];
                            o1g = dpp_mov<0x121>(pgv, pgv); o2g = dpp_mov<0x122>(pgv, pgv); o1v = dpp_mov<0x121>(pvv, pvv); o2v = dpp_mov<0x122>(pvv, pvv); }
                        const float p1g = dpp_mov<0x111>(o1g, xg), p2g = dpp_mov<0x112>(o2g, xg), p1v = dpp_mov<0x111>(o1v, xv), p2v = dpp_mov<0x112>(o2v, xv);
                        const float yg = bg[e] + wg2[e] * xg + wg1[e] * p1g + wg0[e] * p2g;
                        const float yv = bv[e] + wv2[e] * xv + wv1[e] * p1v + wv0[e] * p2v;
                        r[e] = yg * __builtin_amdgcn_rcpf(1.0f + __builtin_amdgcn_exp2f(-1.4426950408889634f * yg)) * yv;
                    }
                    u32x2e w; w.x = cvt_pk_bf16(r[0], r[1]); w.y = cvt_pk_bf16(r[2], r[3]);
                    if (n == 0) keep[ai][m] = w;
                    else { const u32x4 w4 = (u32x4){keep[ai][m].x, keep[ai][m].y, w.x, w.y}; *(u32x4*)(O + (size_t)(u.pm * BM + ai * HALF + wr * 64 + m * 16 + fr) * ldo + f - 4) = w4; }
                }
            }
        }
    }
};

struct EpiResLn {
    static constexpr bool PERM = true, AFTER_DRAIN = false, F16 = false;
    const unsigned short* base16; int isbf; float* out; float* st; const float* cg; const float* cbeta; bf16_t* hb; unsigned short* hf; unsigned* gcnt; unsigned tgt0; int last; PG8_LAS unsigned char* xl; int rev;
    static constexpr int ldc = 1024; static constexpr float alpha = 1.681792830507429f, eps = 1e-5f;
    typedef _Float16 h16x2 __attribute__((ext_vector_type(2)));
    __device__ __forceinline__ f32x4 dec(u32x2e w) const {
        if (isbf) return (f32x4){__uint_as_float(w.x << 16), __uint_as_float(w.x & 0xffff0000u), __uint_as_float(w.y << 16), __uint_as_float(w.y & 0xffff0000u)};
        const float f0 = (float)__builtin_bit_cast(_Float16, (unsigned short)(w.x & 0xffffu)), f1 = (float)__builtin_bit_cast(_Float16, (unsigned short)(w.x >> 16));
        const float f2 = (float)__builtin_bit_cast(_Float16, (unsigned short)(w.y & 0xffffu)), f3 = (float)__builtin_bit_cast(_Float16, (unsigned short)(w.y >> 16));
        return (f32x4){f0, f1, f2, f3}; }
    __device__ __forceinline__ void operator()(f32x4 (&acc)[2][2][4][2], const Unit& u, int wr, int wc, int fr, int fq) const {
        asm volatile("" : "+v"(fr), "+v"(fq));
        typedef float f32x2s __attribute__((ext_vector_type(2)));
        PG8_LAS float* const sl = (PG8_LAS float*)xl; PG8_LAS float* const gl = (PG8_LAS float*)(xl + 8192);
        const int col0 = u.pn * BM + wc * 32 + 8 * fq, lc0 = wc * 32 + 8 * fq;
        { const int t = opaque_tid();
          if (t < 128) { const int which = t >> 6, c4 = 4 * (t & 63); *(PG8_LAS f32x4*)(gl + which * 256 + c4) = *(const f32x4*)((which ? cbeta : cg) + u.pn * BM + c4); } }
        u32x4 nb[2];
        { const size_t off = ((size_t)u.pm * BM + wr * 64 + fr) * ldc + col0;
#pragma unroll
          for (int bj = 0; bj < 2; ++bj) nb[bj] = *(const u32x4*)(base16 + off + bj * HALF); }
#pragma unroll
        for (int i = 0; i < 8; ++i) { const int ai = i >> 2, m = i & 3; const int lrow = ai * HALF + wr * 64 + m * 16 + fr;
            u32x4 cur[2];
#pragma unroll
            for (int bj = 0; bj < 2; ++bj) cur[bj] = nb[bj];
            if (i < 7) { const int lr2 = ((i + 1) >> 2) * HALF + wr * 64 + ((i + 1) & 3) * 16 + fr; const size_t off2 = ((size_t)u.pm * BM + lr2) * ldc + col0;
#pragma unroll
                for (int bj = 0; bj < 2; ++bj) nb[bj] = *(const u32x4*)(base16 + off2 + bj * HALF); }
            asm volatile("" ::: "memory");
            float rsum = 0.f, rq = 0.f;
#pragma unroll
            for (int q = 0; q < 4; ++q) { const int bj = q >> 1, n = q & 1;
                const f32x4 y = dec(n ? (u32x2e){cur[bj].z, cur[bj].w} : (u32x2e){cur[bj].x, cur[bj].y}) * alpha + acc[ai][bj][m][n];
                acc[ai][bj][m][n] = y;
                rsum += (y[0] + y[1]) + (y[2] + y[3]); rq += (y[0] * y[0] + y[1] * y[1]) + (y[2] * y[2] + y[3] * y[3]); }
            rsum += __shfl_xor(rsum, 16); rsum += __shfl_xor(rsum, 32); rq += __shfl_xor(rq, 16); rq += __shfl_xor(rq, 32);
            if (fq == 0) { sl[(lrow * 4 + wc) * 2] = rsum; sl[(lrow * 4 + wc) * 2 + 1] = rq; }
            asm volatile("" ::: "memory"); }
        asm volatile("s_waitcnt lgkmcnt(0)" ::: "memory"); __builtin_amdgcn_s_barrier(); asm volatile("" ::: "memory");
        const int t = opaque_tid();
        if (t < 256) { const f32x4 a = *(PG8_LAS const f32x4*)(sl + t * 8), b = *(PG8_LAS const f32x4*)(sl + t * 8 + 4);
            const float ssum = (a[0] + a[2]) + (b[0] + b[2]), ssq = (a[1] + a[3]) + (b[1] + b[3]);
            __hip_atomic_store((unsigned long long*)(st + ((size_t)u.pm * BM + t) * 8 + u.pn * 2), ((unsigned long long)__float_as_uint(ssq) << 32) | __float_as_uint(ssum), __ATOMIC_RELAXED, __HIP_MEMORY_SCOPE_AGENT); }
        asm volatile("s_waitcnt vmcnt(0) lgkmcnt(0)" ::: "memory"); __builtin_amdgcn_s_barrier(); asm volatile("" ::: "memory");
        if (t == 0) {
            unsigned* const ctr = gcnt + 64 * (blockIdx.x & 7); const unsigned target = tgt0 + 32u * (unsigned)((rev ? 3 - ((u.pm >> 3) & 3) : ((u.pm >> 3) & 3)) + 1);
            __hip_atomic_fetch_add(ctr, 1u, __ATOMIC_RELAXED, __HIP_MEMORY_SCOPE_AGENT);
            while (__hip_atomic_load(ctr, __ATOMIC_RELAXED, __HIP_MEMORY_SCOPE_AGENT) < target) __builtin_amdgcn_s_sleep(1);
        }
        __builtin_amdgcn_s_barrier(); asm volatile("" ::: "memory");
        if (t < 256) { const size_t row = (size_t)u.pm * BM + t;
            float s = 0.f, q = 0.f;
#pragma unroll
            for (int k4 = 0; k4 < 4; ++k4) { const unsigned long long w = __hip_atomic_load((const unsigned long long*)(st + row * 8 + 2 * k4), __ATOMIC_RELAXED, __HIP_MEMORY_SCOPE_AGENT);
                s += __uint_as_float((unsigned)w); q += __uint_as_float((unsigned)(w >> 32)); }
            const float mean = s * (1.f / 1024.f), rstd = 1.f / sqrtf(q * (1.f / 1024.f) - mean * mean + eps);
            *(PG8_LAS f32x2s*)(sl + 2 * t) = (f32x2s){mean, rstd}; }
        asm volatile("s_waitcnt lgkmcnt(0)" ::: "memory"); __builtin_amdgcn_s_barrier(); asm volatile("" ::: "memory");
#pragma unroll
        for (int i = 0; i < 8; ++i) { const int ai = i >> 2, m = i & 3; const int lrow = ai * HALF + wr * 64 + m * 16 + fr; const size_t off = ((size_t)u.pm * BM + lrow) * ldc + col0;
            const f32x2s mr = *(PG8_LAS const f32x2s*)(sl + 2 * lrow); u32x4 pw;
#pragma unroll
            for (int q = 0; q < 4; ++q) { const int bj = q >> 1, n = q & 1;
                const f32x4 g4 = *(PG8_LAS const f32x4*)(gl + lc0 + bj * HALF + n * 4), b4 = *(PG8_LAS const f32x4*)(gl + 256 + lc0 + bj * HALF + n * 4);
                const f32x4 o = (acc[ai][bj][m][n] - mr.x) * mr.y * g4 + b4;
                if (last) *(f32x4*)(out + off + bj * HALF + n * 4) = o;
                else { if (n == 0) { pw.x = cvt_pk_f16(o[0], o[1]); pw.y = cvt_pk_f16(o[2], o[3]); } else { pw.z = cvt_pk_f16(o[0], o[1]); pw.w = cvt_pk_f16(o[2], o[3]); *(u32x4*)(hf + off + bj * HALF) = pw; } } }
            asm volatile("" ::: "memory"); }
    }
};

template <class Epi, class Sched, bool ALIGN_EPI = false, bool SP2 = false>
__device__ __forceinline__ void gemm_phase(PG8_LAS unsigned char* lds, const Gemm g, const Sched& S, const Epi& E) {
    const int tid = opaque_tid(), wid = __builtin_amdgcn_readfirstlane(tid >> 6), lane = tid & 63, wr = wid >> 2, wc = wid & 3, fr = lane & 15, fq = lane >> 4;
    const int K = g.K, nt = K / BK;
    unsigned voffA[2], voffB[2];
#pragma unroll
    for (int i = 0; i < 2; ++i) { int R, C; stage_rc(tid * 16 + i * 8192, R, C); const int Rb = Epi::PERM ? ((R & ~31) + perm32(R & 31)) : R;
        voffA[i] = (unsigned)(R * K + C) * 2u; voffB[i] = (unsigned)(Rb * K + C) * 2u; }
    const size_t kstep = (size_t)(BK * 2);
    const size_t hstep = (size_t)HALF * K * 2;
    const size_t tstep = 2 * hstep;
    const unsigned ldsw = (unsigned)wid * 1024u;
    const int aoff = lds_byte(wr * 64 + fr, fq * 8), boff = lds_byte(wc * 32 + fr, fq * 8);
#define PG8_SA(b, h) (((b) * 2 + (h)) * HTB)
#define PG8_SB(b, h) ((4 + (b) * 2 + (h)) * HTB)
#define PG8_STAGE(bufoff, gbase, voff) do { _Pragma("unroll") for (int _i = 0; _i < 2; ++_i) \
        __builtin_amdgcn_global_load_lds((const unsigned*)((const char*)(gbase) + (voff)[_i]), (PG8_LAS unsigned*)(lds + (bufoff) + ldsw + _i * 8192), 16, 0, 0); } while (0)
#define PG8_LDA(dst, b, h) do { _Pragma("unroll") for (int m = 0; m < 4; ++m) _Pragma("unroll") for (int k = 0; k < 2; ++k) dst[m][k] = *(const PG8_LAS bf16x8*)(lds + PG8_SA(b, h) + aoff + m * 2048 + k * 1024); } while (0)
#define PG8_LDB(dst, b, h) do { _Pragma("unroll") for (int n = 0; n < 2; ++n) _Pragma("unroll") for (int k = 0; k < 2; ++k) dst[n][k] = *(const PG8_LAS bf16x8*)(lds + PG8_SB(b, h) + boff + n * 2048 + k * 1024); } while (0)
#define PG8_MMA(ai, bj, At, Bt) do { __builtin_amdgcn_s_setprio(1); _Pragma("unroll") for (int m = 0; m < 4; ++m) _Pragma("unroll") for (int n = 0; n < 2; ++n) _Pragma("unroll") for (int k = 0; k < 2; ++k) \
        acc[ai][bj][m][n] = mma16<Epi::F16>(Bt[n][k], At[m][k], acc[ai][bj][m][n]); __builtin_amdgcn_s_setprio(0); } while (0)
#define PG8_WAIT_V(n) asm volatile("s_waitcnt vmcnt(" #n ")" ::: "memory")
#define PG8_WAIT_L(n) asm volatile("s_waitcnt lgkmcnt(" #n ")" ::: "memory")
#define PG8_BAR __builtin_amdgcn_s_barrier()
#define PG8_SCHED __builtin_amdgcn_sched_barrier(0)
    Unit cur, nxt; int ui = 0;
    if (!S.next(0, cur)) return;
    f32x4 acc[2][2][4][2];
#pragma unroll
    for (int a = 0; a < 2; ++a)
#pragma unroll
        for (int b = 0; b < 2; ++b)
#pragma unroll
            for (int m = 0; m < 4; ++m)
#pragma unroll
                for (int n = 0; n < 2; ++n) acc[a][b][m][n] = (f32x4){0.f, 0.f, 0.f, 0.f};
    bf16x8 At[4][2], B0[2][2], B1[2][2];
    const char* cA = (const char*)g.A + (size_t)cur.pm * tstep; const char* cB = (const char*)g.Bt + (size_t)cur.pn * tstep;
    S.a_ready(cur);
    if constexpr (SP2) {
        PG8_STAGE(PG8_SB(0, 0), cB, voffB); PG8_STAGE(PG8_SB(0, 1), cB + hstep, voffB); PG8_STAGE(PG8_SA(0, 0), cA, voffA); PG8_STAGE(PG8_SA(0, 1), cA + hstep, voffA);
        if (wr == 1) PG8_BAR;
        PG8_WAIT_V(2); PG8_BAR;
        PG8_STAGE(PG8_SB(1, 0), cB + kstep, voffB); PG8_STAGE(PG8_SA(1, 0), cA + kstep, voffA); PG8_STAGE(PG8_SB(1, 1), cB + hstep + kstep, voffB);
        PG8_WAIT_V(6); PG8_BAR;
    } else {
        PG8_STAGE(PG8_SB(0, 0), cB, voffB); PG8_STAGE(PG8_SA(0, 0), cA, voffA); PG8_STAGE(PG8_SB(0, 1), cB + hstep, voffB); PG8_STAGE(PG8_SA(0, 1), cA + hstep, voffA);
        if (wr == 1) PG8_BAR;
        PG8_WAIT_V(4); PG8_BAR;
        PG8_STAGE(PG8_SB(1, 0), cB + kstep, voffB); PG8_STAGE(PG8_SA(1, 0), cA + kstep, voffA); PG8_STAGE(PG8_SB(1, 1), cB + hstep + kstep, voffB);
        PG8_WAIT_V(6); PG8_BAR;
    }
    for (;;) {
        const bool has_next = S.next(ui + 1, nxt);
        const char* nA = has_next ? (const char*)g.A + (size_t)nxt.pm * tstep : cA; const char* nB = has_next ? (const char*)g.Bt + (size_t)nxt.pn * tstep : cB;
        for (int t = 0; t < nt; t += 2) {
            const bool last = (t == nt - 2);
            const char* a1 = cA + (size_t)(t + 1) * kstep;
            const char* a2 = last ? nA : cA + (size_t)(t + 2) * kstep; const char* b2 = last ? nB : cB + (size_t)(t + 2) * kstep;
            const char* a3 = a2 + kstep; const char* b3 = b2 + kstep;
            if (last && has_next) S.a_ready(nxt);
            if constexpr (SP2) {
            PG8_LDB(B0, 0, 0); PG8_LDB(B1, 0, 1); PG8_SCHED; PG8_LDA(At, 0, 0); PG8_STAGE(PG8_SA(1, 1), a1 + hstep, voffA);
            PG8_WAIT_V(8); PG8_WAIT_L(0); PG8_BAR; PG8_MMA(0, 0, At, B0); PG8_MMA(0, 1, At, B1); PG8_BAR; PG8_SCHED;
            PG8_LDA(At, 0, 1); PG8_STAGE(PG8_SB(0, 0), b2, voffB); PG8_STAGE(PG8_SB(0, 1), b2 + hstep, voffB); PG8_STAGE(PG8_SA(0, 0), a2, voffA);
            PG8_WAIT_V(8); PG8_WAIT_L(0); PG8_BAR; PG8_MMA(1, 0, At, B0); PG8_MMA(1, 1, At, B1); PG8_BAR; PG8_SCHED;
            PG8_LDB(B0, 1, 0); PG8_LDB(B1, 1, 1); PG8_SCHED; PG8_LDA(At, 1, 0); PG8_STAGE(PG8_SA(0, 1), a2 + hstep, voffA);
            PG8_WAIT_V(8); PG8_WAIT_L(0); PG8_BAR; PG8_MMA(0, 0, At, B0); PG8_MMA(0, 1, At, B1); PG8_BAR; PG8_SCHED;
            PG8_LDA(At, 1, 1); PG8_STAGE(PG8_SB(1, 0), b3, voffB); PG8_STAGE(PG8_SB(1, 1), b3 + hstep, voffB); PG8_STAGE(PG8_SA(1, 0), a3, voffA);
            PG8_WAIT_V(8); PG8_WAIT_L(0); PG8_BAR; PG8_MMA(1, 0, At, B0); PG8_MMA(1, 1, At, B1); PG8_BAR; PG8_SCHED;
            } else {
            PG8_LDB(B0, 0, 0); PG8_SCHED; PG8_LDA(At, 0, 0); PG8_STAGE(PG8_SA(1, 1), a1 + hstep, voffA);
            PG8_WAIT_L(8); PG8_BAR; PG8_WAIT_L(0); PG8_MMA(0, 0, At, B0); PG8_BAR; PG8_SCHED;
            PG8_LDB(B1, 0, 1); PG8_STAGE(PG8_SB(0, 0), b2, voffB);
            PG8_BAR; PG8_WAIT_L(0); PG8_MMA(0, 1, At, B1); PG8_BAR;
            PG8_LDA(At, 0, 1); PG8_STAGE(PG8_SA(0, 0), a2, voffA);
            PG8_BAR; PG8_WAIT_L(0); PG8_MMA(1, 0, At, B0); PG8_BAR; PG8_SCHED;
            PG8_STAGE(PG8_SB(0, 1), b2 + hstep, voffB);
            PG8_WAIT_V(6); PG8_BAR; PG8_MMA(1, 1, At, B1); PG8_BAR;
            PG8_LDB(B0, 1, 0); PG8_SCHED; PG8_LDA(At, 1, 0); PG8_STAGE(PG8_SA(0, 1), a2 + hstep, voffA);
            PG8_WAIT_L(8); PG8_BAR; PG8_WAIT_L(0); PG8_MMA(0, 0, At, B0); PG8_BAR; PG8_SCHED;
            PG8_LDB(B1, 1, 1); PG8_STAGE(PG8_SB(1, 0), b3, voffB);
            PG8_BAR; PG8_WAIT_L(0); PG8_MMA(0, 1, At, B1); PG8_BAR;
            PG8_LDA(At, 1, 1); PG8_STAGE(PG8_SA(1, 0), a3, voffA);
            PG8_BAR; PG8_WAIT_L(0); PG8_MMA(1, 0, At, B0); PG8_BAR; PG8_SCHED;
            PG8_STAGE(PG8_SB(1, 1), b3 + hstep, voffB);
            PG8_WAIT_V(6); PG8_BAR; PG8_MMA(1, 1, At, B1); PG8_BAR;
            }
        }
        if constexpr (ALIGN_EPI) { if (wr == 0) PG8_BAR; }
        if constexpr (!Epi::AFTER_DRAIN) { E(acc, cur, wr, wc, fr, fq); S.done(cur); }
        if (!has_next) break;
#pragma unroll
        for (int a = 0; a < 2; ++a)
#pragma unroll
            for (int b = 0; b < 2; ++b)
#pragma unroll
                for (int m = 0; m < 4; ++m)
#pragma unroll
                    for (int n = 0; n < 2; ++n) acc[a][b][m][n] = (f32x4){0.f, 0.f, 0.f, 0.f};
        cur = nxt; cA = nA; cB = nB; ++ui;
        if constexpr (ALIGN_EPI) { if (wr == 1) PG8_BAR; }
    }
    PG8_WAIT_V(0);
    if constexpr (!ALIGN_EPI) { if (wr == 0) PG8_BAR; }
    PG8_BAR;
    if constexpr (Epi::AFTER_DRAIN) { E.fused(acc, cur, wr, wc, fr, fq, lds, wid, lane); S.done(cur); }
#undef PG8_SA
#undef PG8_SB
#undef PG8_STAGE
#undef PG8_LDA
#undef PG8_LDB
#undef PG8_MMA
#undef PG8_WAIT_V
#undef PG8_WAIT_L
#undef PG8_BAR
#undef PG8_SCHED
}
}

constexpr int NB = 32, SEQ = 2048, DM = 1024, NTOK = NB * SEQ;
constexpr int NH = 16, HD = 64, GW = 2048, GG = 8, GC = 128, FF = 2816, FF2 = 5632, DEPTH = 4;
constexpr float LN_EPS = 1e-5f;
constexpr float DN_ALPHA = 1.681792830507429f;
constexpr int HALF_TOK = NTOK / 2;

constexpr size_t MiB = 1u << 20;
constexpr size_t WS_ATTN_IN = 0, WS_ATTN_OUT = 12 * MiB, WS_GMLP_IN = 16 * MiB, WS_GMLP_OUT = 32 * MiB, WS_FFN_UP = 40 * MiB, WS_FFN_DOWN = 84 * MiB, WS_WS = 106 * MiB;
constexpr size_t WS_MS = 110 * MiB;
constexpr size_t WS_CTL = 107 * MiB;
constexpr size_t WS_ST = 108 * MiB;
constexpr size_t WS_HB = 112 * MiB;
constexpr size_t WS_R = 240 * MiB;
constexpr size_t WS_Q = WS_R, WS_K = WS_R + 128 * MiB, WS_V = WS_R + 256 * MiB, WS_O = WS_R + 384 * MiB;
constexpr size_t WS_ZZ = WS_R, WS_GT = WS_R + 512 * MiB;
constexpr size_t WS_HT = WS_R + 400 * MiB;
constexpr size_t WS_G = WS_R;
constexpr size_t WS_VST = 1008 * MiB;
constexpr size_t WS_END = 1012 * MiB;

constexpr int LDS_BYTES = 147456;

#define LAS __attribute__((address_space(3)))
typedef unsigned short bf16;
typedef unsigned u32x4 __attribute__((ext_vector_type(4)));
typedef unsigned u32x2 __attribute__((ext_vector_type(2)));
typedef float f32x4 __attribute__((ext_vector_type(4)));
typedef float f32x16 __attribute__((ext_vector_type(16)));
typedef short bf16x8 __attribute__((ext_vector_type(8)));
typedef short s16x4 __attribute__((ext_vector_type(4)));

__device__ __forceinline__ unsigned pk2(float lo, float hi) { return pg8::cvt_pk_bf16(lo, hi); }
__device__ __forceinline__ float bflo(unsigned w) { return __uint_as_float(w << 16); }
__device__ __forceinline__ float bfhi(unsigned w) { return __uint_as_float(w & 0xffff0000u); }
__device__ __forceinline__ float wave_sum(float v) {
#pragma unroll
    for (int o = 1; o < 64; o <<= 1) v += __shfl_xor(v, o);
    return v;
}
__device__ __forceinline__ s16x4 vtr(LAS const unsigned char* p) { return __builtin_bit_cast(s16x4, __builtin_amdgcn_ds_read_tr16_b64_v4i16((LAS s16x4*)p)); }

__device__ __forceinline__ void transpose_item(const float* W, int K, int N, bf16* WT, int perm, int f16, LAS float* scr, int item, int lane) {
    const int nblk = N / 32, kb = item / nblk, nb = item % nblk, k0 = 64 * kb, n0 = 32 * nb;
    int r0 = n0;
    if (perm) { const int bj = n0 / FF, f0 = n0 - bj * FF; r0 = (f0 >> 7) * 256 + bj * 128 + (f0 & 127); }
#pragma unroll 8
    for (int i = 0; i < 32; ++i) { const int kk = 2 * i + (lane >> 5); scr[kk * 33 + (lane & 31)] = W[(size_t)(k0 + kk) * N + n0 + (lane & 31)]; }
    asm volatile("s_waitcnt lgkmcnt(0)" ::: "memory");
    const int c = lane & 7;
#pragma unroll
    for (int j = 0; j < 4; ++j) { const int n = (lane >> 3) + 8 * j; const LAS float* s = scr + (8 * c) * 33 + n;
        u32x4 o; if (f16) { o.x = pg8::cvt_pk_f16(s[0 * 33], s[1 * 33]); o.y = pg8::cvt_pk_f16(s[2 * 33], s[3 * 33]); o.z = pg8::cvt_pk_f16(s[4 * 33], s[5 * 33]); o.w = pg8::cvt_pk_f16(s[6 * 33], s[7 * 33]); }
        else { o.x = pk2(s[0 * 33], s[1 * 33]); o.y = pk2(s[2 * 33], s[3 * 33]); o.z = pk2(s[4 * 33], s[5 * 33]); o.w = pk2(s[6 * 33], s[7 * 33]); }
        *(u32x4*)(WT + (size_t)(r0 + n) * K + k0 + 8 * c) = o; }
    asm volatile("s_waitcnt lgkmcnt(0)" ::: "memory");
}

struct Args { const float* in[17]; float* out; unsigned char* ws; };

__device__ __forceinline__ void ln_apply(const float* Y, float* Yo, bf16* HB, const float* st, float* ms, const float* gam, const float* bet, int gw, int ngw, int lane) {
    f32x4 g4[4], b4[4];
#pragma unroll
    for (int j = 0; j < 4; ++j) { g4[j] = ((const f32x4*)gam)[lane + 64 * j]; b4[j] = ((const f32x4*)bet)[lane + 64 * j]; }
    for (int m = gw; m < NTOK; m += ngw) {
        const f32x4* yr = (const f32x4*)(Y + (size_t)m * DM) + lane;
        f32x4 v[4];
#pragma unroll
        for (int j = 0; j < 4; ++j) v[j] = yr[64 * j];
        const f32x4 a = *(const f32x4*)(st + (size_t)m * 8), b = *(const f32x4*)(st + (size_t)m * 8 + 4);
        const float s = (a[0] + a[2]) + (b[0] + b[2]), q = (a[1] + a[3]) + (b[1] + b[3]);
        const float mean = s * (1.f / DM), rstd = 1.f / sqrtf(q * (1.f / DM) - mean * mean + LN_EPS);
        if (lane == 0) { ms[(size_t)m * 2] = mean; ms[(size_t)m * 2 + 1] = rstd; }
        u32x2* o8 = (u32x2*)(HB + (size_t)m * DM) + lane;
#pragma unroll
        for (int j = 0; j < 4; ++j) { const f32x4 o = (v[j] - mean) * rstd * g4[j] + b4[j]; if (Yo) ((f32x4*)(Yo + (size_t)m * DM) + lane)[64 * j] = o; u32x2 w; w.x = pk2(o.x, o.y); w.y = pk2(o.z, o.w); o8[64 * j] = w; }
    }
}

__device__ __forceinline__ void ffn_fix_phase(const float* HT, bf16* Gb, const float* cw, const float* cb, int cu, int G, int tid) {
    const int sub = tid >> 6, r = (tid >> 5) & 1, f = (tid & 31) * 4;
    for (int up = cu * 8 + sub; up < 224 * 22; up += G * 8) {
        const int pn = up % 22, pq = up / 22, pm = pq + pq / 7 + 1;
        const float* hc = HT + (size_t)(pm * 22 + pn) * 1024; const float* hp = HT + (size_t)((pm - 1) * 22 + pn) * 1024;
        f32x4 y[2];
#pragma unroll
        for (int hh = 0; hh < 2; ++hh) { const int c = hh * 128 + f; const int F = hh * FF + 128 * pn + f;
            const f32x4 h0 = *(const f32x4*)(hc + c), h1 = *(const f32x4*)(hc + 256 + c), t0 = *(const f32x4*)(hp + 512 + c), t1 = *(const f32x4*)(hp + 768 + c);
            const f32x4 x0 = r ? h1 : h0, xm1 = r ? h0 : t1, xm2 = r ? t1 : t0;
            y[hh] = *(const f32x4*)(cb + F) + *(const f32x4*)(cw + F) * xm2 + *(const f32x4*)(cw + FF2 + F) * xm1 + *(const f32x4*)(cw + 2 * FF2 + F) * x0; }
        float v[4];
#pragma unroll
        for (int e = 0; e < 4; ++e) v[e] = y[0][e] * __builtin_amdgcn_rcpf(1.0f + __builtin_amdgcn_exp2f(-1.4426950408889634f * y[0][e])) * y[1][e];
        u32x2 w; w.x = pk2(v[0], v[1]); w.y = pk2(v[2], v[3]);
        *(u32x2*)(Gb + (size_t)(pm * 256 + r) * FF + 128 * pn + f) = w;
    }
}

__device__ __forceinline__ void attn_phase(LAS unsigned char* lds, const bf16* Q, const bf16* K, const bf16* V, bf16* O, int cu, int G, int rev) {
    const int tid = opaque_tid(), lane = tid & 63, wid = __builtin_amdgcn_readfirstlane(tid >> 6), q32 = lane & 31, hi = lane >> 5, li = lane & 15;
    LAS unsigned char* Ks = lds + wid * 10752;
    LAS unsigned char* Vs = Ks + 4608;
    const int lkey = lane >> 3, lch = lane & 7;
    const float LOG2E = 1.4426950408889634f;
    for (int k = 0; k < 16; ++k) {
        const int idx = cu * 8 + wid + 2048 * (k & 3), b = 4 * (idx & 7) + (rev ? 3 - (k >> 2) : (k >> 2)), h = (idx >> 3) & 15, qb = idx >> 7;
        const size_t rowbase = (size_t)b * SEQ;
        const int q0w = qb * 32;
        bf16x8 qf[4];
        { const bf16* qp = Q + (rowbase + q0w + q32) * DM + h * HD + hi * 8;
#pragma unroll
          for (int ks = 0; ks < 4; ++ks) qf[ks] = *(const bf16x8*)(qp + ks * 16); }
        f32x16 o0, o1;
#pragma unroll
        for (int r = 0; r < 16; ++r) { o0[r] = 0.f; o1[r] = 0.f; }
        float R = 0.f;
        const bf16* kp = K + (rowbase + lkey) * DM + h * HD + lch * 8;
        const bf16* vp = V + (rowbase + lkey) * DM + h * HD + lch * 8;
        u32x4 kr[4], vr[4];
#pragma unroll
        for (int jj = 0; jj < 4; ++jj) { kr[jj] = *(const u32x4*)(kp + (size_t)(q0w + 8 * jj) * DM); vr[jj] = *(const u32x4*)(vp + (size_t)(q0w + 8 * jj) * DM); }
        for (int key0 = q0w; key0 >= 0; key0 -= 32) {
#pragma unroll
            for (int jj = 0; jj < 4; ++jj) { *(LAS u32x4*)(Ks + (lkey + 8 * jj) * 144 + lch * 16) = kr[jj]; *(LAS u32x4*)(Vs + (lkey + 8 * jj) * 192 + lch * 16) = vr[jj]; }
            asm volatile("s_waitcnt lgkmcnt(0)" ::: "memory");
            if (key0 >= 32) {
#pragma unroll
                for (int jj = 0; jj < 4; ++jj) { kr[jj] = *(const u32x4*)(kp + (size_t)(key0 - 32 + 8 * jj) * DM); vr[jj] = *(const u32x4*)(vp + (size_t)(key0 - 32 + 8 * jj) * DM); } }
            const bool diag = (key0 == q0w);
            f32x16 s;
#pragma unroll
            for (int r = 0; r < 16; ++r) s[r] = 0.f;
#pragma unroll
            for (int ks = 0; ks < 4; ++ks) { const bf16x8 kf = *(LAS const bf16x8*)(Ks + q32 * 144 + (16 * ks + 8 * hi) * 2);
                s = __builtin_amdgcn_mfma_f32_32x32x16_bf16(kf, qf[ks], s, 0, 0, 0); }
            float zs[16], l1[16];
#pragma unroll
            for (int r = 0; r < 16; ++r) { const float z = s[r] * LOG2E; const float e = __builtin_amdgcn_exp2f(-__builtin_fabsf(z)); const float t = __builtin_amdgcn_logf(1.0f + e);
                float l = -(__builtin_fmaxf(z, 0.f) + t);
                if (diag) { const int kl = 8 * (r >> 2) + 4 * hi + (r & 3); if (kl >= q32) l = 0.f; }
                zs[r] = z; l1[r] = l; }
            float G0[4], G1[4];
#pragma unroll
            for (int j = 0; j < 4; ++j) { const float gs = (l1[4 * j] + l1[4 * j + 1]) + (l1[4 * j + 2] + l1[4 * j + 3]);
                auto rr = __builtin_amdgcn_permlane32_swap(__float_as_uint(gs), __float_as_uint(gs), false, false); G0[j] = __uint_as_float(rr[0]); G1[j] = __uint_as_float(rr[1]); }
            float p[16]; float run = R;
#pragma unroll
            for (int j = 3; j >= 0; --j) { float sfx = run + (hi == 0 ? G1[j] : 0.f);
#pragma unroll
                for (int e = 3; e >= 0; --e) { const int r = 4 * j + e; float val = __builtin_amdgcn_exp2f(l1[r] + zs[r] + sfx);
                    if (diag) { const int kl = 8 * j + 4 * hi + e; if (kl >= q32) val = 0.f; }
                    p[r] = val; sfx += l1[r]; }
                run += G0[j] + G1[j]; }
            R = run;
#pragma unroll
            for (int ks2 = 0; ks2 < 2; ++ks2) {
                u32x4 pw; pw.x = pk2(p[8 * ks2], p[8 * ks2 + 1]); pw.y = pk2(p[8 * ks2 + 2], p[8 * ks2 + 3]); pw.z = pk2(p[8 * ks2 + 4], p[8 * ks2 + 5]); pw.w = pk2(p[8 * ks2 + 6], p[8 * ks2 + 7]);
                const bf16x8 pb = __builtin_bit_cast(bf16x8, pw);
#pragma unroll
                for (int dh = 0; dh < 2; ++dh) {
                    LAS const unsigned char* va = Vs + (16 * ks2 + 4 * hi + (li >> 2)) * 192 + (32 * dh + 16 * ((lane >> 4) & 1) + 4 * (li & 3)) * 2;
                    const s16x4 lo = vtr(va), hi4 = vtr(va + 8 * 192);
                    const bf16x8 vf = (bf16x8){lo[0], lo[1], lo[2], lo[3], hi4[0], hi4[1], hi4[2], hi4[3]};
                    if (dh == 0) o0 = __builtin_amdgcn_mfma_f32_32x32x16_bf16(vf, pb, o0, 0, 0, 0);
                    else         o1 = __builtin_amdgcn_mfma_f32_32x32x16_bf16(vf, pb, o1, 0, 0, 0);
                }
            }
            asm volatile("s_waitcnt lgkmcnt(0)" ::: "memory");
            if (__all(R < -150.0f)) break;
        }
#pragma unroll
        for (int j = 0; j < 4; ++j) { u32x2 w0, w1; w0.x = pk2(o0[4 * j], o0[4 * j + 1]); w0.y = pk2(o0[4 * j + 2], o0[4 * j + 3]); w1.x = pk2(o1[4 * j], o1[4 * j + 1]); w1.y = pk2(o1[4 * j + 2], o1[4 * j + 3]);
            *(LAS u32x2*)(Ks + q32 * 144 + (8 * j + 4 * hi) * 2) = w0; *(LAS u32x2*)(Ks + q32 * 144 + (32 + 8 * j + 4 * hi) * 2) = w1; }
        asm volatile("s_waitcnt lgkmcnt(0)" ::: "memory");
#pragma unroll
        for (int i = 0; i < 4; ++i) { const int row = lkey + 8 * i; const u32x4 v = *(LAS const u32x4*)(Ks + row * 144 + lch * 16);
            *(u32x4*)(O + (rowbase + q0w + row) * DM + h * HD + lch * 8) = v; }
        asm volatile("s_waitcnt lgkmcnt(0)" ::: "memory");
    }
    __syncthreads();
}

__device__ __forceinline__ void spatial_phase(LAS unsigned char* lds, const bf16* ZZ, bf16* GT, const bf16* Wc, const float* bs, const float* gam, const float* bet, const float* VST, int cu, int G, int rev) {
    const int tid = opaque_tid(), lane = tid & 63, wid = __builtin_amdgcn_readfirstlane(tid >> 6), fr = lane & 15, kg = lane >> 4;
    LAS float* st = (LAS float*)(lds + 69632);
    const int wr = wid >> 2, wc = wid & 3;
    for (int k = 0; k < 2; ++k) {
        const int cls = 2 * k + (cu >> 7); const int chunk = 64 * (cu & 7) + 16 * (rev ? 3 - cls : cls) + ((cu >> 3) & 15);
        const size_t row0 = (size_t)chunk * GC;
        __syncthreads();
        { const int row = tid >> 2, part = tid & 3;
          const f32x4 a = *(const f32x4*)(VST + (row0 + row) * 16 + part * 4);
          float sm = a[0] + a[2], sq = a[1] + a[3];
          sm += __shfl_xor(sm, 1); sm += __shfl_xor(sm, 2); sq += __shfl_xor(sq, 1); sq += __shfl_xor(sq, 2);
          if (part == 0) { const float mean = sm * (1.f / GW); st[2 * row] = mean; st[2 * row + 1] = 1.f / sqrtf(sq * (1.f / GW) - mean * mean + LN_EPS); } }
        const int c8 = tid & 31, srow = tid >> 5;
        LAS unsigned char* const wl = lds + 72704;
        const int wt = tid >> 2, wq = tid & 3;
        u32x4 nv[8], nw[4];
#pragma unroll
        for (int it = 0; it < 8; ++it) nv[it] = *(const u32x4*)(ZZ + (row0 + it * 16 + srow) * 4096 + GW + c8 * 8);
#pragma unroll
        for (int q = 0; q < 4; ++q) nw[q] = *(const u32x4*)(Wc + (size_t)wt * GC + wq * 32 + q * 8);
        for (int g = 0; g < GG; ++g) {
            __syncthreads();
            { const float* gp = gam + g * 256 + c8 * 8; const float* bp = bet + g * 256 + c8 * 8;
              const f32x4 ga = *(const f32x4*)gp, gb = *(const f32x4*)(gp + 4), ba = *(const f32x4*)bp, bb = *(const f32x4*)(bp + 4);
#pragma unroll
              for (int q = 0; q < 4; ++q) *(LAS u32x4*)(wl + wt * 272 + wq * 64 + q * 16) = nw[q];
#pragma unroll
              for (int it = 0; it < 8; ++it) { const int s = it * 16 + srow;
                  const u32x4 w = nv[it];
                  const float mean = st[2 * s], rstd = st[2 * s + 1];
                  u32x4 o;
                  o.x = pk2((bflo(w.x) - mean) * rstd * ga.x + ba.x, (bfhi(w.x) - mean) * rstd * ga.y + ba.y);
                  o.y = pk2((bflo(w.y) - mean) * rstd * ga.z + ba.z, (bfhi(w.y) - mean) * rstd * ga.w + ba.w);
                  o.z = pk2((bflo(w.z) - mean) * rstd * gb.x + bb.x, (bfhi(w.z) - mean) * rstd * gb.y + bb.y);
                  o.w = pk2((bflo(w.w) - mean) * rstd * gb.z + bb.z, (bfhi(w.w) - mean) * rstd * gb.w + bb.w);
                  *(LAS u32x4*)(lds + s * 544 + c8 * 16) = o; } }
            __syncthreads();
            if (g + 1 < GG) {
#pragma unroll
                for (int it = 0; it < 8; ++it) nv[it] = *(const u32x4*)(ZZ + (row0 + it * 16 + srow) * 4096 + GW + (g + 1) * 256 + c8 * 8);
#pragma unroll
                for (int q = 0; q < 4; ++q) nw[q] = *(const u32x4*)(Wc + (size_t)(g + 1) * GC * GC + (size_t)wt * GC + wq * 32 + q * 8); }
            u32x2 uu[4][4];
#pragma unroll
            for (int tb = 0; tb < 4; ++tb)
#pragma unroll
                for (int cb = 0; cb < 4; ++cb) uu[tb][cb] = *(const u32x2*)(ZZ + (row0 + 64 * wr + 16 * tb + fr) * 4096 + g * 256 + 64 * wc + 16 * cb + 4 * kg);
            f32x4 acc[4][4];
#pragma unroll
            for (int a = 0; a < 4; ++a)
#pragma unroll
                for (int b2 = 0; b2 < 4; ++b2) acc[a][b2] = (f32x4){0.f, 0.f, 0.f, 0.f};
#pragma unroll
            for (int ks = 0; ks < 4; ++ks) {
                if (32 * ks <= 64 * wr + 63) {
                    bf16x8 X[4], Y[4];
#pragma unroll
                    for (int tb = 0; tb < 4; ++tb) { LAS const unsigned char* wp = wl + (64 * wr + 16 * tb + fr) * 272 + (32 * ks + 4 * kg) * 2;
                        const u32x2 a = *(LAS const u32x2*)wp, b2 = *(LAS const u32x2*)(wp + 32); const u32x4 w = (u32x4){a.x, a.y, b2.x, b2.y}; Y[tb] = __builtin_bit_cast(bf16x8, w); }
#pragma unroll
                    for (int cb = 0; cb < 4; ++cb) { LAS const unsigned char* xa = lds + (32 * ks + 4 * kg + (fr >> 2)) * 544 + (64 * wc + 16 * cb + 4 * (fr & 3)) * 2;
                        const s16x4 lo = vtr(xa), hi4 = vtr(xa + 16 * 544);
                        X[cb] = (bf16x8){lo[0], lo[1], lo[2], lo[3], hi4[0], hi4[1], hi4[2], hi4[3]}; }
#pragma unroll
                    for (int tb = 0; tb < 4; ++tb)
#pragma unroll
                        for (int cb = 0; cb < 4; ++cb) acc[tb][cb] = __builtin_amdgcn_mfma_f32_16x16x32_bf16(X[cb], Y[tb], acc[tb][cb], 0, 0, 0);
                }
            }
#pragma unroll
            for (int tb = 0; tb < 4; ++tb) { const int t = 64 * wr + 16 * tb + fr; const float bsv = bs[g * GC + t];
#pragma unroll
                for (int cb = 0; cb < 4; ++cb) { const int c = g * 256 + 64 * wc + 16 * cb + 4 * kg;
                    const u32x2 u = uu[tb][cb];
                    u32x2 o; o.x = pk2(bflo(u.x) * (acc[tb][cb][0] + bsv), bfhi(u.x) * (acc[tb][cb][1] + bsv)); o.y = pk2(bflo(u.y) * (acc[tb][cb][2] + bsv), bfhi(u.y) * (acc[tb][cb][3] + bsv));
                    *(u32x2*)(GT + (row0 + t) * GW + c) = o; } }
        }
    }
}

#ifndef PROBE
#define PROBE 0
#endif
#ifndef G2_REV
#define G2_REV 1
#endif
__device__ __forceinline__ void gbar(unsigned* ctr, unsigned target) {
    asm volatile("s_waitcnt vmcnt(0)" ::: "memory");
    __syncthreads();
    if (threadIdx.x == 0) {
        __builtin_amdgcn_fence(__ATOMIC_RELEASE, "agent");
        asm volatile("s_waitcnt vmcnt(0)" ::: "memory");
        __hip_atomic_fetch_add(ctr, 1u, __ATOMIC_RELAXED, __HIP_MEMORY_SCOPE_AGENT);
        while (__hip_atomic_load(ctr, __ATOMIC_RELAXED, __HIP_MEMORY_SCOPE_AGENT) < target) __builtin_amdgcn_s_sleep(1);
        __builtin_amdgcn_fence(__ATOMIC_ACQUIRE, "agent");
        asm volatile("s_waitcnt vmcnt(0)" ::: "memory");
    }
    __syncthreads();
}
#define GSYNC() do { bar_target += (unsigned)G; gbar(bar_ctr, bar_target); if (PROBE == 7) { bar_target += (unsigned)G; gbar(bar_ctr, bar_target); } } while (0)
__global__ void __launch_bounds__(512, 2) fwd_kernel(Args args) {
    extern __shared__ __attribute__((aligned(16))) unsigned char lds_raw[];
    cg::grid_group grid = cg::this_grid();
    LAS unsigned char* lds = (LAS unsigned char*)lds_raw;
    const int G = gridDim.x, cu = blockIdx.x, ngw = G * 8;
    unsigned char* ws = args.ws;
    const float* x = args.in[0];
    float* out = args.out;
    bf16* HB = (bf16*)(ws + WS_HB);
    unsigned* bar_ctr = (unsigned*)(ws + WS_CTL); unsigned bar_target = 0u;
    if (cu == 0 && threadIdx.x < 8) __hip_atomic_store((unsigned*)(ws + WS_CTL + 8192) + 64 * threadIdx.x, 0u, __ATOMIC_RELAXED, __HIP_MEMORY_SCOPE_AGENT);
    if (cu == 0 && threadIdx.x == 0) __hip_atomic_store(bar_ctr, 0u, __ATOMIC_RELAXED, __HIP_MEMORY_SCOPE_AGENT);

    for (int rep = 0; rep < (PROBE == 8 ? 2 : 1); ++rep) {
        const int tid = opaque_tid(), lane = tid & 63, wave = __builtin_amdgcn_readfirstlane(tid >> 6), gw = cu * 8 + wave;
        LAS float* scr = (LAS float*)(lds + wave * 16384);
        for (int mat = 0; mat < 16; ++mat) {
            const float* W; bf16* WT; int K, N, perm = 0;
            if (mat < 2)       { W = args.in[1] + (size_t)mat * DM * 3072;        WT = (bf16*)(ws + WS_ATTN_IN) + (size_t)mat * 3072 * DM;        K = DM; N = 3072; }
            else if (mat < 4)  { W = args.in[2] + (size_t)(mat - 2) * DM * DM;    WT = (bf16*)(ws + WS_ATTN_OUT) + (size_t)(mat - 2) * DM * DM;   K = DM; N = DM; }
            else if (mat < 6)  { W = args.in[3] + (size_t)(mat - 4) * DM * 4096;  WT = (bf16*)(ws + WS_GMLP_IN) + (size_t)(mat - 4) * 4096 * DM;  K = DM; N = 4096; }
            else if (mat < 8)  { W = args.in[8] + (size_t)(mat - 6) * GW * DM;    WT = (bf16*)(ws + WS_GMLP_OUT) + (size_t)(mat - 6) * DM * GW;   K = GW; N = DM; }
            else if (mat < 12) { W = args.in[9] + (size_t)(mat - 8) * DM * FF2;   WT = (bf16*)(ws + WS_FFN_UP) + (size_t)(mat - 8) * FF2 * DM;    K = DM; N = FF2; perm = 1; }
            else               { W = args.in[12] + (size_t)(mat - 12) * FF * DM;  WT = (bf16*)(ws + WS_FFN_DOWN) + (size_t)(mat - 12) * DM * FF;  K = FF; N = DM; }
            const int nitems = (K / 64) * (N / 32);
            for (int it = gw; it < nitems; it += ngw) transpose_item(W, K, N, WT, perm, (mat < 2 || mat == 4 || mat == 5 || (mat >= 8 && mat < 12)) ? 1 : 0, scr, it, lane);
        }
        { const float* wsrc = args.in[6]; bf16* wd = (bf16*)(ws + WS_WS);
          for (int i = cu * 512 + tid; i < 2 * GG * GC * GC; i += G * 512) { const int s = i & 127, t = (i >> 7) & 127; const float v = (s <= t) ? wsrc[i] : 0.f; wd[i] = (bf16)(pk2(v, v) & 0xffffu); } }
        for (int m = gw; m < NTOK; m += ngw) {
            const f32x4* xr = (const f32x4*)(x + (size_t)m * DM) + lane; u32x2* o8 = (u32x2*)(HB + (size_t)m * DM) + lane;
#pragma unroll
            for (int j = 0; j < 4; ++j) { const f32x4 v = xr[64 * j]; u32x2 w; w.x = pg8::cvt_pk_f16(v.x, v.y); w.y = pg8::cvt_pk_f16(v.z, v.w); o8[64 * j] = w; }
        }
    }
    grid.sync();

    int dir = 0;
    for (int layer = 0; layer < DEPTH; ++layer) {
        const int j = layer >> 1, mixer = layer & 1;
        for (int step = 0; step < 2; ++step) {
            if (step == 0) {
                pg8::Gemm g; pg8::EpiBf16 E;
                if (mixer == 0) { g = pg8::Gemm{HB, (const bf16*)(ws + WS_ATTN_IN) + (size_t)j * 3072 * DM, NTOK, 3072, DM};
                    E = pg8::EpiBf16{(bf16*)(ws + WS_Q), DM, 0, DM, (size_t)NTOK * DM, 0.125f, nullptr, nullptr}; }
                else { g = pg8::Gemm{HB, (const bf16*)(ws + WS_GMLP_IN) + (size_t)j * 4096 * DM, NTOK, 4096, DM};
                    E = pg8::EpiBf16{(bf16*)(ws + WS_ZZ), 4096, 1, 0, 0, 1.f, (float*)(ws + WS_VST), (LAS float*)(lds + 131072)}; }
                pg8::StaticOrder S; S.rev = dir; dir ^= 1; S.init(g.M, g.N, G, cu);
                for (int rep = 0; rep < (PROBE == 1 ? 2 : 1); ++rep)
                pg8::gemm_phase<pg8::EpiBf16, pg8::StaticOrder, true, true>(lds, g, S, E);
            } else {
                pg8::Gemm g{HB, (const bf16*)(ws + WS_FFN_UP) + (size_t)layer * FF2 * DM, NTOK, FF2, DM};
                pg8::EpiConv E{(bf16*)(ws + WS_G), args.in[10] + (size_t)layer * 3 * FF2, args.in[11] + (size_t)layer * FF2, lds + 131072, FF, FF2, FF, (float*)(ws + WS_HT)};
                pg8::StaticOrder S; S.rev = dir; dir ^= 1; S.init(g.M, g.N, G, cu);
                for (int rep = 0; rep < (PROBE == 4 ? 2 : 1); ++rep)
                pg8::gemm_phase<pg8::EpiConv, pg8::StaticOrder, true, true>(lds, g, S, E);
                GSYNC();
                ffn_fix_phase((const float*)(ws + WS_HT), (bf16*)(ws + WS_G), args.in[10] + (size_t)layer * 3 * FF2, args.in[11] + (size_t)layer * FF2, cu, G, opaque_tid());
            }
            GSYNC();
            if (step == 0) {
                for (int rep = 0; rep < (((PROBE == 2 && mixer == 0) || (PROBE == 3 && mixer == 1)) ? 2 : 1); ++rep)
                if (mixer == 0) attn_phase(lds, (const bf16*)(ws + WS_Q), (const bf16*)(ws + WS_K), (const bf16*)(ws + WS_V), (bf16*)(ws + WS_O), cu, G, dir);
                else spatial_phase(lds, (const bf16*)(ws + WS_ZZ), (bf16*)(ws + WS_GT), (const bf16*)(ws + WS_WS) + (size_t)j * GG * GC * GC, args.in[7] + j * GG * GC, args.in[4] + j * GW, args.in[5] + j * GW, (const float*)(ws + WS_VST), cu, G, dir); dir ^= 1;
                GSYNC();
            }
            const int lnidx = 2 * layer + step;
            {
                pg8::Gemm g;
                if (step == 0 && mixer == 0) g = pg8::Gemm{(const bf16*)(ws + WS_O), (const bf16*)(ws + WS_ATTN_OUT) + (size_t)j * DM * DM, NTOK, DM, DM};
                else if (step == 0) g = pg8::Gemm{(const bf16*)(ws + WS_GT), (const bf16*)(ws + WS_GMLP_OUT) + (size_t)j * DM * GW, NTOK, DM, GW};
                else g = pg8::Gemm{(const bf16*)(ws + WS_G), (const bf16*)(ws + WS_FFN_DOWN) + (size_t)layer * DM * FF, NTOK, DM, FF};
                const int pl = (lnidx - 1) >> 1;
                const float* pgam = lnidx == 0 ? nullptr : (((lnidx - 1) & 1) ? args.in[15] : args.in[13]) + pl * DM;
                const float* pbet = lnidx == 0 ? nullptr : (((lnidx - 1) & 1) ? args.in[16] : args.in[14]) + pl * DM;
                const float* cgam = (step == 0 ? args.in[13] : args.in[15]) + layer * DM;
                const float* cbet = (step == 0 ? args.in[14] : args.in[16]) + layer * DM;
                const bool lastln = lnidx == 2 * DEPTH - 1;
                pg8::EpiResLn E{(const unsigned short*)HB, 0, out, (float*)(ws + WS_ST), cgam, cbet, HB, (unsigned short*)HB,
                                (unsigned*)(ws + WS_CTL + 8192), 128u * (unsigned)lnidx, lastln ? 1 : 0, lds + 131072, dir};
                pg8::StaticOrder S; S.rev = dir; dir ^= 1; S.init(g.M, g.N, G, cu);
                if (PROBE == 9) { pg8::EpiBf16 E0{(bf16*)(ws + WS_R + (step == 1 ? 512 * MiB : 0)), DM, 0, 0, 0, 1.f};
                    pg8::gemm_phase<pg8::EpiBf16, pg8::StaticOrder, true, true>(lds, g, S, E0); }
                pg8::gemm_phase<pg8::EpiResLn, pg8::StaticOrder, true, true>(lds, g, S, E);
            }
            if (lnidx != 2 * DEPTH - 1) GSYNC();
        }
    }
}

extern "C" void kernel_launch(void* const* d_in, const int* in_sizes, int n_in, void* d_out, int out_size, void* d_ws, size_t ws_size, hipStream_t stream) {
    static int grid = 0;
    if (grid == 0) {
        if (n_in != 17 || out_size != NTOK * DM || ws_size < WS_END) { fprintf(stderr, "kernel_launch: unexpected shapes (n_in %d, out %d, ws %zu)\n", n_in, out_size, ws_size); grid = -1; return; }
        int dev = 0, cus = 0, per_cu = 0;
        hipGetDevice(&dev);
        hipDeviceGetAttribute(&cus, hipDeviceAttributeMultiprocessorCount, dev);
        if (hipFuncSetAttribute((const void*)fwd_kernel, hipFuncAttributeMaxDynamicSharedMemorySize, LDS_BYTES) != hipSuccess) { fprintf(stderr, "kernel_launch: hipFuncSetAttribute failed\n"); grid = -1; return; }
        if (hipOccupancyMaxActiveBlocksPerMultiprocessor(&per_cu, (const void*)fwd_kernel, 512, LDS_BYTES) != hipSuccess || per_cu < 1) { fprintf(stderr, "kernel_launch: occupancy query says %d\n", per_cu); per_cu = 1; }
        (void)hipGetLastError();
        grid = cus * per_cu;
        fprintf(stderr, "kernel_launch: grid %d (cus %d x %d)\n", grid, cus, per_cu);
        if (grid != 256) { fprintf(stderr, "kernel_launch: the fused LayerNorm epilogue's group barrier is laid out for a 256-workgroup grid; nothing launched\n"); grid = -1; return; }
    }
    if (grid < 0) return;
    Args a{};
    for (int i = 0; i < 17; ++i) a.in[i] = (const float*)d_in[i];
    a.out = (float*)d_out; a.ws = (unsigned char*)d_ws;
    void* kargs[] = {&a};
    hipError_t e = hipLaunchCooperativeKernel((const void*)fwd_kernel, dim3(grid), dim3(512), kargs, LDS_BYTES, stream);
    if (e != hipSuccess) fprintf(stderr, "cooperative launch failed: %s (grid %d)\n", hipGetErrorString(e), grid);
}
```

```cpp
#include <hip/hip_runtime.h>
#include <hip/hip_cooperative_groups.h>
#include <cstdio>
#include <cstdint>
namespace cg = cooperative_groups;
__device__ __forceinline__ int opaque_tid() { int t = threadIdx.x; asm volatile("" : "+v"(t)); return t; }
namespace pg8 {
#define PG8_LAS __attribute__((address_space(3)))
typedef unsigned short bf16_t;
typedef short bf16x8 __attribute__((ext_vector_type(8)));
typedef float f32x4 __attribute__((ext_vector_type(4)));
typedef unsigned u32x4 __attribute__((ext_vector_type(4)));
constexpr int BM = 256, BK = 64, HALF = 128, HTB = HALF * BK * 2  , STAGE_BYTES = 8 * HTB, NXCD = 8, WGM = 8;

__host__ __device__ __forceinline__ int lds_byte(int r, int c) { const int st = (r >> 4) * 2 + (c >> 5), rr = r & 15, cc = c & 31, ob = rr * 64 + cc * 2; return st * 1024 + (ob ^ (((ob >> 9) & 1) << 5)); }
__host__ __device__ __forceinline__ void stage_rc(int b, int& R, int& C) { const int st = b / 1024, sb = b % 1024, swz = sb ^ (((sb >> 9) & 1) << 5); R = (st >> 1) * 16 + swz / 64; C = (st & 1) * 32 + (swz % 64) / 2; }
__host__ __device__ __forceinline__ int perm32(int rho) { const int n = rho >> 4, i = rho & 15; return 8 * (i >> 2) + 4 * n + (i & 3); }

struct Unit { int pm, pn; };
struct Gemm { const bf16_t* A; const bf16_t* Bt; int M, N, K; };

struct StaticOrder {
    int nM, nN, nwg, G, c, rev = 0;
    __host__ __device__ void init(int M, int N, int G_, int c_) { nM = M / BM; nN = N / BM; nwg = nM * nN; G = G_; c = c_; }
    __host__ __device__ bool next(int i, Unit& u) const {
        if ((long)i * G + c >= nwg) return false;
        const long L = (long)(rev ? (nwg / G - 1 - i) : i) * G + c;
        int wgid = (int)L; { const int q = nwg / NXCD, r = nwg % NXCD, xcd = wgid % NXCD, off = wgid / NXCD; wgid = (xcd < r ? xcd * (q + 1) : r * (q + 1) + (xcd - r) * q) + off; }
        const int nig = WGM * nN, gid = wgid / nig, fm = gid * WGM, gsz = (nM - fm) < WGM ? (nM - fm) : WGM;
        u.pm = fm + ((wgid % nig) % gsz); u.pn = (wgid % nig) / gsz; return true;
    }
    __device__ __forceinline__ void a_ready(const Unit&) const {}
    __device__ __forceinline__ void done(const Unit&) const {}
};
__device__ __forceinline__ unsigned cvt_pk_bf16(float lo, float hi) { unsigned r; asm volatile("v_cvt_pk_bf16_f32 %0, %1, %2" : "=v"(r) : "v"(lo), "v"(hi)); return r; }
typedef float f32x2 __attribute__((ext_vector_type(2)));
typedef _Float16 f16x8 __attribute__((ext_vector_type(8)));
template <bool F16> __device__ __forceinline__ f32x4 mma16(bf16x8 a, bf16x8 b, f32x4 c) {
    if constexpr (F16) return __builtin_amdgcn_mfma_f32_16x16x32_f16(__builtin_bit_cast(f16x8, a), __builtin_bit_cast(f16x8, b), c, 0, 0, 0);
    else return __builtin_amdgcn_mfma_f32_16x16x32_bf16(a, b, c, 0, 0, 0);
}
__device__ __forceinline__ unsigned cvt_pk_f16(float lo, float hi) { typedef _Float16 h2 __attribute__((ext_vector_type(2))); const h2 v = {(_Float16)lo, (_Float16)hi}; return __builtin_bit_cast(unsigned, v); }
typedef unsigned u32x2e __attribute__((ext_vector_type(2)));
__device__ __forceinline__ float gelu_tanh(float x) {
    const float t = x * (-2.302208198f + (-0.1029432397f) * x * x);
    return x * __builtin_amdgcn_rcpf(1.0f + __builtin_amdgcn_exp2f(t));
}
struct EpiBf16 {
    static constexpr bool PERM = true, AFTER_DRAIN = false, F16 = true;
    bf16_t* O; int ldc; int act; int split_cols; size_t split_stride; float scale0;
    float* vst; PG8_LAS float* sl;
    __device__ __forceinline__ void operator()(const f32x4 (&acc)[2][2][4][2], const Unit& u, int wr, int wc, int fr, int fq) const {
        const int row0 = u.pm * BM + wr * 64 + fr; int colt = u.pn * BM; bf16_t* base = O;
        float sc = 1.f; if (split_cols) { const int t = colt / split_cols; base += (size_t)t * split_stride; colt -= t * split_cols; if (t == 0) sc = scale0; }
        const int col0 = colt + wc * 32 + 8 * fq;
        const bool dost = vst != nullptr && u.pn >= 8;
#pragma unroll
        for (int ai = 0; ai < 2; ++ai)
#pragma unroll
            for (int m = 0; m < 4; ++m) { bf16_t* rowp = base + (size_t)(row0 + ai * HALF + m * 16) * ldc + col0; float rs = 0.f, rq = 0.f;
#pragma unroll
                for (int bj = 0; bj < 2; ++bj) { f32x4 v0 = acc[ai][bj][m][0], v1 = acc[ai][bj][m][1];
                    if (act) { v0 = (f32x4){gelu_tanh(v0[0]), gelu_tanh(v0[1]), gelu_tanh(v0[2]), gelu_tanh(v0[3])};
                               v1 = (f32x4){gelu_tanh(v1[0]), gelu_tanh(v1[1]), gelu_tanh(v1[2]), gelu_tanh(v1[3])}; }
                    if (dost) { rs += ((v0[0] + v0[1]) + (v0[2] + v0[3])) + ((v1[0] + v1[1]) + (v1[2] + v1[3]));
                                rq += ((v0[0] * v0[0] + v0[1] * v0[1]) + (v0[2] * v0[2] + v0[3] * v0[3])) + ((v1[0] * v1[0] + v1[1] * v1[1]) + (v1[2] * v1[2] + v1[3] * v1[3])); }
                    v0 = v0 * sc; v1 = v1 * sc; u32x4 w; w.x = cvt_pk_bf16(v0[0], v0[1]); w.y = cvt_pk_bf16(v0[2], v0[3]); w.z = cvt_pk_bf16(v1[0], v1[1]); w.w = cvt_pk_bf16(v1[2], v1[3]);
                    *(u32x4*)(rowp + bj * HALF) = w; }
                if (dost) { rs += __shfl_xor(rs, 16); rs += __shfl_xor(rs, 32); rq += __shfl_xor(rq, 16); rq += __shfl_xor(rq, 32);
                    const int lrow = ai * HALF + wr * 64 + m * 16 + fr; if (fq == 0) { sl[(lrow * 4 + wc) * 2] = rs; sl[(lrow * 4 + wc) * 2 + 1] = rq; } } }
        if (dost) {
            asm volatile("s_waitcnt lgkmcnt(0)" ::: "memory"); __builtin_amdgcn_s_barrier(); asm volatile("" ::: "memory");
            const int t = opaque_tid();
            if (t < 256) { const f32x4 a = *(PG8_LAS const f32x4*)(sl + t * 8), b = *(PG8_LAS const f32x4*)(sl + t * 8 + 4);
                typedef float f32x2v __attribute__((ext_vector_type(2)));
                *(f32x2v*)(vst + ((size_t)u.pm * BM + t) * 16 + (u.pn - 8) * 2) = (f32x2v){(a[0] + a[2]) + (b[0] + b[2]), (a[1] + a[3]) + (b[1] + b[3])}; }
        }
    }
};
struct EpiRes {
    static constexpr bool PERM = false, AFTER_DRAIN = false, F16 = false;
    const float* base; float* out; int ldc; float alpha;
    __device__ __forceinline__ void operator()(const f32x4 (&acc)[2][2][4][2], const Unit& u, int wr, int wc, int fr, int fq) const {
        const int col0 = u.pn * BM + wc * 32 + 4 * fq;
#pragma unroll
        for (int ai = 0; ai < 2; ++ai)
#pragma unroll
            for (int m = 0; m < 4; ++m) { const size_t off = (size_t)(u.pm * BM + ai * HALF + wr * 64 + m * 16 + fr) * ldc + col0;
#pragma unroll
                for (int bj = 0; bj < 2; ++bj)
#pragma unroll
                    for (int n = 0; n < 2; ++n) { const f32x4 bs = *(const f32x4*)(base + off + bj * HALF + n * 16);
                        *(f32x4*)(out + off + bj * HALF + n * 16) = bs * alpha + acc[ai][bj][m][n]; }
                asm volatile("" ::: "memory"); }
    }
};

template <int CTRL> __device__ __forceinline__ float dpp_mov(float old, float src) {
    return __builtin_bit_cast(float, __builtin_amdgcn_update_dpp(__builtin_bit_cast(int, old), __builtin_bit_cast(int, src), CTRL, 0xf, 0xf, false));
}
struct SeqOrder {
    int G, c;
    __device__ bool next(int i, Unit& u) const { if (i >= 22) return false; int it, step;
        if (i < 16) { it = c + G * (i >> 3); step = i & 7; } else { const int v = 6 * c + (i - 16); it = 512 + (v >> 3); step = v & 7; }
        u.pn = it >> 5; u.pm = 8 * (it & 31) + step; return true; }
    __device__ __forceinline__ void a_ready(const Unit&) const {}
    __device__ __forceinline__ void done(const Unit&) const {}
};
struct EpiConv {
    static constexpr bool PERM = true, AFTER_DRAIN = false, F16 = true;
    bf16_t* O; const float* cw; const float* cb; PG8_LAS unsigned char* hl; int ldo, ncol2, nfeat; float* ht;
    __device__ __forceinline__ void operator()(const f32x4 (&acc)[2][2][4][2], const Unit& u, int wr, int wc, int fr, int fq) const {
        const int lcol = wc * 32 + 8 * fq;
        { const int t = opaque_tid();
          if (t < 256) { const int p = t >> 5, ch = t & 31, pp = p & 3; const float* src = (pp < 3 ? cw + pp * ncol2 : cb) + (p >> 2) * nfeat + 128 * u.pn + 4 * ch;
              *(PG8_LAS f32x4*)(hl + 10240 + (p * 128 + 4 * ch) * 4) = *(const f32x4*)src; } }
        float* const htu = ht + (size_t)(u.pm * 22 + u.pn) * 1024;
        if (fr >= 14) {
#pragma unroll
            for (int ai = 0; ai < 2; ++ai) { const int k = 2 * ai + wr;
                if (k < 3) { PG8_LAS unsigned char* hp = hl + k * 2048 + (fr - 14) * 1024 + lcol * 4;
#pragma unroll
                    for (int bj = 0; bj < 2; ++bj)
#pragma unroll
                        for (int n = 0; n < 2; ++n) *(PG8_LAS f32x4*)(hp + bj * 512 + n * 16) = acc[ai][bj][3][n]; }
                else {
#pragma unroll
                    for (int bj = 0; bj < 2; ++bj)
#pragma unroll
                        for (int n = 0; n < 2; ++n) *(f32x4*)(htu + (2 + fr - 14) * 256 + bj * 128 + lcol + 4 * n) = acc[ai][bj][3][n]; } }
        }
        if (wr == 0 && fr < 2) {
#pragma unroll
            for (int bj = 0; bj < 2; ++bj)
#pragma unroll
                for (int n = 0; n < 2; ++n) *(f32x4*)(htu + fr * 256 + bj * 128 + lcol + 4 * n) = acc[0][bj][0][n];
        }
        asm volatile("s_waitcnt lgkmcnt(0)" ::: "memory"); __builtin_amdgcn_s_barrier(); asm volatile("" ::: "memory");
        u32x2e keep[2][4];
#pragma unroll
        for (int n = 0; n < 2; ++n) {
            const int f = 128 * u.pn + lcol + 4 * n;
            PG8_LAS const float* const wl = (PG8_LAS const float*)(hl + 10240) + lcol + 4 * n;
            const f32x4 wg0 = *(PG8_LAS const f32x4*)(wl), wg1 = *(PG8_LAS const f32x4*)(wl + 128), wg2 = *(PG8_LAS const f32x4*)(wl + 256), bg = *(PG8_LAS const f32x4*)(wl + 384);
            const f32x4 wv0 = *(PG8_LAS const f32x4*)(wl + 512), wv1 = *(PG8_LAS const f32x4*)(wl + 640), wv2 = *(PG8_LAS const f32x4*)(wl + 768), bv = *(PG8_LAS const f32x4*)(wl + 896);
#pragma unroll
            for (int ai = 0; ai < 2; ++ai) {
                const int k = 2 * ai + wr;
                const int rslot = k > 0 ? k - 1 : 0;
                PG8_LAS const unsigned char* hp = hl + rslot * 2048 + (lcol + 4 * n) * 4;
                f32x4 hg2 = *(PG8_LAS const f32x4*)hp, hv2 = *(PG8_LAS const f32x4*)(hp + 512), hg1 = *(PG8_LAS const f32x4*)(hp + 1024), hv1 = *(PG8_LAS const f32x4*)(hp + 1536);
                if (k == 0) { hg2 = (f32x4){0.f, 0.f, 0.f, 0.f}; hv2 = hg2; hg1 = hg2; hv1 = hg2; }
#pragma unroll
                for (int m = 0; m < 4; ++m) {
                    float r[4];
#pragma unroll
                    for (int e = 0; e < 4; ++e) {
                        const float xg = acc[ai][0][m][n][e], xv = acc[ai][1][m][n][e];
                        float o1g, o2g, o1v, o2v;
                        if (m == 0) { o1g = hg1[e]; o2g = fr == 0 ? hg2[e] : hg1[e]; o1v = hv1[e]; o2v = fr == 0 ? hv2[e] : hv1[e]; }
                        else { const float pgv = acc[ai][0][m > 0 ? m - 1 : 0][n][e], pvv = acc[ai][1][m > 0 ? m - 1 : 0][n][e];
                            o1g = dpp_mov<0x121>(pgv, pgv); o2g = dpp_mov<0x122>(pgv, pgv); o1v = dpp_mov<0x121>(pvv, pvv); o2v = dpp_mov<0x122>(pvv, pvv); }
                        const float p1g = dpp_mov<0x111>(o1g, xg), p2g = dpp_mov<0x112>(o2g, xg), p1v = dpp_mov<0x111>(o1v, xv), p2v = dpp_mov<0x112>(o2v, xv);
                        const float yg = bg[e] + wg2[e] * xg + wg1[e] * p1g + wg0[e] * p2g;
                        const float yv = bv[e] + wv2[e] * xv + wv1[e] * p1v + wv0[e] * p2v;
                        r[e] = yg * __builtin_amdgcn_rcpf(1.0f + __builtin_amdgcn_exp2f(-1.4426950408889634f * yg)) * yv;
                    }
                    u32x2e w; w.x = cvt_pk_bf16(r[0], r[1]); w.y = cvt_pk_bf16(r[2], r[3]);
                    if (n == 0) keep[ai][m] = w;
                    else { const u32x4 w4 = (u32x4){keep[ai][m].x, keep[ai][m].y, w.x, w.y}; *(u32x4*)(O + (size_t)(u.pm * BM + ai * HALF + wr * 64 + m * 16 + fr) * ldo + f - 4) = w4; }
                }
            }
        }
    }
};

struct EpiResLn {
    static constexpr bool PERM = true, AFTER_DRAIN = false, F16 = false;
    const unsigned short* base16; int isbf; float* out; float* st; const float* cg; const float* cbeta; bf16_t* hb; unsigned short* hf; unsigned* gcnt; unsigned tgt0; int last; PG8_LAS unsigned char* xl; int rev;
    static constexpr int ldc = 1024; static constexpr float alpha = 1.681792830507429f, eps = 1e-5f;
    typedef _Float16 h16x2 __attribute__((ext_vector_type(2)));
    __device__ __forceinline__ f32x4 dec(u32x2e w) const {
        if (isbf) return (f32x4){__uint_as_float(w.x << 16), __uint_as_float(w.x & 0xffff0000u), __uint_as_float(w.y << 16), __uint_as_float(w.y & 0xffff0000u)};
        const float f0 = (float)__builtin_bit_cast(_Float16, (unsigned short)(w.x & 0xffffu)), f1 = (float)__builtin_bit_cast(_Float16, (unsigned short)(w.x >> 16));
        const float f2 = (float)__builtin_bit_cast(_Float16, (unsigned short)(w.y & 0xffffu)), f3 = (float)__builtin_bit_cast(_Float16, (unsigned short)(w.y >> 16));
        return (f32x4){f0, f1, f2, f3}; }
    __device__ __forceinline__ void operator()(f32x4 (&acc)[2][2][4][2], const Unit& u, int wr, int wc, int fr, int fq) const {
        asm volatile("" : "+v"(fr), "+v"(fq));
        typedef float f32x2s __attribute__((ext_vector_type(2)));
        PG8_LAS float* const sl = (PG8_LAS float*)xl; PG8_LAS float* const gl = (PG8_LAS float*)(xl + 8192);
        const int col0 = u.pn * BM + wc * 32 + 8 * fq, lc0 = wc * 32 + 8 * fq;
        { const int t = opaque_tid();
          if (t < 128) { const int which = t >> 6, c4 = 4 * (t & 63); *(PG8_LAS f32x4*)(gl + which * 256 + c4) = *(const f32x4*)((which ? cbeta : cg) + u.pn * BM + c4); } }
        u32x4 nb[2];
        { const size_t off = ((size_t)u.pm * BM + wr * 64 + fr) * ldc + col0;
#pragma unroll
          for (int bj = 0; bj < 2; ++bj) nb[bj] = *(const u32x4*)(base16 + off + bj * HALF); }
#pragma unroll
        for (int i = 0; i < 8; ++i) { const int ai = i >> 2, m = i & 3; const int lrow = ai * HALF + wr * 64 + m * 16 + fr;
            u32x4 cur[2];
#pragma unroll
            for (int bj = 0; bj < 2; ++bj) cur[bj] = nb[bj];
            if (i < 7) { const int lr2 = ((i + 1) >> 2) * HALF + wr * 64 + ((i + 1) & 3) * 16 + fr; const size_t off2 = ((size_t)u.pm * BM + lr2) * ldc + col0;
#pragma unroll
                for (int bj = 0; bj < 2; ++bj) nb[bj] = *(const u32x4*)(base16 + off2 + bj * HALF); }
            asm volatile("" ::: "memory");
            float rsum = 0.f, rq = 0.f;
#pragma unroll
            for (int q = 0; q < 4; ++q) { const int bj = q >> 1, n = q & 1;
                const f32x4 y = dec(n ? (u32x2e){cur[bj].z, cur[bj].w} : (u32x2e){cur[bj].x, cur[bj].y}) * alpha + acc[ai][bj][m][n];
                acc[ai][bj][m][n] = y;
                rsum += (y[0] + y[1]) + (y[2] + y[3]); rq += (y[0] * y[0] + y[1] * y[1]) + (y[2] * y[2] + y[3] * y[3]); }
            rsum += __shfl_xor(rsum, 16); rsum += __shfl_xor(rsum, 32); rq += __shfl_xor(rq, 16); rq += __shfl_xor(rq, 32);
            if (fq == 0) { sl[(lrow * 4 + wc) * 2] = rsum; sl[(lrow * 4 + wc) * 2 + 1] = rq; }
            asm volatile("" ::: "memory"); }
        asm volatile("s_waitcnt lgkmcnt(0)" ::: "memory"); __builtin_amdgcn_s_barrier(); asm volatile("" ::: "memory");
        const int t = opaque_tid();
        if (t < 256) { const f32x4 a = *(PG8_LAS const f32x4*)(sl + t * 8), b = *(PG8_LAS const f32x4*)(sl + t * 8 + 4);
            const float ssum = (a[0] + a[2]) + (b[0] + b[2]), ssq = (a[1] + a[3]) + (b[1] + b[3]);
            __hip_atomic_store((unsigned long long*)(st + ((size_t)u.pm * BM + t) * 8 + u.pn * 2), ((unsigned long long)__float_as_uint(ssq) << 32) | __float_as_uint(ssum), __ATOMIC_RELAXED, __HIP_MEMORY_SCOPE_AGENT); }
        asm volatile("s_waitcnt vmcnt(0) lgkmcnt(0)" ::: "memory"); __builtin_amdgcn_s_barrier(); asm volatile("" ::: "memory");
        if (t == 0) {
            unsigned* const ctr = gcnt + 64 * (blockIdx.x & 7); const unsigned target = tgt0 + 32u * (unsigned)((rev ? 3 - ((u.pm >> 3) & 3) : ((u.pm >> 3) & 3)) + 1);
            __hip_atomic_fetch_add(ctr, 1u, __ATOMIC_RELAXED, __HIP_MEMORY_SCOPE_AGENT);
            while (__hip_atomic_load(ctr, __ATOMIC_RELAXED, __HIP_MEMORY_SCOPE_AGENT) < target) __builtin_amdgcn_s_sleep(1);
        }
        __builtin_amdgcn_s_barrier(); asm volatile("" ::: "memory");
        if (t < 256) { const size_t row = (size_t)u.pm * BM + t;
            float s = 0.f, q = 0.f;
#pragma unroll
            for (int k4 = 0; k4 < 4; ++k4) { const unsigned long long w = __hip_atomic_load((const unsigned long long*)(st + row * 8 + 2 * k4), __ATOMIC_RELAXED, __HIP_MEMORY_SCOPE_AGENT);
                s += __uint_as_float((unsigned)w); q += __uint_as_float((unsigned)(w >> 32)); }
            const float mean = s * (1.f / 1024.f), rstd = 1.f / sqrtf(q * (1.f / 1024.f) - mean * mean + eps);
            *(PG8_LAS f32x2s*)(sl + 2 * t) = (f32x2s){mean, rstd}; }
        asm volatile("s_waitcnt lgkmcnt(0)" ::: "memory"); __builtin_amdgcn_s_barrier(); asm volatile("" ::: "memory");
#pragma unroll
        for (int i = 0; i < 8; ++i) { const int ai = i >> 2, m = i & 3; const int lrow = ai * HALF + wr * 64 + m * 16 + fr; const size_t off = ((size_t)u.pm * BM + lrow) * ldc + col0;
            const f32x2s mr = *(PG8_LAS const f32x2s*)(sl + 2 * lrow); u32x4 pw;
#pragma unroll
            for (int q = 0; q < 4; ++q) { const int bj = q >> 1, n = q & 1;
                const f32x4 g4 = *(PG8_LAS const f32x4*)(gl + lc0 + bj * HALF + n * 4), b4 = *(PG8_LAS const f32x4*)(gl + 256 + lc0 + bj * HALF + n * 4);
                const f32x4 o = (acc[ai][bj][m][n] - mr.x) * mr.y * g4 + b4;
                if (last) *(f32x4*)(out + off + bj * HALF + n * 4) = o;
                else { if (n == 0) { pw.x = cvt_pk_f16(o[0], o[1]); pw.y = cvt_pk_f16(o[2], o[3]); } else { pw.z = cvt_pk_f16(o[0], o[1]); pw.w = cvt_pk_f16(o[2], o[3]); *(u32x4*)(hf + off + bj * HALF) = pw; } } }
            asm volatile("" ::: "memory"); }
    }
};

template <class Epi, class Sched, bool ALIGN_EPI = false, bool SP2 = false>
__device__ __forceinline__ void gemm_phase(PG8_LAS unsigned char* lds, const Gemm g, const Sched& S, const Epi& E) {
    const int tid = opaque_tid(), wid = __builtin_amdgcn_readfirstlane(tid >> 6), lane = tid & 63, wr = wid >> 2, wc = wid & 3, fr = lane & 15, fq = lane >> 4;
    const int K = g.K, nt = K / BK;
    unsigned voffA[2], voffB[2];
#pragma unroll
    for (int i = 0; i < 2; ++i) { int R, C; stage_rc(tid * 16 + i * 8192, R, C); const int Rb = Epi::PERM ? ((R & ~31) + perm32(R & 31)) : R;
        voffA[i] = (unsigned)(R * K + C) * 2u; voffB[i] = (unsigned)(Rb * K + C) * 2u; }
    const size_t kstep = (size_t)(BK * 2);
    const size_t hstep = (size_t)HALF * K * 2;
    const size_t tstep = 2 * hstep;
    const unsigned ldsw = (unsigned)wid * 1024u;
    const int aoff = lds_byte(wr * 64 + fr, fq * 8), boff = lds_byte(wc * 32 + fr, fq * 8);
#define PG8_SA(b, h) (((b) * 2 + (h)) * HTB)
#define PG8_SB(b, h) ((4 + (b) * 2 + (h)) * HTB)
#define PG8_STAGE(bufoff, gbase, voff) do { _Pragma("unroll") for (int _i = 0; _i < 2; ++_i) \
        __builtin_amdgcn_global_load_lds((const unsigned*)((const char*)(gbase) + (voff)[_i]), (PG8_LAS unsigned*)(lds + (bufoff) + ldsw + _i * 8192), 16, 0, 0); } while (0)
#define PG8_LDA(dst, b, h) do { _Pragma("unroll") for (int m = 0; m < 4; ++m) _Pragma("unroll") for (int k = 0; k < 2; ++k) dst[m][k] = *(const PG8_LAS bf16x8*)(lds + PG8_SA(b, h) + aoff + m * 2048 + k * 1024); } while (0)
#define PG8_LDB(dst, b, h) do { _Pragma("unroll") for (int n = 0; n < 2; ++n) _Pragma("unroll") for (int k = 0; k < 2; ++k) dst[n][k] = *(const PG8_LAS bf16x8*)(lds + PG8_SB(b, h) + boff + n * 2048 + k * 1024); } while (0)
#define PG8_MMA(ai, bj, At, Bt) do { __builtin_amdgcn_s_setprio(1); _Pragma("unroll") for (int m = 0; m < 4; ++m) _Pragma("unroll") for (int n = 0; n < 2; ++n) _Pragma("unroll") for (int k = 0; k < 2; ++k) \
        acc[ai][bj][m][n] = mma16<Epi::F16>(Bt[n][k], At[m][k], acc[ai][bj][m][n]); __builtin_amdgcn_s_setprio(0); } while (0)
#define PG8_WAIT_V(n) asm volatile("s_waitcnt vmcnt(" #n ")" ::: "memory")
#define PG8_WAIT_L(n) asm volatile("s_waitcnt lgkmcnt(" #n ")" ::: "memory")
#define PG8_BAR __builtin_amdgcn_s_barrier()
#define PG8_SCHED __builtin_amdgcn_sched_barrier(0)
    Unit cur, nxt; int ui = 0;
    if (!S.next(0, cur)) return;
    f32x4 acc[2][2][4][2];
#pragma unroll
    for (int a = 0; a < 2; ++a)
#pragma unroll
        for (int b = 0; b < 2; ++b)
#pragma unroll
            for (int m = 0; m < 4; ++m)
#pragma unroll
                for (int n = 0; n < 2; ++n) acc[a][b][m][n] = (f32x4){0.f, 0.f, 0.f, 0.f};
    bf16x8 At[4][2], B0[2][2], B1[2][2];
    const char* cA = (const char*)g.A + (size_t)cur.pm * tstep; const char* cB = (const char*)g.Bt + (size_t)cur.pn * tstep;
    S.a_ready(cur);
    if constexpr (SP2) {
        PG8_STAGE(PG8_SB(0, 0), cB, voffB); PG8_STAGE(PG8_SB(0, 1), cB + hstep, voffB); PG8_STAGE(PG8_SA(0, 0), cA, voffA); PG8_STAGE(PG8_SA(0, 1), cA + hstep, voffA);
        if (wr == 1) PG8_BAR;
        PG8_WAIT_V(2); PG8_BAR;
        PG8_STAGE(PG8_SB(1, 0), cB + kstep, voffB); PG8_STAGE(PG8_SA(1, 0), cA + kstep, voffA); PG8_STAGE(PG8_SB(1, 1), cB + hstep + kstep, voffB);
        PG8_WAIT_V(6); PG8_BAR;
    } else {
        PG8_STAGE(PG8_SB(0, 0), cB, voffB); PG8_STAGE(PG8_SA(0, 0), cA, voffA); PG8_STAGE(PG8_SB(0, 1), cB + hstep, voffB); PG8_STAGE(PG8_SA(0, 1), cA + hstep, voffA);
        if (wr == 1) PG8_BAR;
        PG8_WAIT_V(4); PG8_BAR;
        PG8_STAGE(PG8_SB(1, 0), cB + kstep, voffB); PG8_STAGE(PG8_SA(1, 0), cA + kstep, voffA); PG8_STAGE(PG8_SB(1, 1), cB + hstep + kstep, voffB);
        PG8_WAIT_V(6); PG8_BAR;
    }
    for (;;) {
        const bool has_next = S.next(ui + 1, nxt);
        const char* nA = has_next ? (const char*)g.A + (size_t)nxt.pm * tstep : cA; const char* nB = has_next ? (const char*)g.Bt + (size_t)nxt.pn * tstep : cB;
        for (int t = 0; t < nt; t += 2) {
            const bool last = (t == nt - 2);
            const char* a1 = cA + (size_t)(t + 1) * kstep;
            const char* a2 = last ? nA : cA + (size_t)(t + 2) * kstep; const char* b2 = last ? nB : cB + (size_t)(t + 2) * kstep;
            const char* a3 = a2 + kstep; const char* b3 = b2 + kstep;
            if (last && has_next) S.a_ready(nxt);
            if constexpr (SP2) {
            PG8_LDB(B0, 0, 0); PG8_LDB(B1, 0, 1); PG8_SCHED; PG8_LDA(At, 0, 0); PG8_STAGE(PG8_SA(1, 1), a1 + hstep, voffA);
            PG8_WAIT_V(8); PG8_WAIT_L(0); PG8_BAR; PG8_MMA(0, 0, At, B0); PG8_MMA(0, 1, At, B1); PG8_BAR; PG8_SCHED;
            PG8_LDA(At, 0, 1); PG8_STAGE(PG8_SB(0, 0), b2, voffB); PG8_STAGE(PG8_SB(0, 1), b2 + hstep, voffB); PG8_STAGE(PG8_SA(0, 0), a2, voffA);
            PG8_WAIT_V(8); PG8_WAIT_L(0); PG8_BAR; PG8_MMA(1, 0, At, B0); PG8_MMA(1, 1, At, B1); PG8_BAR; PG8_SCHED;
            PG8_LDB(B0, 1, 0); PG8_LDB(B1, 1, 1); PG8_SCHED; PG8_LDA(At, 1, 0); PG8_STAGE(PG8_SA(0, 1), a2 + hstep, voffA);
            PG8_WAIT_V(8); PG8_WAIT_L(0); PG8_BAR; PG8_MMA(0, 0, At, B0); PG8_MMA(0, 1, At, B1); PG8_BAR; PG8_SCHED;
            PG8_LDA(At, 1, 1); PG8_STAGE(PG8_SB(1, 0), b3, voffB); PG8_STAGE(PG8_SB(1, 1), b3 + hstep, voffB); PG8_STAGE(PG8_SA(1, 0), a3, voffA);
            PG8_WAIT_V(8); PG8_WAIT_L(0); PG8_BAR; PG8_MMA(1, 0, At, B0); PG8_MMA(1, 1, At, B1); PG8_BAR; PG8_SCHED;
            } else {
            PG8_LDB(B0, 0, 0); PG8_SCHED; PG8_LDA(At, 0, 0); PG8_STAGE(PG8_SA(1, 1), a1 + hstep, voffA);
            PG8_WAIT_L(8); PG8_BAR; PG8_WAIT_L(0); PG8_MMA(0, 0, At, B0); PG8_BAR; PG8_SCHED;
            PG8_LDB(B1, 0, 1); PG8_STAGE(PG8_SB(0, 0), b2, voffB);
            PG8_BAR; PG8_WAIT_L(0); PG8_MMA(0, 1, At, B1); PG8_BAR;
            PG8_LDA(At, 0, 1); PG8_STAGE(PG8_SA(0, 0), a2, voffA);
            PG8_BAR; PG8_WAIT_L(0); PG8_MMA(1, 0, At, B0); PG8_BAR; PG8_SCHED;
            PG8_STAGE(PG8_SB(0, 1), b2 + hstep, voffB);
            PG8_WAIT_V(6); PG8_BAR; PG8_MMA(1, 1, At, B1); PG8_BAR;
            PG8_LDB(B0, 1, 0); PG8_SCHED; PG8_LDA(At, 1, 0); PG8_STAGE(PG8_SA(0, 1), a2 + hstep, voffA);
            PG8_WAIT_L(8); PG8_BAR; PG8_WAIT_L(0); PG8_MMA(0, 0, At, B0); PG8_BAR; PG8_SCHED;
            PG8_LDB(B1, 1, 1); PG8_STAGE(PG8_SB(1, 0), b3, voffB);
            PG8_BAR; PG8_WAIT_L(0); PG8_MMA(0, 1, At, B1); PG8_BAR;
            PG8_LDA(At, 1, 1); PG8_STAGE(PG8_SA(1, 0), a3, voffA);
            PG8_BAR; PG8_WAIT_L(0); PG8_MMA(1, 0, At, B0); PG8_BAR; PG8_SCHED;
            PG8_STAGE(PG8_SB(1, 1), b3 + hstep, voffB);
            PG8_WAIT_V(6); PG8_BAR; PG8_MMA(1, 1, At, B1); PG8_BAR;
            }
        }
        if constexpr (ALIGN_EPI) { if (wr == 0) PG8_BAR; }
        if constexpr (!Epi::AFTER_DRAIN) { E(acc, cur, wr, wc, fr, fq); S.done(cur); }
        if (!has_next) break;
#pragma unroll
        for (int a = 0; a < 2; ++a)
#pragma unroll
            for (int b = 0; b < 2; ++b)
#pragma unroll
                for (int m = 0; m < 4; ++m)
#pragma unroll
                    for (int n = 0; n < 2; ++n) acc[a][b][m][n] = (f32x4){0.f, 0.f, 0.f, 0.f};
        cur = nxt; cA = nA; cB = nB; ++ui;
        if constexpr (ALIGN_EPI) { if (wr == 1) PG8_BAR; }
    }
    PG8_WAIT_V(0);
    if constexpr (!ALIGN_EPI) { if (wr == 0) PG8_BAR; }
    PG8_BAR;
    if constexpr (Epi::AFTER_DRAIN) { E.fused(acc, cur, wr, wc, fr, fq, lds, wid, lane); S.done(cur); }
#undef PG8_SA
#undef PG8_SB
#undef PG8_STAGE
#undef PG8_LDA
#undef PG8_LDB
#undef PG8_MMA
#undef PG8_WAIT_V
#undef PG8_WAIT_L
#undef PG8_BAR
#undef PG8_SCHED
}
}

constexpr int NB = 32, SEQ = 2048, DM = 1024, NTOK = NB * SEQ;
constexpr int NH = 16, HD = 64, GW = 2048, GG = 8, GC = 128, FF = 2816, FF2 = 5632, DEPTH = 4;
constexpr float LN_EPS = 1e-5f;
constexpr float DN_ALPHA = 1.681792830507429f;
constexpr int HALF_TOK = NTOK / 2;

constexpr size_t MiB = 1u << 20;
constexpr size_t WS_ATTN_IN = 0, WS_ATTN_OUT = 12 * MiB, WS_GMLP_IN = 16 * MiB, WS_GMLP_OUT = 32 * MiB, WS_FFN_UP = 40 * MiB, WS_FFN_DOWN = 84 * MiB, WS_WS = 106 * MiB;
constexpr size_t WS_MS = 110 * MiB;
constexpr size_t WS_CTL = 107 * MiB;
constexpr size_t WS_ST = 108 * MiB;
constexpr size_t WS_HB = 112 * MiB;
constexpr size_t WS_R = 240 * MiB;
constexpr size_t WS_Q = WS_R, WS_K = WS_R + 128 * MiB, WS_V = WS_R + 256 * MiB, WS_O = WS_R + 384 * MiB;
constexpr size_t WS_ZZ = WS_R, WS_GT = WS_R + 512 * MiB;
constexpr size_t WS_HT = WS_R + 400 * MiB;
constexpr size_t WS_G = WS_R;
constexpr size_t WS_VST = 1008 * MiB;
constexpr size_t WS_END = 1012 * MiB;

constexpr int LDS_BYTES = 147456;

#define LAS __attribute__((address_space(3)))
typedef unsigned short bf16;
typedef unsigned u32x4 __attribute__((ext_vector_type(4)));
typedef unsigned u32x2 __attribute__((ext_vector_type(2)));
typedef float f32x4 __attribute__((ext_vector_type(4)));
typedef float f32x16 __attribute__((ext_vector_type(16)));
typedef short bf16x8 __attribute__((ext_vector_type(8)));
typedef short s16x4 __attribute__((ext_vector_type(4)));

__device__ __forceinline__ unsigned pk2(float lo, float hi) { return pg8::cvt_pk_bf16(lo, hi); }
__device__ __forceinline__ float bflo(unsigned w) { return __uint_as_float(w << 16); }
__device__ __forceinline__ float bfhi(unsigned w) { return __uint_as_float(w & 0xffff0000u); }
__device__ __forceinline__ float wave_sum(float v) {
#pragma unroll
    for (int o = 1; o < 64; o <<= 1) v += __shfl_xor(v, o);
    return v;
}
__device__ __forceinline__ s16x4 vtr(LAS const unsigned char* p) { return __builtin_bit_cast(s16x4, __builtin_amdgcn_ds_read_tr16_b64_v4i16((LAS s16x4*)p)); }

__device__ __forceinline__ void transpose_item(const float* W, int K, int N, bf16* WT, int perm, int f16, LAS float* scr, int item, int lane) {
    const int nblk = N / 32, kb = item / nblk, nb = item % nblk, k0 = 64 * kb, n0 = 32 * nb;
    int r0 = n0;
    if (perm) { const int bj = n0 / FF, f0 = n0 - bj * FF; r0 = (f0 >> 7) * 256 + bj * 128 + (f0 & 127); }
#pragma unroll 8
    for (int i = 0; i < 32; ++i) { const int kk = 2 * i + (lane >> 5); scr[kk * 33 + (lane & 31)] = W[(size_t)(k0 + kk) * N + n0 + (lane & 31)]; }
    asm volatile("s_waitcnt lgkmcnt(0)" ::: "memory");
    const int c = lane & 7;
#pragma unroll
    for (int j = 0; j < 4; ++j) { const int n = (lane >> 3) + 8 * j; const LAS float* s = scr + (8 * c) * 33 + n;
        u32x4 o; if (f16) { o.x = pg8::cvt_pk_f16(s[0 * 33], s[1 * 33]); o.y = pg8::cvt_pk_f16(s[2 * 33], s[3 * 33]); o.z = pg8::cvt_pk_f16(s[4 * 33], s[5 * 33]); o.w = pg8::cvt_pk_f16(s[6 * 33], s[7 * 33]); }
        else { o.x = pk2(s[0 * 33], s[1 * 33]); o.y = pk2(s[2 * 33], s[3 * 33]); o.z = pk2(s[4 * 33], s[5 * 33]); o.w = pk2(s[6 * 33], s[7 * 33]); }
        *(u32x4*)(WT + (size_t)(r0 + n) * K + k0 + 8 * c) = o; }
    asm volatile("s_waitcnt lgkmcnt(0)" ::: "memory");
}

struct Args { const float* in[17]; float* out; unsigned char* ws; };

__device__ __forceinline__ void ln_apply(const float* Y, float* Yo, bf16* HB, const float* st, float* ms, const float* gam, const float* bet, int gw, int ngw, int lane) {
    f32x4 g4[4], b4[4];
#pragma unroll
    for (int j = 0; j < 4; ++j) { g4[j] = ((const f32x4*)gam)[lane + 64 * j]; b4[j] = ((const f32x4*)bet)[lane + 64 * j]; }
    for (int m = gw; m < NTOK; m += ngw) {
        const f32x4* yr = (const f32x4*)(Y + (size_t)m * DM) + lane;
        f32x4 v[4];
#pragma unroll
        for (int j = 0; j < 4; ++j) v[j] = yr[64 * j];
        const f32x4 a = *(const f32x4*)(st + (size_t)m * 8), b = *(const f32x4*)(st + (size_t)m * 8 + 4);
        const float s = (a[0] + a[2]) + (b[0] + b[2]), q = (a[1] + a[3]) + (b[1] + b[3]);
        const float mean = s * (1.f / DM), rstd = 1.f / sqrtf(q * (1.f / DM) - mean * mean + LN_EPS);
        if (lane == 0) { ms[(size_t)m * 2] = mean; ms[(size_t)m * 2 + 1] = rstd; }
        u32x2* o8 = (u32x2*)(HB + (size_t)m * DM) + lane;
#pragma unroll
        for (int j = 0; j < 4; ++j) { const f32x4 o = (v[j] - mean) * rstd * g4[j] + b4[j]; if (Yo) ((f32x4*)(Yo + (size_t)m * DM) + lane)[64 * j] = o; u32x2 w; w.x = pk2(o.x, o.y); w.y = pk2(o.z, o.w); o8[64 * j] = w; }
    }
}

__device__ __forceinline__ void ffn_fix_phase(const float* HT, bf16* Gb, const float* cw, const float* cb, int cu, int G, int tid) {
    const int sub = tid >> 6, r = (tid >> 5) & 1, f = (tid & 31) * 4;
    for (int up = cu * 8 + sub; up < 224 * 22; up += G * 8) {
        const int pn = up % 22, pq = up / 22, pm = pq + pq / 7 + 1;
        const float* hc = HT + (size_t)(pm * 22 + pn) * 1024; const float* hp = HT + (size_t)((pm - 1) * 22 + pn) * 1024;
        f32x4 y[2];
#pragma unroll
        for (int hh = 0; hh < 2; ++hh) { const int c = hh * 128 + f; const int F = hh * FF + 128 * pn + f;
            const f32x4 h0 = *(const f32x4*)(hc + c), h1 = *(const f32x4*)(hc + 256 + c), t0 = *(const f32x4*)(hp + 512 + c), t1 = *(const f32x4*)(hp + 768 + c);
            const f32x4 x0 = r ? h1 : h0, xm1 = r ? h0 : t1, xm2 = r ? t1 : t0;
            y[hh] = *(const f32x4*)(cb + F) + *(const f32x4*)(cw + F) * xm2 + *(const f32x4*)(cw + FF2 + F) * xm1 + *(const f32x4*)(cw + 2 * FF2 + F) * x0; }
        float v[4];
#pragma unroll
        for (int e = 0; e < 4; ++e) v[e] = y[0][e] * __builtin_amdgcn_rcpf(1.0f + __builtin_amdgcn_exp2f(-1.4426950408889634f * y[0][e])) * y[1][e];
        u32x2 w; w.x = pk2(v[0], v[1]); w.y = pk2(v[2], v[3]);
        *(u32x2*)(Gb + (size_t)(pm * 256 + r) * FF + 128 * pn + f) = w;
    }
}

__device__ __forceinline__ void attn_phase(LAS unsigned char* lds, const bf16* Q, const bf16* K, const bf16* V, bf16* O, int cu, int G, int rev) {
    const int tid = opaque_tid(), lane = tid & 63, wid = __builtin_amdgcn_readfirstlane(tid >> 6), q32 = lane & 31, hi = lane >> 5, li = lane & 15;
    LAS unsigned char* Ks = lds + wid * 10752;
    LAS unsigned char* Vs = Ks + 4608;
    const int lkey = lane >> 3, lch = lane & 7;
    const float LOG2E = 1.4426950408889634f;
    for (int k = 0; k < 16; ++k) {
        const int idx = cu * 8 + wid + 2048 * (k & 3), b = 4 * (idx & 7) + (rev ? 3 - (k >> 2) : (k >> 2)), h = (idx >> 3) & 15, qb = idx >> 7;
        const size_t rowbase = (size_t)b * SEQ;
        const int q0w = qb * 32;
        bf16x8 qf[4];
        { const bf16* qp = Q + (rowbase + q0w + q32) * DM + h * HD + hi * 8;
#pragma unroll
          for (int ks = 0; ks < 4; ++ks) qf[ks] = *(const bf16x8*)(qp + ks * 16); }
        f32x16 o0, o1;
#pragma unroll
        for (int r = 0; r < 16; ++r) { o0[r] = 0.f; o1[r] = 0.f; }
        float R = 0.f;
        const bf16* kp = K + (rowbase + lkey) * DM + h * HD + lch * 8;
        const bf16* vp = V + (rowbase + lkey) * DM + h * HD + lch * 8;
        u32x4 kr[4], vr[4];
#pragma unroll
        for (int jj = 0; jj < 4; ++jj) { kr[jj] = *(const u32x4*)(kp + (size_t)(q0w + 8 * jj) * DM); vr[jj] = *(const u32x4*)(vp + (size_t)(q0w + 8 * jj) * DM); }
        for (int key0 = q0w; key0 >= 0; key0 -= 32) {
#pragma unroll
            for (int jj = 0; jj < 4; ++jj) { *(LAS u32x4*)(Ks + (lkey + 8 * jj) * 144 + lch * 16) = kr[jj]; *(LAS u32x4*)(Vs + (lkey + 8 * jj) * 192 + lch * 16) = vr[jj]; }
            asm volatile("s_waitcnt lgkmcnt(0)" ::: "memory");
            if (key0 >= 32) {
#pragma unroll
                for (int jj = 0; jj < 4; ++jj) { kr[jj] = *(const u32x4*)(kp + (size_t)(key0 - 32 + 8 * jj) * DM); vr[jj] = *(const u32x4*)(vp + (size_t)(key0 - 32 + 8 * jj) * DM); } }
            const bool diag = (key0 == q0w);
            f32x16 s;
#pragma unroll
            for (int r = 0; r < 16; ++r) s[r] = 0.f;
#pragma unroll
            for (int ks = 0; ks < 4; ++ks) { const bf16x8 kf = *(LAS const bf16x8*)(Ks + q32 * 144 + (16 * ks + 8 * hi) * 2);
                s = __builtin_amdgcn_mfma_f32_32x32x16_bf16(kf, qf[ks], s, 0, 0, 0); }
            float zs[16], l1[16];
#pragma unroll
            for (int r = 0; r < 16; ++r) { const float z = s[r] * LOG2E; const float e = __builtin_amdgcn_exp2f(-__builtin_fabsf(z)); const float t = __builtin_amdgcn_logf(1.0f + e);
                float l = -(__builtin_fmaxf(z, 0.f) + t);
                if (diag) { const int kl = 8 * (r >> 2) + 4 * hi + (r & 3); if (kl >= q32) l = 0.f; }
                zs[r] = z; l1[r] = l; }
            float G0[4], G1[4];
#pragma unroll
            for (int j = 0; j < 4; ++j) { const float gs = (l1[4 * j] + l1[4 * j + 1]) + (l1[4 * j + 2] + l1[4 * j + 3]);
                auto rr = __builtin_amdgcn_permlane32_swap(__float_as_uint(gs), __float_as_uint(gs), false, false); G0[j] = __uint_as_float(rr[0]); G1[j] = __uint_as_float(rr[1]); }
            float p[16]; float run = R;
#pragma unroll
            for (int j = 3; j >= 0; --j) { float sfx = run + (hi == 0 ? G1[j] : 0.f);
#pragma unroll
                for (int e = 3; e >= 0; --e) { const int r = 4 * j + e; float val = __builtin_amdgcn_exp2f(l1[r] + zs[r] + sfx);
                    if (diag) { const int kl = 8 * j + 4 * hi + e; if (kl >= q32) val = 0.f; }
                    p[r] = val; sfx += l1[r]; }
                run += G0[j] + G1[j]; }
            R = run;
#pragma unroll
            for (int ks2 = 0; ks2 < 2; ++ks2) {
                u32x4 pw; pw.x = pk2(p[8 * ks2], p[8 * ks2 + 1]); pw.y = pk2(p[8 * ks2 + 2], p[8 * ks2 + 3]); pw.z = pk2(p[8 * ks2 + 4], p[8 * ks2 + 5]); pw.w = pk2(p[8 * ks2 + 6], p[8 * ks2 + 7]);
                const bf16x8 pb = __builtin_bit_cast(bf16x8, pw);
#pragma unroll
                for (int dh = 0; dh < 2; ++dh) {
                    LAS const unsigned char* va = Vs + (16 * ks2 + 4 * hi + (li >> 2)) * 192 + (32 * dh + 16 * ((lane >> 4) & 1) + 4 * (li & 3)) * 2;
                    const s16x4 lo = vtr(va), hi4 = vtr(va + 8 * 192);
                    const bf16x8 vf = (bf16x8){lo[0], lo[1], lo[2], lo[3], hi4[0], hi4[1], hi4[2], hi4[3]};
                    if (dh == 0) o0 = __builtin_amdgcn_mfma_f32_32x32x16_bf16(vf, pb, o0, 0, 0, 0);
                    else         o1 = __builtin_amdgcn_mfma_f32_32x32x16_bf16(vf, pb, o1, 0, 0, 0);
                }
            }
            asm volatile("s_waitcnt lgkmcnt(0)" ::: "memory");
            if (__all(R < -150.0f)) break;
        }
#pragma unroll
        for (int j = 0; j < 4; ++j) { u32x2 w0, w1; w0.x = pk2(o0[4 * j], o0[4 * j + 1]); w0.y = pk2(o0[4 * j + 2], o0[4 * j + 3]); w1.x = pk2(o1[4 * j], o1[4 * j + 1]); w1.y = pk2(o1[4 * j + 2], o1[4 * j + 3]);
            *(LAS u32x2*)(Ks + q32 * 144 + (8 * j + 4 * hi) * 2) = w0; *(LAS u32x2*)(Ks + q32 * 144 + (32 + 8 * j + 4 * hi) * 2) = w1; }
        asm volatile("s_waitcnt lgkmcnt(0)" ::: "memory");
#pragma unroll
        for (int i = 0; i < 4; ++i) { const int row = lkey + 8 * i; const u32x4 v = *(LAS const u32x4*)(Ks + row * 144 + lch * 16);
            *(u32x4*)(O + (rowbase + q0w + row) * DM + h * HD + lch * 8) = v; }
        asm volatile("s_waitcnt lgkmcnt(0)" ::: "memory");
    }
    __syncthreads();
}

__device__ __forceinline__ void spatial_phase(LAS unsigned char* lds, const bf16* ZZ, bf16* GT, const bf16* Wc, const float* bs, const float* gam, const float* bet, const float* VST, int cu, int G, int rev) {
    const int tid = opaque_tid(), lane = tid & 63, wid = __builtin_amdgcn_readfirstlane(tid >> 6), fr = lane & 15, kg = lane >> 4;
    LAS float* st = (LAS float*)(lds + 69632);
    const int wr = wid >> 2, wc = wid & 3;
    for (int k = 0; k < 2; ++k) {
        const int cls = 2 * k + (cu >> 7); const int chunk = 64 * (cu & 7) + 16 * (rev ? 3 - cls : cls) + ((cu >> 3) & 15);
        const size_t row0 = (size_t)chunk * GC;
        __syncthreads();
        { const int row = tid >> 2, part = tid & 3;
          const f32x4 a = *(const f32x4*)(VST + (row0 + row) * 16 + part * 4);
          float sm = a[0] + a[2], sq = a[1] + a[3];
          sm += __shfl_xor(sm, 1); sm += __shfl_xor(sm, 2); sq += __shfl_xor(sq, 1); sq += __shfl_xor(sq, 2);
          if (part == 0) { const float mean = sm * (1.f / GW); st[2 * row] = mean; st[2 * row + 1] = 1.f / sqrtf(sq * (1.f / GW) - mean * mean + LN_EPS); } }
        const int c8 = tid & 31, srow = tid >> 5;
        LAS unsigned char* const wl = lds + 72704;
        const int wt = tid >> 2, wq = tid & 3;
        u32x4 nv[8], nw[4];
#pragma unroll
        for (int it = 0; it < 8; ++it) nv[it] = *(const u32x4*)(ZZ + (row0 + it * 16 + srow) * 4096 + GW + c8 * 8);
#pragma unroll
        for (int q = 0; q < 4; ++q) nw[q] = *(const u32x4*)(Wc + (size_t)wt * GC + wq * 32 + q * 8);
        for (int g = 0; g < GG; ++g) {
            __syncthreads();
            { const float* gp = gam + g * 256 + c8 * 8; const float* bp = bet + g * 256 + c8 * 8;
              const f32x4 ga = *(const f32x4*)gp, gb = *(const f32x4*)(gp + 4), ba = *(const f32x4*)bp, bb = *(const f32x4*)(bp + 4);
#pragma unroll
              for (int q = 0; q < 4; ++q) *(LAS u32x4*)(wl + wt * 272 + wq * 64 + q * 16) = nw[q];
#pragma unroll
              for (int it = 0; it < 8; ++it) { const int s = it * 16 + srow;
                  const u32x4 w = nv[it];
                  const float mean = st[2 * s], rstd = st[2 * s + 1];
                  u32x4 o;
                  o.x = pk2((bflo(w.x) - mean) * rstd * ga.x + ba.x, (bfhi(w.x) - mean) * rstd * ga.y + ba.y);
                  o.y = pk2((bflo(w.y) - mean) * rstd * ga.z + ba.z, (bfhi(w.y) - mean) * rstd * ga.w + ba.w);
                  o.z = pk2((bflo(w.z) - mean) * rstd * gb.x + bb.x, (bfhi(w.z) - mean) * rstd * gb.y + bb.y);
                  o.w = pk2((bflo(w.w) - mean) * rstd * gb.z + bb.z, (bfhi(w.w) - mean) * rstd * gb.w + bb.w);
                  { const int pos0 = 64 * (c8 >> 3) + 32 * ((c8 & 7) >> 2) + 4 * (c8 & 3);
                    *(LAS u32x2*)(lds + s * 544 + pos0 * 2) = (u32x2){o.x, o.y}; *(LAS u32x2*)(lds + s * 544 + (pos0 + 16) * 2) = (u32x2){o.z, o.w}; } } }
            __syncthreads();
            if (g + 1 < GG) {
#pragma unroll
                for (int it = 0; it < 8; ++it) nv[it] = *(const u32x4*)(ZZ + (row0 + it * 16 + srow) * 4096 + GW + (g + 1) * 256 + c8 * 8);
#pragma unroll
                for (int q = 0; q < 4; ++q) nw[q] = *(const u32x4*)(Wc + (size_t)(g + 1) * GC * GC + (size_t)wt * GC + wq * 32 + q * 8); }
            u32x4 uu[4][2];
#pragma unroll
            for (int tb = 0; tb < 4; ++tb)
#pragma unroll
                for (int a2 = 0; a2 < 2; ++a2) uu[tb][a2] = *(const u32x4*)(ZZ + (row0 + 64 * wr + 16 * tb + fr) * 4096 + g * 256 + 64 * wc + 32 * a2 + 8 * kg);
            f32x4 acc[4][4];
#pragma unroll
            for (int a = 0; a < 4; ++a)
#pragma unroll
                for (int b2 = 0; b2 < 4; ++b2) acc[a][b2] = (f32x4){0.f, 0.f, 0.f, 0.f};
#pragma unroll
            for (int ks = 0; ks < 4; ++ks) {
                if (32 * ks <= 64 * wr + 63) {
                    bf16x8 X[4], Y[4];
#pragma unroll
                    for (int tb = 0; tb < 4; ++tb) { LAS const unsigned char* wp = wl + (64 * wr + 16 * tb + fr) * 272 + (32 * ks + 4 * kg) * 2;
                        const u32x2 a = *(LAS const u32x2*)wp, b2 = *(LAS const u32x2*)(wp + 32); const u32x4 w = (u32x4){a.x, a.y, b2.x, b2.y}; Y[tb] = __builtin_bit_cast(bf16x8, w); }
#pragma unroll
                    for (int cb = 0; cb < 4; ++cb) { LAS const unsigned char* xa = lds + (32 * ks + 4 * kg + (fr >> 2)) * 544 + (64 * wc + 16 * cb + 4 * (fr & 3)) * 2;
                        const s16x4 lo = vtr(xa), hi4 = vtr(xa + 16 * 544);
                        X[cb] = (bf16x8){lo[0], lo[1], lo[2], lo[3], hi4[0], hi4[1], hi4[2], hi4[3]}; }
#pragma unroll
                    for (int tb = 0; tb < 4; ++tb)
#pragma unroll
                        for (int cb = 0; cb < 4; ++cb) acc[tb][cb] = __builtin_amdgcn_mfma_f32_16x16x32_bf16(X[cb], Y[tb], acc[tb][cb], 0, 0, 0);
                }
            }
#pragma unroll
            for (int tb = 0; tb < 4; ++tb) { const int t = 64 * wr + 16 * tb + fr; const float bsv = bs[g * GC + t];
#pragma unroll
                for (int a2 = 0; a2 < 2; ++a2) { const int c = g * 256 + 64 * wc + 32 * a2 + 8 * kg;
                    const u32x4 u = uu[tb][a2]; const f32x4 s0 = acc[tb][2 * a2] + bsv, s1 = acc[tb][2 * a2 + 1] + bsv;
                    u32x4 o; o.x = pk2(bflo(u.x) * s0[0], bfhi(u.x) * s0[1]); o.y = pk2(bflo(u.y) * s0[2], bfhi(u.y) * s0[3]); o.z = pk2(bflo(u.z) * s1[0], bfhi(u.z) * s1[1]); o.w = pk2(bflo(u.w) * s1[2], bfhi(u.w) * s1[3]);
                    *(u32x4*)(GT + (row0 + t) * GW + c) = o; } }
        }
    }
}

#ifndef PROBE
#define PROBE 0
#endif
#ifndef G2_REV
#define G2_REV 1
#endif
__device__ __forceinline__ void gbar(unsigned* ctr, unsigned target) {
    asm volatile("s_waitcnt vmcnt(0)" ::: "memory");
    __syncthreads();
    if (threadIdx.x == 0) {
        __builtin_amdgcn_fence(__ATOMIC_RELEASE, "agent");
        asm volatile("s_waitcnt vmcnt(0)" ::: "memory");
        __hip_atomic_fetch_add(ctr, 1u, __ATOMIC_RELAXED, __HIP_MEMORY_SCOPE_AGENT);
        while (__hip_atomic_load(ctr, __ATOMIC_RELAXED, __HIP_MEMORY_SCOPE_AGENT) < target) __builtin_amdgcn_s_sleep(1);
        __builtin_amdgcn_fence(__ATOMIC_ACQUIRE, "agent");
        asm volatile("s_waitcnt vmcnt(0)" ::: "memory");
    }
    __syncthreads();
}
#define GSYNC() do { bar_target += (unsigned)G; gbar(bar_ctr, bar_target); if (PROBE == 7) { bar_target += (unsigned)G; gbar(bar_ctr, bar_target); } } while (0)
__global__ void __launch_bounds__(512, 2) fwd_kernel(Args args) {
    extern __shared__ __attribute__((aligned(16))) unsigned char lds_raw[];
    cg::grid_group grid = cg::this_grid();
    LAS unsigned char* lds = (LAS unsigned char*)lds_raw;
    const int G = gridDim.x, cu = blockIdx.x, ngw = G * 8;
    unsigned char* ws = args.ws;
    const float* x = args.in[0];
    float* out = args.out;
    bf16* HB = (bf16*)(ws + WS_HB);
    unsigned* bar_ctr = (unsigned*)(ws + WS_CTL); unsigned bar_target = 0u;
    if (cu == 0 && threadIdx.x < 8) __hip_atomic_store((unsigned*)(ws + WS_CTL + 8192) + 64 * threadIdx.x, 0u, __ATOMIC_RELAXED, __HIP_MEMORY_SCOPE_AGENT);
    if (cu == 0 && threadIdx.x == 0) __hip_atomic_store(bar_ctr, 0u, __ATOMIC_RELAXED, __HIP_MEMORY_SCOPE_AGENT);

    for (int rep = 0; rep < (PROBE == 8 ? 2 : 1); ++rep) {
        const int tid = opaque_tid(), lane = tid & 63, wave = __builtin_amdgcn_readfirstlane(tid >> 6), gw = cu * 8 + wave;
        LAS float* scr = (LAS float*)(lds + wave * 16384);
        for (int mat = 0; mat < 16; ++mat) {
            const float* W; bf16* WT; int K, N, perm = 0;
            if (mat < 2)       { W = args.in[1] + (size_t)mat * DM * 3072;        WT = (bf16*)(ws + WS_ATTN_IN) + (size_t)mat * 3072 * DM;        K = DM; N = 3072; }
            else if (mat < 4)  { W = args.in[2] + (size_t)(mat - 2) * DM * DM;    WT = (bf16*)(ws + WS_ATTN_OUT) + (size_t)(mat - 2) * DM * DM;   K = DM; N = DM; }
            else if (mat < 6)  { W = args.in[3] + (size_t)(mat - 4) * DM * 4096;  WT = (bf16*)(ws + WS_GMLP_IN) + (size_t)(mat - 4) * 4096 * DM;  K = DM; N = 4096; }
            else if (mat < 8)  { W = args.in[8] + (size_t)(mat - 6) * GW * DM;    WT = (bf16*)(ws + WS_GMLP_OUT) + (size_t)(mat - 6) * DM * GW;   K = GW; N = DM; }
            else if (mat < 12) { W = args.in[9] + (size_t)(mat - 8) * DM * FF2;   WT = (bf16*)(ws + WS_FFN_UP) + (size_t)(mat - 8) * FF2 * DM;    K = DM; N = FF2; perm = 1; }
            else               { W = args.in[12] + (size_t)(mat - 12) * FF * DM;  WT = (bf16*)(ws + WS_FFN_DOWN) + (size_t)(mat - 12) * DM * FF;  K = FF; N = DM; }
            const int nitems = (K / 64) * (N / 32);
            for (int it = gw; it < nitems; it += ngw) transpose_item(W, K, N, WT, perm, (mat < 2 || mat == 4 || mat == 5 || (mat >= 8 && mat < 12)) ? 1 : 0, scr, it, lane);
        }
        { const float* wsrc = args.in[6]; bf16* wd = (bf16*)(ws + WS_WS);
          for (int i = cu * 512 + tid; i < 2 * GG * GC * GC; i += G * 512) { const int s = i & 127, t = (i >> 7) & 127; const float v = (s <= t) ? wsrc[i] : 0.f; wd[i] = (bf16)(pk2(v, v) & 0xffffu); } }
        for (int m = gw; m < NTOK; m += ngw) {
            const f32x4* xr = (const f32x4*)(x + (size_t)m * DM) + lane; u32x2* o8 = (u32x2*)(HB + (size_t)m * DM) + lane;
#pragma unroll
            for (int j = 0; j < 4; ++j) { const f32x4 v = xr[64 * j]; u32x2 w; w.x = pg8::cvt_pk_f16(v.x, v.y); w.y = pg8::cvt_pk_f16(v.z, v.w); o8[64 * j] = w; }
        }
    }
    grid.sync();

    int dir = 0;
    for (int layer = 0; layer < DEPTH; ++layer) {
        const int j = layer >> 1, mixer = layer & 1;
        for (int step = 0; step < 2; ++step) {
            if (step == 0) {
                pg8::Gemm g; pg8::EpiBf16 E;
                if (mixer == 0) { g = pg8::Gemm{HB, (const bf16*)(ws + WS_ATTN_IN) + (size_t)j * 3072 * DM, NTOK, 3072, DM};
                    E = pg8::EpiBf16{(bf16*)(ws + WS_Q), DM, 0, DM, (size_t)NTOK * DM, 0.125f, nullptr, nullptr}; }
                else { g = pg8::Gemm{HB, (const bf16*)(ws + WS_GMLP_IN) + (size_t)j * 4096 * DM, NTOK, 4096, DM};
                    E = pg8::EpiBf16{(bf16*)(ws + WS_ZZ), 4096, 1, 0, 0, 1.f, (float*)(ws + WS_VST), (LAS float*)(lds + 131072)}; }
                pg8::StaticOrder S; S.rev = dir; dir ^= 1; S.init(g.M, g.N, G, cu);
                for (int rep = 0; rep < (PROBE == 1 ? 2 : 1); ++rep)
                pg8::gemm_phase<pg8::EpiBf16, pg8::StaticOrder, true, true>(lds, g, S, E);
            } else {
                pg8::Gemm g{HB, (const bf16*)(ws + WS_FFN_UP) + (size_t)layer * FF2 * DM, NTOK, FF2, DM};
                pg8::EpiConv E{(bf16*)(ws + WS_G), args.in[10] + (size_t)layer * 3 * FF2, args.in[11] + (size_t)layer * FF2, lds + 131072, FF, FF2, FF, (float*)(ws + WS_HT)};
                pg8::StaticOrder S; S.rev = dir; dir ^= 1; S.init(g.M, g.N, G, cu);
                for (int rep = 0; rep < (PROBE == 4 ? 2 : 1); ++rep)
                pg8::gemm_phase<pg8::EpiConv, pg8::StaticOrder, true, true>(lds, g, S, E);
                GSYNC();
                ffn_fix_phase((const float*)(ws + WS_HT), (bf16*)(ws + WS_G), args.in[10] + (size_t)layer * 3 * FF2, args.in[11] + (size_t)layer * FF2, cu, G, opaque_tid());
            }
            GSYNC();
            if (step == 0) {
                for (int rep = 0; rep < (((PROBE == 2 && mixer == 0) || (PROBE == 3 && mixer == 1)) ? 2 : 1); ++rep)
                if (mixer == 0) attn_phase(lds, (const bf16*)(ws + WS_Q), (const bf16*)(ws + WS_K), (const bf16*)(ws + WS_V), (bf16*)(ws + WS_O), cu, G, dir);
                else spatial_phase(lds, (const bf16*)(ws + WS_ZZ), (bf16*)(ws + WS_GT), (const bf16*)(ws + WS_WS) + (size_t)j * GG * GC * GC, args.in[7] + j * GG * GC, args.in[4] + j * GW, args.in[5] + j * GW, (const float*)(ws + WS_VST), cu, G, dir); dir ^= 1;
                GSYNC();
            }
            const int lnidx = 2 * layer + step;
            {
                pg8::Gemm g;
                if (step == 0 && mixer == 0) g = pg8::Gemm{(const bf16*)(ws + WS_O), (const bf16*)(ws + WS_ATTN_OUT) + (size_t)j * DM * DM, NTOK, DM, DM};
                else if (step == 0) g = pg8::Gemm{(const bf16*)(ws + WS_GT), (const bf16*)(ws + WS_GMLP_OUT) + (size_t)j * DM * GW, NTOK, DM, GW};
                else g = pg8::Gemm{(const bf16*)(ws + WS_G), (const bf16*)(ws + WS_FFN_DOWN) + (size_t)layer * DM * FF, NTOK, DM, FF};
                const int pl = (lnidx - 1) >> 1;
                const float* pgam = lnidx == 0 ? nullptr : (((lnidx - 1) & 1) ? args.in[15] : args.in[13]) + pl * DM;
                const float* pbet = lnidx == 0 ? nullptr : (((lnidx - 1) & 1) ? args.in[16] : args.in[14]) + pl * DM;
                const float* cgam = (step == 0 ? args.in[13] : args.in[15]) + layer * DM;
                const float* cbet = (step == 0 ? args.in[14] : args.in[16]) + layer * DM;
                const bool lastln = lnidx == 2 * DEPTH - 1;
                pg8::EpiResLn E{(const unsigned short*)HB, 0, out, (float*)(ws + WS_ST), cgam, cbet, HB, (unsigned short*)HB,
                                (unsigned*)(ws + WS_CTL + 8192), 128u * (unsigned)lnidx, lastln ? 1 : 0, lds + 131072, dir};
                pg8::StaticOrder S; S.rev = dir; dir ^= 1; S.init(g.M, g.N, G, cu);
                if (PROBE == 9) { pg8::EpiBf16 E0{(bf16*)(ws + WS_R + (step == 1 ? 512 * MiB : 0)), DM, 0, 0, 0, 1.f};
                    pg8::gemm_phase<pg8::EpiBf16, pg8::StaticOrder, true, true>(lds, g, S, E0); }
                pg8::gemm_phase<pg8::EpiResLn, pg8::StaticOrder, true, true>(lds, g, S, E);
            }
            if (lnidx != 2 * DEPTH - 1) GSYNC();
        }
    }
}

extern "C" void kernel_launch(void* const* d_in, const int* in_sizes, int n_in, void* d_out, int out_size, void* d_ws, size_t ws_size, hipStream_t stream) {
    static int grid = 0;
    if (grid == 0) {
        if (n_in != 17 || out_size != NTOK * DM || ws_size < WS_END) { fprintf(stderr, "kernel_launch: unexpected shapes (n_in %d, out %d, ws %zu)\n", n_in, out_size, ws_size); grid = -1; return; }
        int dev = 0, cus = 0, per_cu = 0;
        hipGetDevice(&dev);
        hipDeviceGetAttribute(&cus, hipDeviceAttributeMultiprocessorCount, dev);
        if (hipFuncSetAttribute((const void*)fwd_kernel, hipFuncAttributeMaxDynamicSharedMemorySize, LDS_BYTES) != hipSuccess) { fprintf(stderr, "kernel_launch: hipFuncSetAttribute failed\n"); grid = -1; return; }
        if (hipOccupancyMaxActiveBlocksPerMultiprocessor(&per_cu, (const void*)fwd_kernel, 512, LDS_BYTES) != hipSuccess || per_cu < 1) { fprintf(stderr, "kernel_launch: occupancy query says %d\n", per_cu); per_cu = 1; }
        (void)hipGetLastError();
        grid = cus * per_cu;
        fprintf(stderr, "kernel_launch: grid %d (cus %d x %d)\n", grid, cus, per_cu);
        if (grid != 256) { fprintf(stderr, "kernel_launch: the fused LayerNorm epilogue's group barrier is laid out for a 256-workgroup grid; nothing launched\n"); grid = -1; return; }
    }
    if (grid < 0) return;
    Args a{};
    for (int i = 0; i < 17; ++i) a.in[i] = (const float*)d_in[i];
    a.out = (float*)d_out; a.ws = (unsigned char*)d_ws;
    void* kargs[] = {&a};
    hipError_t e = hipLaunchCooperativeKernel((const void*)fwd_kernel, dim3(grid), dim3(512), kargs, LDS_BYTES, stream);
    if (e != hipSuccess) fprintf(stderr, "cooperative launch failed: %s (grid %d)\n", hipGetErrorString(e), grid);
}
```

```cpp
#include <hip/hip_runtime.h>
#include <hip/hip_cooperative_groups.h>
#include <cstdio>
#include <cstdint>
namespace cg = cooperative_groups;
__device__ __forceinline__ int opaque_tid() { int t = threadIdx.x; asm volatile("" : "+v"(t)); return t; }
namespace pg8 {
#define PG8_LAS __attribute__((address_space(3)))
typedef unsigned short bf16_t;
typedef short bf16x8 __attribute__((ext_vector_type(8)));
typedef float f32x4 __attribute__((ext_vector_type(4)));
typedef unsigned u32x4 __attribute__((ext_vector_type(4)));
constexpr int BM = 256, BK = 64, HALF = 128, HTB = HALF * BK * 2  , STAGE_BYTES = 8 * HTB, NXCD = 8, WGM = 8;

__host__ __device__ __forceinline__ int lds_byte(int r, int c) { const int st = (r >> 4) * 2 + (c >> 5), rr = r & 15, cc = c & 31, ob = rr * 64 + cc * 2; return st * 1024 + (ob ^ (((ob >> 9) & 1) << 5)); }
__host__ __device__ __forceinline__ void stage_rc(int b, int& R, int& C) { const int st = b / 1024, sb = b % 1024, swz = sb ^ (((sb >> 9) & 1) << 5); R = (st >> 1) * 16 + swz / 64; C = (st & 1) * 32 + (swz % 64) / 2; }
__host__ __device__ __forceinline__ int perm32(int rho) { const int n = rho >> 4, i = rho & 15; return 8 * (i >> 2) + 4 * n + (i & 3); }

struct Unit { int pm, pn; };
struct Gemm { const bf16_t* A; const bf16_t* Bt; int M, N, K; };

struct StaticOrder {
    int nM, nN, nwg, G, c, rev = 0;
    __host__ __device__ void init(int M, int N, int G_, int c_) { nM = M / BM; nN = N / BM; nwg = nM * nN; G = G_; c = c_; }
    __host__ __device__ bool next(int i, Unit& u) const {
        if ((long)i * G + c >= nwg) return false;
        const long L = (long)(rev ? (nwg / G - 1 - i) : i) * G + c;
        int wgid = (int)L; { const int q = nwg / NXCD, r = nwg % NXCD, xcd = wgid % NXCD, off = wgid / NXCD; wgid = (xcd < r ? xcd * (q + 1) : r * (q + 1) + (xcd - r) * q) + off; }
        const int nig = WGM * nN, gid = wgid / nig, fm = gid * WGM, gsz = (nM - fm) < WGM ? (nM - fm) : WGM;
        u.pm = fm + ((wgid % nig) % gsz); u.pn = (wgid % nig) / gsz; return true;
    }
    __device__ __forceinline__ void a_ready(const Unit&) const {}
    __device__ __forceinline__ void done(const Unit&) const {}
};
__device__ __forceinline__ unsigned cvt_pk_bf16(float lo, float hi) { unsigned r; asm volatile("v_cvt_pk_bf16_f32 %0, %1, %2" : "=v"(r) : "v"(lo), "v"(hi)); return r; }
typedef float f32x2 __attribute__((ext_vector_type(2)));
typedef _Float16 f16x8 __attribute__((ext_vector_type(8)));
template <bool F16> __device__ __forceinline__ f32x4 mma16(bf16x8 a, bf16x8 b, f32x4 c) {
    if constexpr (F16) return __builtin_amdgcn_mfma_f32_16x16x32_f16(__builtin_bit_cast(f16x8, a), __builtin_bit_cast(f16x8, b), c, 0, 0, 0);
    else return __builtin_amdgcn_mfma_f32_16x16x32_bf16(a, b, c, 0, 0, 0);
}
__device__ __forceinline__ unsigned cvt_pk_f16(float lo, float hi) { typedef _Float16 h2 __attribute__((ext_vector_type(2))); const h2 v = {(_Float16)lo, (_Float16)hi}; return __builtin_bit_cast(unsigned, v); }
typedef unsigned u32x2e __attribute__((ext_vector_type(2)));
__device__ __forceinline__ float gelu_tanh(float x) {
    const float t = x * (-2.302208198f + (-0.1029432397f) * x * x);
    return x * __builtin_amdgcn_rcpf(1.0f + __builtin_amdgcn_exp2f(t));
}
struct EpiBf16 {
    static constexpr bool PERM = true, AFTER_DRAIN = false, F16 = true;
    bf16_t* O; int ldc; int act; int split_cols; size_t split_stride; float scale0;
    float* vst; PG8_LAS float* sl;
    __device__ __forceinline__ void operator()(const f32x4 (&acc)[2][2][4][2], const Unit& u, int wr, int wc, int fr, int fq) const {
        const int row0 = u.pm * BM + wr * 64 + fr; int colt = u.pn * BM; bf16_t* base = O;
        float sc = 1.f; if (split_cols) { const int t = colt / split_cols; base += (size_t)t * split_stride; colt -= t * split_cols; if (t == 0) sc = scale0; }
        const int col0 = colt + wc * 32 + 8 * fq;
        const bool dost = vst != nullptr && u.pn >= 8;
#pragma unroll
        for (int ai = 0; ai < 2; ++ai)
#pragma unroll
            for (int m = 0; m < 4; ++m) { bf16_t* rowp = base + (size_t)(row0 + ai * HALF + m * 16) * ldc + col0; float rs = 0.f, rq = 0.f;
#pragma unroll
                for (int bj = 0; bj < 2; ++bj) { f32x4 v0 = acc[ai][bj][m][0], v1 = acc[ai][bj][m][1];
                    if (act) { v0 = (f32x4){gelu_tanh(v0[0]), gelu_tanh(v0[1]), gelu_tanh(v0[2]), gelu_tanh(v0[3])};
                               v1 = (f32x4){gelu_tanh(v1[0]), gelu_tanh(v1[1]), gelu_tanh(v1[2]), gelu_tanh(v1[3])}; }
                    if (dost) { rs += ((v0[0] + v0[1]) + (v0[2] + v0[3])) + ((v1[0] + v1[1]) + (v1[2] + v1[3]));
                                rq += ((v0[0] * v0[0] + v0[1] * v0[1]) + (v0[2] * v0[2] + v0[3] * v0[3])) + ((v1[0] * v1[0] + v1[1] * v1[1]) + (v1[2] * v1[2] + v1[3] * v1[3])); }
                    v0 = v0 * sc; v1 = v1 * sc; u32x4 w; w.x = cvt_pk_bf16(v0[0], v0[1]); w.y = cvt_pk_bf16(v0[2], v0[3]); w.z = cvt_pk_bf16(v1[0], v1[1]); w.w = cvt_pk_bf16(v1[2], v1[3]);
                    *(u32x4*)(rowp + bj * HALF) = w; }
                if (dost) { rs += __shfl_xor(rs, 16); rs += __shfl_xor(rs, 32); rq += __shfl_xor(rq, 16); rq += __shfl_xor(rq, 32);
                    const int lrow = ai * HALF + wr * 64 + m * 16 + fr; if (fq == 0) { sl[(lrow * 4 + wc) * 2] = rs; sl[(lrow * 4 + wc) * 2 + 1] = rq; } } }
        if (dost) {
            asm volatile("s_waitcnt lgkmcnt(0)" ::: "memory"); __builtin_amdgcn_s_barrier(); asm volatile("" ::: "memory");
            const int t = opaque_tid();
            if (t < 256) { const f32x4 a = *(PG8_LAS const f32x4*)(sl + t * 8), b = *(PG8_LAS const f32x4*)(sl + t * 8 + 4);
                typedef float f32x2v __attribute__((ext_vector_type(2)));
                *(f32x2v*)(vst + ((size_t)u.pm * BM + t) * 16 + (u.pn - 8) * 2) = (f32x2v){(a[0] + a[2]) + (b[0] + b[2]), (a[1] + a[3]) + (b[1] + b[3])}; }
        }
    }
};
struct EpiRes {
    static constexpr bool PERM = false, AFTER_DRAIN = false, F16 = false;
    const float* base; float* out; int ldc; float alpha;
    __device__ __forceinline__ void operator()(const f32x4 (&acc)[2][2][4][2], const Unit& u, int wr, int wc, int fr, int fq) const {
        const int col0 = u.pn * BM + wc * 32 + 4 * fq;
#pragma unroll
        for (int ai = 0; ai < 2; ++ai)
#pragma unroll
            for (int m = 0; m < 4; ++m) { const size_t off = (size_t)(u.pm * BM + ai * HALF + wr * 64 + m * 16 + fr) * ldc + col0;
#pragma unroll
                for (int bj = 0; bj < 2; ++bj)
#pragma unroll
                    for (int n = 0; n < 2; ++n) { const f32x4 bs = *(const f32x4*)(base + off + bj * HALF + n * 16);
                        *(f32x4*)(out + off + bj * HALF + n * 16) = bs * alpha + acc[ai][bj][m][n]; }
                asm volatile("" ::: "memory"); }
    }
};

template <int CTRL> __device__ __forceinline__ float dpp_mov(float old, float src) {
    return __builtin_bit_cast(float, __builtin_amdgcn_update_dpp(__builtin_bit_cast(int, old), __builtin_bit_cast(int, src), CTRL, 0xf, 0xf, false));
}
struct SeqOrder {
    int G, c;
    __device__ bool next(int i, Unit& u) const { if (i >= 22) return false; int it, step;
        if (i < 16) { it = c + G * (i >> 3); step = i & 7; } else { const int v = 6 * c + (i - 16); it = 512 + (v >> 3); step = v & 7; }
        u.pn = it >> 5; u.pm = 8 * (it & 31) + step; return true; }
    __device__ __forceinline__ void a_ready(const Unit&) const {}
    __device__ __forceinline__ void done(const Unit&) const {}
};
struct EpiConv {
    static constexpr bool PERM = true, AFTER_DRAIN = false, F16 = true;
    bf16_t* O; const float* cw; const float* cb; PG8_LAS unsigned char* hl; int ldo, ncol2, nfeat; float* ht;
    __device__ __forceinline__ void operator()(const f32x4 (&acc)[2][2][4][2], const Unit& u, int wr, int wc, int fr, int fq) const {
        const int lcol = wc * 32 + 8 * fq;
        { const int t = opaque_tid();
          if (t < 256) { const int p = t >> 5, ch = t & 31, pp = p & 3; const float* src = (pp < 3 ? cw + pp * ncol2 : cb) + (p >> 2) * nfeat + 128 * u.pn + 4 * ch;
              *(PG8_LAS f32x4*)(hl + 10240 + (p * 128 + 4 * ch) * 4) = *(const f32x4*)src; } }
        float* const htu = ht + (size_t)(u.pm * 22 + u.pn) * 1024;
        if (fr >= 14) {
#pragma unroll
            for (int ai = 0; ai < 2; ++ai) { const int k = 2 * ai + wr;
                if (k < 3) { PG8_LAS unsigned char* hp = hl + k * 2048 + (fr - 14) * 1024 + lcol * 4;
#pragma unroll
                    for (int bj = 0; bj < 2; ++bj)
#pragma unroll
                        for (int n = 0; n < 2; ++n) *(PG8_LAS f32x4*)(hp + bj * 512 + n * 16) = acc[ai][bj][3][n]; }
                else {
#pragma unroll
                    for (int bj = 0; bj < 2; ++bj)
#pragma unroll
                        for (int n = 0; n < 2; ++n) *(f32x4*)(htu + (2 + fr - 14) * 256 + bj * 128 + lcol + 4 * n) = acc[ai][bj][3][n]; } }
        }
        if (wr == 0 && fr < 2) {
#pragma unroll
            for (int bj = 0; bj < 2; ++bj)
#pragma unroll
                for (int n = 0; n < 2; ++n) *(f32x4*)(htu + fr * 256 + bj * 128 + lcol + 4 * n) = acc[0][bj][0][n];
        }
        asm volatile("s_waitcnt lgkmcnt(0)" ::: "memory"); __builtin_amdgcn_s_barrier(); asm volatile("" ::: "memory");
        u32x2e keep[2][4];
#pragma unroll
        for (int n = 0; n < 2; ++n) {
            const int f = 128 * u.pn + lcol + 4 * n;
            PG8_LAS const float* const wl = (PG8_LAS const float*)(hl + 10240) + lcol + 4 * n;
            const f32x4 wg0 = *(PG8_LAS const f32x4*)(wl), wg1 = *(PG8_LAS const f32x4*)(wl + 128), wg2 = *(PG8_LAS const f32x4*)(wl + 256), bg = *(PG8_LAS const f32x4*)(wl + 384);
            const f32x4 wv0 = *(PG8_LAS const f32x4*)(wl + 512), wv1 = *(PG8_LAS const f32x4*)(wl + 640), wv2 = *(PG8_LAS const f32x4*)(wl + 768), bv = *(PG8_LAS const f32x4*)(wl + 896);
#pragma unroll
            for (int ai = 0; ai < 2; ++ai) {
                const int k = 2 * ai + wr;
                const int rslot = k > 0 ? k - 1 : 0;
                PG8_LAS const unsigned char* hp = hl + rslot * 2048 + (lcol + 4 * n) * 4;
                f32x4 hg2 = *(PG8_LAS const f32x4*)hp, hv2 = *(PG8_LAS const f32x4*)(hp + 512), hg1 = *(PG8_LAS const f32x4*)(hp + 1024), hv1 = *(PG8_LAS const f32x4*)(hp + 1536);
                if (k == 0) { hg2 = (f32x4){0.f, 0.f, 0.f, 0.f}; hv2 = hg2; hg1 = hg2; hv1 = hg2; }
#pragma unroll
                for (int m = 0; m < 4; ++m) {
                    float r[4];
#pragma unroll
                    for (int e = 0; e < 4; ++e) {
                        const float xg = acc[ai][0][m][n][e], xv = acc[ai][1][m][n][e];
                        float o1g, o2g, o1v, o2v;
                        if (m == 0) { o1g = hg1[e]; o2g = fr == 0 ? hg2[e] : hg1[e]; o1v = hv1[e]; o2v = fr == 0 ? hv2[e] : hv1[e]; }
                        else { const float pgv = acc[ai][0][m > 0 ? m - 1 : 0][n][e], pvv = acc[ai][1][m > 0 ? m - 1 : 0][n][e];
                            o1g = dpp_mov<0x121>(pgv, pgv); o2g = dpp_mov<0x122>(pgv, pgv); o1v = dpp_mov<0x121>(pvv, pvv); o2v = dpp_mov<0x122>(pvv, pvv); }
                        const float p1g = dpp_mov<0x111>(o1g, xg), p2g = dpp_mov<0x112>(o2g, xg), p1v = dpp_mov<0x111>(o1v, xv), p2v = dpp_mov<0x112>(o2v, xv);
                        const float yg = bg[e] + wg2[e] * xg + wg1[e] * p1g + wg0[e] * p2g;
                        const float yv = bv[e] + wv2[e] * xv + wv1[e] * p1v + wv0[e] * p2v;
                        r[e] = yg * __builtin_amdgcn_rcpf(1.0f + __builtin_amdgcn_exp2f(-1.4426950408889634f * yg)) * yv;
                    }
                    u32x2e w; w.x = cvt_pk_bf16(r[0], r[1]); w.y = cvt_pk_bf16(r[2], r[3]);
                    if (n == 0) keep[ai][m] = w;
                    else { const u32x4 w4 = (u32x4){keep[ai][m].x, keep[ai][m].y, w.x, w.y}; *(u32x4*)(O + (size_t)(u.pm * BM + ai * HALF + wr * 64 + m * 16 + fr) * ldo + f - 4) = w4; }
                }
            }
        }
    }
};

struct EpiResLn {
    static constexpr bool PERM = true, AFTER_DRAIN = false, F16 = false;
    const unsigned short* base16; int isbf; float* out; float* st; const float* cg; const float* cbeta; bf16_t* hb; unsigned short* hf; unsigned* gcnt; unsigned tgt0; int last; PG8_LAS unsigned char* xl; int rev;
    static constexpr int ldc = 1024; static constexpr float alpha = 1.681792830507429f, eps = 1e-5f;
    typedef _Float16 h16x2 __attribute__((ext_vector_type(2)));
    __device__ __forceinline__ f32x4 dec(u32x2e w) const {
        if (isbf) return (f32x4){__uint_as_float(w.x << 16), __uint_as_float(w.x & 0xffff0000u), __uint_as_float(w.y << 16), __uint_as_float(w.y & 0xffff0000u)};
        const float f0 = (float)__builtin_bit_cast(_Float16, (unsigned short)(w.x & 0xffffu)), f1 = (float)__builtin_bit_cast(_Float16, (unsigned short)(w.x >> 16));
        const float f2 = (float)__builtin_bit_cast(_Float16, (unsigned short)(w.y & 0xffffu)), f3 = (float)__builtin_bit_cast(_Float16, (unsigned short)(w.y >> 16));
        return (f32x4){f0, f1, f2, f3}; }
    __device__ __forceinline__ void operator()(f32x4 (&acc)[2][2][4][2], const Unit& u, int wr, int wc, int fr, int fq) const {
        asm volatile("" : "+v"(fr), "+v"(fq));
        typedef float f32x2s __attribute__((ext_vector_type(2)));
        PG8_LAS float* const sl = (PG8_LAS float*)xl; PG8_LAS float* const gl = (PG8_LAS float*)(xl + 8192);
        const int col0 = u.pn * BM + wc * 32 + 8 * fq, lc0 = wc * 32 + 8 * fq;
        { const int t = opaque_tid();
          if (t < 128) { const int which = t >> 6, c4 = 4 * (t & 63); *(PG8_LAS f32x4*)(gl + which * 256 + c4) = *(const f32x4*)((which ? cbeta : cg) + u.pn * BM + c4); } }
        u32x4 nb[2];
        { const size_t off = ((size_t)u.pm * BM + wr * 64 + fr) * ldc + col0;
#pragma unroll
          for (int bj = 0; bj < 2; ++bj) nb[bj] = *(const u32x4*)(base16 + off + bj * HALF); }
#pragma unroll
        for (int i = 0; i < 8; ++i) { const int ai = i >> 2, m = i & 3; const int lrow = ai * HALF + wr * 64 + m * 16 + fr;
            u32x4 cur[2];
#pragma unroll
            for (int bj = 0; bj < 2; ++bj) cur[bj] = nb[bj];
            if (i < 7) { const int lr2 = ((i + 1) >> 2) * HALF + wr * 64 + ((i + 1) & 3) * 16 + fr; const size_t off2 = ((size_t)u.pm * BM + lr2) * ldc + col0;
#pragma unroll
                for (int bj = 0; bj < 2; ++bj) nb[bj] = *(const u32x4*)(base16 + off2 + bj * HALF); }
            asm volatile("" ::: "memory");
            float rsum = 0.f, rq = 0.f;
#pragma unroll
            for (int q = 0; q < 4; ++q) { const int bj = q >> 1, n = q & 1;
                const f32x4 y = dec(n ? (u32x2e){cur[bj].z, cur[bj].w} : (u32x2e){cur[bj].x, cur[bj].y}) * alpha + acc[ai][bj][m][n];
                acc[ai][bj][m][n] = y;
                rsum += (y[0] + y[1]) + (y[2] + y[3]); rq += (y[0] * y[0] + y[1] * y[1]) + (y[2] * y[2] + y[3] * y[3]); }
            rsum += __shfl_xor(rsum, 16); rsum += __shfl_xor(rsum, 32); rq += __shfl_xor(rq, 16); rq += __shfl_xor(rq, 32);
            if (fq == 0) { sl[(lrow * 4 + wc) * 2] = rsum; sl[(lrow * 4 + wc) * 2 + 1] = rq; }
            asm volatile("" ::: "memory"); }
        asm volatile("s_waitcnt lgkmcnt(0)" ::: "memory"); __builtin_amdgcn_s_barrier(); asm volatile("" ::: "memory");
        const int t = opaque_tid();
        if (t < 256) { const f32x4 a = *(PG8_LAS const f32x4*)(sl + t * 8), b = *(PG8_LAS const f32x4*)(sl + t * 8 + 4);
            const float ssum = (a[0] + a[2]) + (b[0] + b[2]), ssq = (a[1] + a[3]) + (b[1] + b[3]);
            __hip_atomic_store((unsigned long long*)(st + ((size_t)u.pm * BM + t) * 8 + u.pn * 2), ((unsigned long long)__float_as_uint(ssq) << 32) | __float_as_uint(ssum), __ATOMIC_RELAXED, __HIP_MEMORY_SCOPE_AGENT); }
        asm volatile("s_waitcnt vmcnt(0) lgkmcnt(0)" ::: "memory"); __builtin_amdgcn_s_barrier(); asm volatile("" ::: "memory");
        if (t == 0) {
            unsigned* const ctr = gcnt + 64 * (blockIdx.x & 7); const unsigned target = tgt0 + 32u * (unsigned)((rev ? 3 - ((u.pm >> 3) & 3) : ((u.pm >> 3) & 3)) + 1);
            __hip_atomic_fetch_add(ctr, 1u, __ATOMIC_RELAXED, __HIP_MEMORY_SCOPE_AGENT);
            while (__hip_atomic_load(ctr, __ATOMIC_RELAXED, __HIP_MEMORY_SCOPE_AGENT) < target) __builtin_amdgcn_s_sleep(1);
        }
        __builtin_amdgcn_s_barrier(); asm volatile("" ::: "memory");
        if (t < 256) { const size_t row = (size_t)u.pm * BM + t;
            float s = 0.f, q = 0.f;
#pragma unroll
            for (int k4 = 0; k4 < 4; ++k4) { const unsigned long long w = __hip_atomic_load((const unsigned long long*)(st + row * 8 + 2 * k4), __ATOMIC_RELAXED, __HIP_MEMORY_SCOPE_AGENT);
                s += __uint_as_float((unsigned)w); q += __uint_as_float((unsigned)(w >> 32)); }
            const float mean = s * (1.f / 1024.f), rstd = 1.f / sqrtf(q * (1.f / 1024.f) - mean * mean + eps);
            *(PG8_LAS f32x2s*)(sl + 2 * t) = (f32x2s){mean, rstd}; }
        asm volatile("s_waitcnt lgkmcnt(0)" ::: "memory"); __builtin_amdgcn_s_barrier(); asm volatile("" ::: "memory");
#pragma unroll
        for (int i = 0; i < 8; ++i) { const int ai = i >> 2, m = i & 3; const int lrow = ai * HALF + wr * 64 + m * 16 + fr; const size_t off = ((size_t)u.pm * BM + lrow) * ldc + col0;
            const f32x2s mr = *(PG8_LAS const f32x2s*)(sl + 2 * lrow); u32x4 pw;
#pragma unroll
            for (int q = 0; q < 4; ++q) { const int bj = q >> 1, n = q & 1;
                const f32x4 g4 = *(PG8_LAS const f32x4*)(gl + lc0 + bj * HALF + n * 4), b4 = *(PG8_LAS const f32x4*)(gl + 256 + lc0 + bj * HALF + n * 4);
                const f32x4 o = (acc[ai][bj][m][n] - mr.x) * mr.y * g4 + b4;
                if (last) *(f32x4*)(out + off + bj * HALF + n * 4) = o;
                else { if (n == 0) { pw.x = cvt_pk_f16(o[0], o[1]); pw.y = cvt_pk_f16(o[2], o[3]); } else { pw.z = cvt_pk_f16(o[0], o[1]); pw.w = cvt_pk_f16(o[2], o[3]); *(u32x4*)(hf + off + bj * HALF) = pw; } } }
            asm volatile("" ::: "memory"); }
    }
};

template <class Epi, class Sched, bool ALIGN_EPI = false, bool SP2 = false>
__device__ __forceinline__ void gemm_phase(PG8_LAS unsigned char* lds, const Gemm g, const Sched& S, const Epi& E) {
    const int tid = opaque_tid(), wid = __builtin_amdgcn_readfirstlane(tid >> 6), lane = tid & 63, wr = wid >> 2, wc = wid & 3, fr = lane & 15, fq = lane >> 4;
    const int K = g.K, nt = K / BK;
    unsigned voffA[2], voffB[2];
#pragma unroll
    for (int i = 0; i < 2; ++i) { int R, C; stage_rc(tid * 16 + i * 8192, R, C); const int Rb = Epi::PERM ? ((R & ~31) + perm32(R & 31)) : R;
        voffA[i] = (unsigned)(R * K + C) * 2u; voffB[i] = (unsigned)(Rb * K + C) * 2u; }
    const size_t kstep = (size_t)(BK * 2);
    const size_t hstep = (size_t)HALF * K * 2;
    const size_t tstep = 2 * hstep;
    const unsigned ldsw = (unsigned)wid * 1024u;
    const int aoff = lds_byte(wr * 64 + fr, fq * 8), boff = lds_byte(wc * 32 + fr, fq * 8);
#define PG8_SA(b, h) (((b) * 2 + (h)) * HTB)
#define PG8_SB(b, h) ((4 + (b) * 2 + (h)) * HTB)
#define PG8_STAGE(bufoff, gbase, voff) do { _Pragma("unroll") for (int _i = 0; _i < 2; ++_i) \
        __builtin_amdgcn_global_load_lds((const unsigned*)((const char*)(gbase) + (voff)[_i]), (PG8_LAS unsigned*)(lds + (bufoff) + ldsw + _i * 8192), 16, 0, 0); } while (0)
#define PG8_LDA(dst, b, h) do { _Pragma("unroll") for (int m = 0; m < 4; ++m) _Pragma("unroll") for (int k = 0; k < 2; ++k) dst[m][k] = *(const PG8_LAS bf16x8*)(lds + PG8_SA(b, h) + aoff + m * 2048 + k * 1024); } while (0)
#define PG8_LDB(dst, b, h) do { _Pragma("unroll") for (int n = 0; n < 2; ++n) _Pragma("unroll") for (int k = 0; k < 2; ++k) dst[n][k] = *(const PG8_LAS bf16x8*)(lds + PG8_SB(b, h) + boff + n * 2048 + k * 1024); } while (0)
#define PG8_MMA(ai, bj, At, Bt) do { __builtin_amdgcn_s_setprio(1); _Pragma("unroll") for (int m = 0; m < 4; ++m) _Pragma("unroll") for (int n = 0; n < 2; ++n) _Pragma("unroll") for (int k = 0; k < 2; ++k) \
        acc[ai][bj][m][n] = mma16<Epi::F16>(Bt[n][k], At[m][k], acc[ai][bj][m][n]); __builtin_amdgcn_s_setprio(0); } while (0)
#define PG8_WAIT_V(n) asm volatile("s_waitcnt vmcnt(" #n ")" ::: "memory")
#define PG8_WAIT_L(n) asm volatile("s_waitcnt lgkmcnt(" #n ")" ::: "memory")
#define PG8_BAR __builtin_amdgcn_s_barrier()
#define PG8_SCHED __builtin_amdgcn_sched_barrier(0)
    Unit cur, nxt; int ui = 0;
    if (!S.next(0, cur)) return;
    f32x4 acc[2][2][4][2];
#pragma unroll
    for (int a = 0; a < 2; ++a)
#pragma unroll
        for (int b = 0; b < 2; ++b)
#pragma unroll
            for (int m = 0; m < 4; ++m)
#pragma unroll
                for (int n = 0; n < 2; ++n) acc[a][b][m][n] = (f32x4){0.f, 0.f, 0.f, 0.f};
    bf16x8 At[4][2], B0[2][2], B1[2][2];
    const char* cA = (const char*)g.A + (size_t)cur.pm * tstep; const char* cB = (const char*)g.Bt + (size_t)cur.pn * tstep;
    S.a_ready(cur);
    if constexpr (SP2) {
        PG8_STAGE(PG8_SB(0, 0), cB, voffB); PG8_STAGE(PG8_SB(0, 1), cB + hstep, voffB); PG8_STAGE(PG8_SA(0, 0), cA, voffA); PG8_STAGE(PG8_SA(0, 1), cA + hstep, voffA);
        if (wr == 1) PG8_BAR;
        PG8_WAIT_V(2); PG8_BAR;
        PG8_STAGE(PG8_SB(1, 0), cB + kstep, voffB); PG8_STAGE(PG8_SA(1, 0), cA + kstep, voffA); PG8_STAGE(PG8_SB(1, 1), cB + hstep + kstep, voffB);
        PG8_WAIT_V(6); PG8_BAR;
    } else {
        PG8_STAGE(PG8_SB(0, 0), cB, voffB); PG8_STAGE(PG8_SA(0, 0), cA, voffA); PG8_STAGE(PG8_SB(0, 1), cB + hstep, voffB); PG8_STAGE(PG8_SA(0, 1), cA + hstep, voffA);
        if (wr == 1) PG8_BAR;
        PG8_WAIT_V(4); PG8_BAR;
        PG8_STAGE(PG8_SB(1, 0), cB + kstep, voffB); PG8_STAGE(PG8_SA(1, 0), cA + kstep, voffA); PG8_STAGE(PG8_SB(1, 1), cB + hstep + kstep, voffB);
        PG8_WAIT_V(6); PG8_BAR;
    }
    for (;;) {
        const bool has_next = S.next(ui + 1, nxt);
        const char* nA = has_next ? (const char*)g.A + (size_t)nxt.pm * tstep : cA; const char* nB = has_next ? (const char*)g.Bt + (size_t)nxt.pn * tstep : cB;
        for (int t = 0; t < nt; t += 2) {
            const bool last = (t == nt - 2);
            const char* a1 = cA + (size_t)(t + 1) * kstep;
            const char* a2 = last ? nA : cA + (size_t)(t + 2) * kstep; const char* b2 = last ? nB : cB + (size_t)(t + 2) * kstep;
            const char* a3 = a2 + kstep; const char* b3 = b2 + kstep;
            if (last && has_next) S.a_ready(nxt);
            if constexpr (SP2) {
            PG8_LDB(B0, 0, 0); PG8_LDB(B1, 0, 1); PG8_SCHED; PG8_LDA(At, 0, 0); PG8_STAGE(PG8_SA(1, 1), a1 + hstep, voffA);
            PG8_WAIT_V(8); PG8_WAIT_L(0); PG8_BAR; PG8_MMA(0, 0, At, B0); PG8_MMA(0, 1, At, B1); PG8_BAR; PG8_SCHED;
            PG8_LDA(At, 0, 1); PG8_STAGE(PG8_SB(0, 0), b2, voffB); PG8_STAGE(PG8_SB(0, 1), b2 + hstep, voffB); PG8_STAGE(PG8_SA(0, 0), a2, voffA);
            PG8_WAIT_V(8); PG8_WAIT_L(0); PG8_BAR; PG8_MMA(1, 0, At, B0); PG8_MMA(1, 1, At, B1); PG8_BAR; PG8_SCHED;
            PG8_LDB(B0, 1, 0); PG8_LDB(B1, 1, 1); PG8_SCHED; PG8_LDA(At, 1, 0); PG8_STAGE(PG8_SA(0, 1), a2 + hstep, voffA);
            PG8_WAIT_V(8); PG8_WAIT_L(0); PG8_BAR; PG8_MMA(0, 0, At, B0); PG8_MMA(0, 1, At, B1); PG8_BAR; PG8_SCHED;
            PG8_LDA(At, 1, 1); PG8_STAGE(PG8_SB(1, 0), b3, voffB); PG8_STAGE(PG8_SB(1, 1), b3 + hstep, voffB); PG8_STAGE(PG8_SA(1, 0), a3, voffA);
            PG8_WAIT_V(8); PG8_WAIT_L(0); PG8_BAR; PG8_MMA(1, 0, At, B0); PG8_MMA(1, 1, At, B1); PG8_BAR; PG8_SCHED;
            } else {
            PG8_LDB(B0, 0, 0); PG8_SCHED; PG8_LDA(At, 0, 0); PG8_STAGE(PG8_SA(1, 1), a1 + hstep, voffA);
            PG8_WAIT_L(8); PG8_BAR; PG8_WAIT_L(0); PG8_MMA(0, 0, At, B0); PG8_BAR; PG8_SCHED;
            PG8_LDB(B1, 0, 1); PG8_STAGE(PG8_SB(0, 0), b2, voffB);
            PG8_BAR; PG8_WAIT_L(0); PG8_MMA(0, 1, At, B1); PG8_BAR;
            PG8_LDA(At, 0, 1); PG8_STAGE(PG8_SA(0, 0), a2, voffA);
            PG8_BAR; PG8_WAIT_L(0); PG8_MMA(1, 0, At, B0); PG8_BAR; PG8_SCHED;
            PG8_STAGE(PG8_SB(0, 1), b2 + hstep, voffB);
            PG8_WAIT_V(6); PG8_BAR; PG8_MMA(1, 1, At, B1); PG8_BAR;
            PG8_LDB(B0, 1, 0); PG8_SCHED; PG8_LDA(At, 1, 0); PG8_STAGE(PG8_SA(0, 1), a2 + hstep, voffA);
            PG8_WAIT_L(8); PG8_BAR; PG8_WAIT_L(0); PG8_MMA(0, 0, At, B0); PG8_BAR; PG8_SCHED;
            PG8_LDB(B1, 1, 1); PG8_STAGE(PG8_SB(1, 0), b3, voffB);
            PG8_BAR; PG8_WAIT_L(0); PG8_MMA(0, 1, At, B1); PG8_BAR;
            PG8_LDA(At, 1, 1); PG8_STAGE(PG8_SA(1, 0), a3, voffA);
            PG8_BAR; PG8_WAIT_L(0); PG8_MMA(1, 0, At, B0); PG8_BAR; PG8_SCHED;
            PG8_STAGE(PG8_SB(1, 1), b3 + hstep, voffB);
            PG8_WAIT_V(6); PG8_BAR; PG8_MMA(1, 1, At, B1); PG8_BAR;
            }
        }
        if constexpr (ALIGN_EPI) { if (wr == 0) PG8_BAR; }
        if constexpr (!Epi::AFTER_DRAIN) { E(acc, cur, wr, wc, fr, fq); S.done(cur); }
        if (!has_next) break;
#pragma unroll
        for (int a = 0; a < 2; ++a)
#pragma unroll
            for (int b = 0; b < 2; ++b)
#pragma unroll
                for (int m = 0; m < 4; ++m)
#pragma unroll
                    for (int n = 0; n < 2; ++n) acc[a][b][m][n] = (f32x4){0.f, 0.f, 0.f, 0.f};
        cur = nxt; cA = nA; cB = nB; ++ui;
        if constexpr (ALIGN_EPI) { if (wr == 1) PG8_BAR; }
    }
    PG8_WAIT_V(0);
    if constexpr (!ALIGN_EPI) { if (wr == 0) PG8_BAR; }
    PG8_BAR;
    if constexpr (Epi::AFTER_DRAIN) { E.fused(acc, cur, wr, wc, fr, fq, lds, wid, lane); S.done(cur); }
#undef PG8_SA
#undef PG8_SB
#undef PG8_STAGE
#undef PG8_LDA
#undef PG8_LDB
#undef PG8_MMA
#undef PG8_WAIT_V
#undef PG8_WAIT_L
#undef PG8_BAR
#undef PG8_SCHED
}
}

constexpr int NB = 32, SEQ = 2048, DM = 1024, NTOK = NB * SEQ;
constexpr int NH = 16, HD = 64, GW = 2048, GG = 8, GC = 128, FF = 2816, FF2 = 5632, DEPTH = 4;
constexpr float LN_EPS = 1e-5f;
constexpr float DN_ALPHA = 1.681792830507429f;
constexpr int HALF_TOK = NTOK / 2;

constexpr size_t MiB = 1u << 20;
constexpr size_t WS_ATTN_IN = 0, WS_ATTN_OUT = 12 * MiB, WS_GMLP_IN = 16 * MiB, WS_GMLP_OUT = 32 * MiB, WS_FFN_UP = 40 * MiB, WS_FFN_DOWN = 84 * MiB, WS_WS = 106 * MiB;
constexpr size_t WS_MS = 110 * MiB;
constexpr size_t WS_CTL = 107 * MiB;
constexpr size_t WS_ST = 108 * MiB;
constexpr size_t WS_HB = 112 * MiB;
constexpr size_t WS_R = 240 * MiB;
constexpr size_t WS_Q = WS_R, WS_K = WS_R + 128 * MiB, WS_V = WS_R + 256 * MiB, WS_O = WS_R + 384 * MiB;
constexpr size_t WS_ZZ = WS_R, WS_GT = WS_R + 512 * MiB;
constexpr size_t WS_HT = WS_R + 400 * MiB;
constexpr size_t WS_G = WS_R;
constexpr size_t WS_VST = 1008 * MiB;
constexpr size_t WS_END = 1012 * MiB;

constexpr int LDS_BYTES = 147456;

#define LAS __attribute__((address_space(3)))
typedef unsigned short bf16;
typedef unsigned u32x4 __attribute__((ext_vector_type(4)));
typedef unsigned u32x2 __attribute__((ext_vector_type(2)));
typedef float f32x4 __attribute__((ext_vector_type(4)));
typedef float f32x16 __attribute__((ext_vector_type(16)));
typedef short bf16x8 __attribute__((ext_vector_type(8)));
typedef short s16x4 __attribute__((ext_vector_type(4)));

__device__ __forceinline__ unsigned pk2(float lo, float hi) { return pg8::cvt_pk_bf16(lo, hi); }
__device__ __forceinline__ float bflo(unsigned w) { return __uint_as_float(w << 16); }
__device__ __forceinline__ float bfhi(unsigned w) { return __uint_as_float(w & 0xffff0000u); }
__device__ __forceinline__ float wave_sum(float v) {
#pragma unroll
    for (int o = 1; o < 64; o <<= 1) v += __shfl_xor(v, o);
    return v;
}
__device__ __forceinline__ s16x4 vtr(LAS const unsigned char* p) { return __builtin_bit_cast(s16x4, __builtin_amdgcn_ds_read_tr16_b64_v4i16((LAS s16x4*)p)); }

__device__ __forceinline__ void transpose_item(const float* W, int K, int N, bf16* WT, int perm, int f16, LAS float* scr, int item, int lane) {
    const int nblk = N / 32, kb = item / nblk, nb = item % nblk, k0 = 64 * kb, n0 = 32 * nb;
    int r0 = n0;
    if (perm) { const int bj = n0 / FF, f0 = n0 - bj * FF; r0 = (f0 >> 7) * 256 + bj * 128 + (f0 & 127); }
#pragma unroll 8
    for (int i = 0; i < 32; ++i) { const int kk = 2 * i + (lane >> 5); scr[kk * 33 + (lane & 31)] = W[(size_t)(k0 + kk) * N + n0 + (lane & 31)]; }
    asm volatile("s_waitcnt lgkmcnt(0)" ::: "memory");
    const int c = lane & 7;
#pragma unroll
    for (int j = 0; j < 4; ++j) { const int n = (lane >> 3) + 8 * j; const LAS float* s = scr + (8 * c) * 33 + n;
        u32x4 o; if (f16) { o.x = pg8::cvt_pk_f16(s[0 * 33], s[1 * 33]); o.y = pg8::cvt_pk_f16(s[2 * 33], s[3 * 33]); o.z = pg8::cvt_pk_f16(s[4 * 33], s[5 * 33]); o.w = pg8::cvt_pk_f16(s[6 * 33], s[7 * 33]); }
        else { o.x = pk2(s[0 * 33], s[1 * 33]); o.y = pk2(s[2 * 33], s[3 * 33]); o.z = pk2(s[4 * 33], s[5 * 33]); o.w = pk2(s[6 * 33], s[7 * 33]); }
        *(u32x4*)(WT + (size_t)(r0 + n) * K + k0 + 8 * c) = o; }
    asm volatile("s_waitcnt lgkmcnt(0)" ::: "memory");
}

struct Args { const float* in[17]; float* out; unsigned char* ws; };

__device__ __forceinline__ void ln_apply(const float* Y, float* Yo, bf16* HB, const float* st, float* ms, const float* gam, const float* bet, int gw, int ngw, int lane) {
    f32x4 g4[4], b4[4];
#pragma unroll
    for (int j = 0; j < 4; ++j) { g4[j] = ((const f32x4*)gam)[lane + 64 * j]; b4[j] = ((const f32x4*)bet)[lane + 64 * j]; }
    for (int m = gw; m < NTOK; m += ngw) {
        const f32x4* yr = (const f32x4*)(Y + (size_t)m * DM) + lane;
        f32x4 v[4];
#pragma unroll
        for (int j = 0; j < 4; ++j) v[j] = yr[64 * j];
        const f32x4 a = *(const f32x4*)(st + (size_t)m * 8), b = *(const f32x4*)(st + (size_t)m * 8 + 4);
        const float s = (a[0] + a[2]) + (b[0] + b[2]), q = (a[1] + a[3]) + (b[1] + b[3]);
        const float mean = s * (1.f / DM), rstd = 1.f / sqrtf(q * (1.f / DM) - mean * mean + LN_EPS);
        if (lane == 0) { ms[(size_t)m * 2] = mean; ms[(size_t)m * 2 + 1] = rstd; }
        u32x2* o8 = (u32x2*)(HB + (size_t)m * DM) + lane;
#pragma unroll
        for (int j = 0; j < 4; ++j) { const f32x4 o = (v[j] - mean) * rstd * g4[j] + b4[j]; if (Yo) ((f32x4*)(Yo + (size_t)m * DM) + lane)[64 * j] = o; u32x2 w; w.x = pk2(o.x, o.y); w.y = pk2(o.z, o.w); o8[64 * j] = w; }
    }
}

__device__ __forceinline__ void ffn_fix_phase(const float* HT, bf16* Gb, const float* cw, const float* cb, int cu, int G, int tid) {
    const int sub = tid >> 6, r = (tid >> 5) & 1, f = (tid & 31) * 4;
    for (int up = cu * 8 + sub; up < 224 * 22; up += G * 8) {
        const int pn = up % 22, pq = up / 22, pm = pq + pq / 7 + 1;
        const float* hc = HT + (size_t)(pm * 22 + pn) * 1024; const float* hp = HT + (size_t)((pm - 1) * 22 + pn) * 1024;
        f32x4 y[2];
#pragma unroll
        for (int hh = 0; hh < 2; ++hh) { const int c = hh * 128 + f; const int F = hh * FF + 128 * pn + f;
            const f32x4 h0 = *(const f32x4*)(hc + c), h1 = *(const f32x4*)(hc + 256 + c), t0 = *(const f32x4*)(hp + 512 + c), t1 = *(const f32x4*)(hp + 768 + c);
            const f32x4 x0 = r ? h1 : h0, xm1 = r ? h0 : t1, xm2 = r ? t1 : t0;
            y[hh] = *(const f32x4*)(cb + F) + *(const f32x4*)(cw + F) * xm2 + *(const f32x4*)(cw + FF2 + F) * xm1 + *(const f32x4*)(cw + 2 * FF2 + F) * x0; }
        float v[4];
#pragma unroll
        for (int e = 0; e < 4; ++e) v[e] = y[0][e] * __builtin_amdgcn_rcpf(1.0f + __builtin_amdgcn_exp2f(-1.4426950408889634f * y[0][e])) * y[1][e];
        u32x2 w; w.x = pk2(v[0], v[1]); w.y = pk2(v[2], v[3]);
        *(u32x2*)(Gb + (size_t)(pm * 256 + r) * FF + 128 * pn + f) = w;
    }
}

__device__ __forceinline__ void attn_phase(LAS unsigned char* lds, const bf16* Q, const bf16* K, const bf16* V, bf16* O, int cu, int G, int rev) {
    const int tid = opaque_tid(), lane = tid & 63, wid = __builtin_amdgcn_readfirstlane(tid >> 6), q32 = lane & 31, hi = lane >> 5, li = lane & 15;
    LAS unsigned char* Ks = lds + wid * 10752;
    LAS unsigned char* Vs = Ks + 4608;
    const int lkey = lane >> 3, lch = lane & 7;
    const float LOG2E = 1.4426950408889634f;
    for (int k = 0; k < 16; ++k) {
        const int idx = cu * 8 + wid + 2048 * (k & 3), b = 4 * (idx & 7) + (rev ? 3 - (k >> 2) : (k >> 2)), h = (idx >> 3) & 15, qb = idx >> 7;
        const size_t rowbase = (size_t)b * SEQ;
        const int q0w = qb * 32;
        bf16x8 qf[4];
        { const bf16* qp = Q + (rowbase + q0w + q32) * DM + h * HD + hi * 8;
#pragma unroll
          for (int ks = 0; ks < 4; ++ks) qf[ks] = *(const bf16x8*)(qp + ks * 16); }
        f32x16 o0, o1;
#pragma unroll
        for (int r = 0; r < 16; ++r) { o0[r] = 0.f; o1[r] = 0.f; }
        float R = 0.f;
        const bf16* kp = K + (rowbase + lkey) * DM + h * HD + lch * 8;
        const bf16* vp = V + (rowbase + lkey) * DM + h * HD + lch * 8;
        u32x4 kr[4], vr[4];
#pragma unroll
        for (int jj = 0; jj < 4; ++jj) { kr[jj] = *(const u32x4*)(kp + (size_t)(q0w + 8 * jj) * DM); vr[jj] = *(const u32x4*)(vp + (size_t)(q0w + 8 * jj) * DM); }
        for (int key0 = q0w; key0 >= 0; key0 -= 32) {
#pragma unroll
            for (int jj = 0; jj < 4; ++jj) { *(LAS u32x4*)(Ks + (lkey + 8 * jj) * 144 + lch * 16) = kr[jj]; *(LAS u32x4*)(Vs + (lkey + 8 * jj) * 192 + lch * 16) = vr[jj]; }
            asm volatile("s_waitcnt lgkmcnt(0)" ::: "memory");
            if (key0 >= 32) {
#pragma unroll
                for (int jj = 0; jj < 4; ++jj) { kr[jj] = *(const u32x4*)(kp + (size_t)(key0 - 32 + 8 * jj) * DM); vr[jj] = *(const u32x4*)(vp + (size_t)(key0 - 32 + 8 * jj) * DM); } }
            const bool diag = (key0 == q0w);
            f32x16 s;
#pragma unroll
            for (int r = 0; r < 16; ++r) s[r] = 0.f;
#pragma unroll
            for (int ks = 0; ks < 4; ++ks) { const bf16x8 kf = *(LAS const bf16x8*)(Ks + q32 * 144 + (16 * ks + 8 * hi) * 2);
                s = __builtin_amdgcn_mfma_f32_32x32x16_bf16(kf, qf[ks], s, 0, 0, 0); }
            float zs[16], l1[16];
#pragma unroll
            for (int r = 0; r < 16; ++r) { const float z = s[r] * LOG2E; const float e = __builtin_amdgcn_exp2f(-__builtin_fabsf(z)); const float t = __builtin_amdgcn_logf(1.0f + e);
                float l = -(__builtin_fmaxf(z, 0.f) + t);
                if (diag) { const int kl = 8 * (r >> 2) + 4 * hi + (r & 3); if (kl >= q32) l = 0.f; }
                zs[r] = z; l1[r] = l; }
            float G0[4], G1[4];
#pragma unroll
            for (int j = 0; j < 4; ++j) { const float gs = (l1[4 * j] + l1[4 * j + 1]) + (l1[4 * j + 2] + l1[4 * j + 3]);
                auto rr = __builtin_amdgcn_permlane32_swap(__float_as_uint(gs), __float_as_uint(gs), false, false); G0[j] = __uint_as_float(rr[0]); G1[j] = __uint_as_float(rr[1]); }
            float p[16]; float run = R;
#pragma unroll
            for (int j = 3; j >= 0; --j) { float sfx = run + (hi == 0 ? G1[j] : 0.f);
#pragma unroll
                for (int e = 3; e >= 0; --e) { const int r = 4 * j + e; float val = __builtin_amdgcn_exp2f(l1[r] + zs[r] + sfx);
                    if (diag) { const int kl = 8 * j + 4 * hi + e; if (kl >= q32) val = 0.f; }
                    p[r] = val; sfx += l1[r]; }
                run += G0[j] + G1[j]; }
            R = run;
#pragma unroll
            for (int ks2 = 0; ks2 < 2; ++ks2) {
                u32x4 pw; pw.x = pk2(p[8 * ks2], p[8 * ks2 + 1]); pw.y = pk2(p[8 * ks2 + 2], p[8 * ks2 + 3]); pw.z = pk2(p[8 * ks2 + 4], p[8 * ks2 + 5]); pw.w = pk2(p[8 * ks2 + 6], p[8 * ks2 + 7]);
                const bf16x8 pb = __builtin_bit_cast(bf16x8, pw);
#pragma unroll
                for (int dh = 0; dh < 2; ++dh) {
                    LAS const unsigned char* va = Vs + (16 * ks2 + 4 * hi + (li >> 2)) * 192 + (32 * dh + 16 * ((lane >> 4) & 1) + 4 * (li & 3)) * 2;
                    const s16x4 lo = vtr(va), hi4 = vtr(va + 8 * 192);
                    const bf16x8 vf = (bf16x8){lo[0], lo[1], lo[2], lo[3], hi4[0], hi4[1], hi4[2], hi4[3]};
                    if (dh == 0) o0 = __builtin_amdgcn_mfma_f32_32x32x16_bf16(vf, pb, o0, 0, 0, 0);
                    else         o1 = __builtin_amdgcn_mfma_f32_32x32x16_bf16(vf, pb, o1, 0, 0, 0);
                }
            }
            asm volatile("s_waitcnt lgkmcnt(0)" ::: "memory");
            if (__all(R < -150.0f)) break;
        }
#pragma unroll
        for (int j = 0; j < 4; ++j) { u32x2 w0, w1; w0.x = pk2(o0[4 * j], o0[4 * j + 1]); w0.y = pk2(o0[4 * j + 2], o0[4 * j + 3]); w1.x = pk2(o1[4 * j], o1[4 * j + 1]); w1.y = pk2(o1[4 * j + 2], o1[4 * j + 3]);
            *(LAS u32x2*)(Ks + q32 * 144 + (8 * j + 4 * hi) * 2) = w0; *(LAS u32x2*)(Ks + q32 * 144 + (32 + 8 * j + 4 * hi) * 2) = w1; }
        asm volatile("s_waitcnt lgkmcnt(0)" ::: "memory");
#pragma unroll
        for (int i = 0; i < 4; ++i) { const int row = lkey + 8 * i; const u32x4 v = *(LAS const u32x4*)(Ks + row * 144 + lch * 16);
            *(u32x4*)(O + (rowbase + q0w + row) * DM + h * HD + lch * 8) = v; }
        asm volatile("s_waitcnt lgkmcnt(0)" ::: "memory");
    }
    __syncthreads();
}

__device__ __forceinline__ void spatial_phase(LAS unsigned char* lds, const bf16* ZZ, bf16* GT, const bf16* Wc, const float* bs, const float* gam, const float* bet, const float* VST, int cu, int G, int rev) {
    const int tid = opaque_tid(), lane = tid & 63, wid = __builtin_amdgcn_readfirstlane(tid >> 6), fr = lane & 15, kg = lane >> 4;
    LAS float* st = (LAS float*)(lds + 69632);
    const int wr = wid >> 2, wc = wid & 3;
    for (int k = 0; k < 2; ++k) {
        const int cls = 2 * k + (cu >> 7); const int chunk = 64 * (cu & 7) + 16 * (rev ? 3 - cls : cls) + ((cu >> 3) & 15);
        const size_t row0 = (size_t)chunk * GC;
        __syncthreads();
        { const int row = tid >> 2, part = tid & 3;
          const f32x4 a = *(const f32x4*)(VST + (row0 + row) * 16 + part * 4);
          float sm = a[0] + a[2], sq = a[1] + a[3];
          sm += __shfl_xor(sm, 1); sm += __shfl_xor(sm, 2); sq += __shfl_xor(sq, 1); sq += __shfl_xor(sq, 2);
          if (part == 0) { const float mean = sm * (1.f / GW); st[2 * row] = mean; st[2 * row + 1] = 1.f / sqrtf(sq * (1.f / GW) - mean * mean + LN_EPS); } }
        const int c8 = tid & 31, srow = tid >> 5;
        LAS unsigned char* const wl = lds + 72704;
        const int wt = tid >> 2, wq = tid & 3;
        u32x4 nv[8], nw[4];
#pragma unroll
        for (int it = 0; it < 8; ++it) nv[it] = *(const u32x4*)(ZZ + (row0 + it * 16 + srow) * 4096 + GW + c8 * 8);
#pragma unroll
        for (int q = 0; q < 4; ++q) nw[q] = *(const u32x4*)(Wc + (size_t)wt * GC + wq * 32 + q * 8);
        for (int g = 0; g < GG; ++g) {
            __syncthreads();
            { const float* gp = gam + g * 256 + c8 * 8; const float* bp = bet + g * 256 + c8 * 8;
              const f32x4 ga = *(const f32x4*)gp, gb = *(const f32x4*)(gp + 4), ba = *(const f32x4*)bp, bb = *(const f32x4*)(bp + 4);
#pragma unroll
              for (int q = 0; q < 4; ++q) *(LAS u32x4*)(wl + wt * 272 + wq * 64 + q * 16) = nw[q];
#pragma unroll
              for (int it = 0; it < 8; ++it) { const int s = it * 16 + srow;
                  const u32x4 w = nv[it];
                  const float mean = st[2 * s], rstd = st[2 * s + 1];
                  u32x4 o;
                  o.x = pk2((bflo(w.x) - mean) * rstd * ga.x + ba.x, (bfhi(w.x) - mean) * rstd * ga.y + ba.y);
                  o.y = pk2((bflo(w.y) - mean) * rstd * ga.z + ba.z, (bfhi(w.y) - mean) * rstd * ga.w + ba.w);
                  o.z = pk2((bflo(w.z) - mean) * rstd * gb.x + bb.x, (bfhi(w.z) - mean) * rstd * gb.y + bb.y);
                  o.w = pk2((bflo(w.w) - mean) * rstd * gb.z + bb.z, (bfhi(w.w) - mean) * rstd * gb.w + bb.w);
                  { const int pos0 = 64 * (c8 >> 3) + 32 * ((c8 & 7) >> 2) + 4 * (c8 & 3);
                    *(LAS u32x2*)(lds + s * 544 + pos0 * 2) = (u32x2){o.x, o.y}; *(LAS u32x2*)(lds + s * 544 + (pos0 + 16) * 2) = (u32x2){o.z, o.w}; } } }
            __syncthreads();
            if (g + 1 < GG) {
#pragma unroll
                for (int it = 0; it < 8; ++it) nv[it] = *(const u32x4*)(ZZ + (row0 + it * 16 + srow) * 4096 + GW + (g + 1) * 256 + c8 * 8);
#pragma unroll
                for (int q = 0; q < 4; ++q) nw[q] = *(const u32x4*)(Wc + (size_t)(g + 1) * GC * GC + (size_t)wt * GC + wq * 32 + q * 8); }
            u32x4 uu[4][2];
#pragma unroll
            for (int tb = 0; tb < 4; ++tb)
#pragma unroll
                for (int a2 = 0; a2 < 2; ++a2) uu[tb][a2] = *(const u32x4*)(ZZ + (row0 + 64 * wr + 16 * tb + fr) * 4096 + g * 256 + 64 * wc + 32 * a2 + 8 * kg);
            f32x4 acc[4][4];
#pragma unroll
            for (int a = 0; a < 4; ++a)
#pragma unroll
                for (int b2 = 0; b2 < 4; ++b2) acc[a][b2] = (f32x4){0.f, 0.f, 0.f, 0.f};
#pragma unroll
            for (int ks = 0; ks < 4; ++ks) {
                if (32 * ks <= 64 * wr + 63) {
                    bf16x8 X[4], Y[4];
#pragma unroll
                    for (int tb = 0; tb < 4; ++tb) { LAS const unsigned char* wp = wl + (64 * wr + 16 * tb + fr) * 272 + (32 * ks + 4 * kg) * 2;
                        const u32x2 a = *(LAS const u32x2*)wp, b2 = *(LAS const u32x2*)(wp + 32); const u32x4 w = (u32x4){a.x, a.y, b2.x, b2.y}; Y[tb] = __builtin_bit_cast(bf16x8, w); }
#pragma unroll
                    for (int cb = 0; cb < 4; ++cb) { LAS const unsigned char* xa = lds + (32 * ks + 4 * kg + (fr >> 2)) * 544 + (64 * wc + 16 * cb + 4 * (fr & 3)) * 2;
                        const s16x4 lo = vtr(xa), hi4 = vtr(xa + 16 * 544);
                        X[cb] = (bf16x8){lo[0], lo[1], lo[2], lo[3], hi4[0], hi4[1], hi4[2], hi4[3]}; }
#pragma unroll
                    for (int tb = 0; tb < 4; ++tb)
#pragma unroll
                        for (int cb = 0; cb < 4; ++cb) acc[tb][cb] = __builtin_amdgcn_mfma_f32_16x16x32_bf16(X[cb], Y[tb], acc[tb][cb], 0, 0, 0);
                }
            }
#pragma unroll
            for (int tb = 0; tb < 4; ++tb) { const int t = 64 * wr + 16 * tb + fr; const float bsv = bs[g * GC + t];
#pragma unroll
                for (int a2 = 0; a2 < 2; ++a2) { const int c = g * 256 + 64 * wc + 32 * a2 + 8 * kg;
                    const u32x4 u = uu[tb][a2]; const f32x4 s0 = acc[tb][2 * a2] + bsv, s1 = acc[tb][2 * a2 + 1] + bsv;
                    u32x4 o; o.x = pk2(bflo(u.x) * s0[0], bfhi(u.x) * s0[1]); o.y = pk2(bflo(u.y) * s0[2], bfhi(u.y) * s0[3]); o.z = pk2(bflo(u.z) * s1[0], bfhi(u.z) * s1[1]); o.w = pk2(bflo(u.w) * s1[2], bfhi(u.w) * s1[3]);
                    *(u32x4*)(GT + (row0 + t) * GW + c) = o; } }
        }
    }
}

#ifndef PROBE
#define PROBE 0
#endif
#ifndef G2_REV
#define G2_REV 1
#endif
__device__ __forceinline__ void gbar(unsigned* ctr, unsigned target) {
    asm volatile("s_waitcnt vmcnt(0)" ::: "memory");
    __syncthreads();
    if (threadIdx.x == 0) {
        __builtin_amdgcn_fence(__ATOMIC_RELEASE, "agent");
        asm volatile("s_waitcnt vmcnt(0)" ::: "memory");
        const unsigned epoch = target >> 8;
        unsigned* const loc = ctr + 64 * (1 + (blockIdx.x & 7));
        if (__hip_atomic_fetch_add(loc, 1u, __ATOMIC_RELAXED, __HIP_MEMORY_SCOPE_AGENT) + 1u == 32u * epoch)
            __hip_atomic_fetch_add(ctr, 1u, __ATOMIC_RELEASE, __HIP_MEMORY_SCOPE_AGENT);
        while (__hip_atomic_load(ctr, __ATOMIC_RELAXED, __HIP_MEMORY_SCOPE_AGENT) < 8u * epoch) __builtin_amdgcn_s_sleep(1);
        __builtin_amdgcn_fence(__ATOMIC_ACQUIRE, "agent");
        asm volatile("s_waitcnt vmcnt(0)" ::: "memory");
    }
    __syncthreads();
}
#define GSYNC() do { bar_target += (unsigned)G; gbar(bar_ctr, bar_target); if (PROBE == 7) { bar_target += (unsigned)G; gbar(bar_ctr, bar_target); } } while (0)
__global__ void __launch_bounds__(512, 2) fwd_kernel(Args args) {
    extern __shared__ __attribute__((aligned(16))) unsigned char lds_raw[];
    cg::grid_group grid = cg::this_grid();
    LAS unsigned char* lds = (LAS unsigned char*)lds_raw;
    const int G = gridDim.x, cu = blockIdx.x, ngw = G * 8;
    unsigned char* ws = args.ws;
    const float* x = args.in[0];
    float* out = args.out;
    bf16* HB = (bf16*)(ws + WS_HB);
    unsigned* bar_ctr = (unsigned*)(ws + WS_CTL); unsigned bar_target = 0u;
    if (cu == 0 && threadIdx.x < 8) __hip_atomic_store((unsigned*)(ws + WS_CTL + 8192) + 64 * threadIdx.x, 0u, __ATOMIC_RELAXED, __HIP_MEMORY_SCOPE_AGENT);
    if (cu == 0 && threadIdx.x < 9) __hip_atomic_store(bar_ctr + 64 * threadIdx.x, 0u, __ATOMIC_RELAXED, __HIP_MEMORY_SCOPE_AGENT);

    for (int rep = 0; rep < (PROBE == 8 ? 2 : 1); ++rep) {
        const int tid = opaque_tid(), lane = tid & 63, wave = __builtin_amdgcn_readfirstlane(tid >> 6), gw = cu * 8 + wave;
        LAS float* scr = (LAS float*)(lds + wave * 16384);
        for (int mat = 0; mat < 16; ++mat) {
            const float* W; bf16* WT; int K, N, perm = 0;
            if (mat < 2)       { W = args.in[1] + (size_t)mat * DM * 3072;        WT = (bf16*)(ws + WS_ATTN_IN) + (size_t)mat * 3072 * DM;        K = DM; N = 3072; }
            else if (mat < 4)  { W = args.in[2] + (size_t)(mat - 2) * DM * DM;    WT = (bf16*)(ws + WS_ATTN_OUT) + (size_t)(mat - 2) * DM * DM;   K = DM; N = DM; }
            else if (mat < 6)  { W = args.in[3] + (size_t)(mat - 4) * DM * 4096;  WT = (bf16*)(ws + WS_GMLP_IN) + (size_t)(mat - 4) * 4096 * DM;  K = DM; N = 4096; }
            else if (mat < 8)  { W = args.in[8] + (size_t)(mat - 6) * GW * DM;    WT = (bf16*)(ws + WS_GMLP_OUT) + (size_t)(mat - 6) * DM * GW;   K = GW; N = DM; }
            else if (mat < 12) { W = args.in[9] + (size_t)(mat - 8) * DM * FF2;   WT = (bf16*)(ws + WS_FFN_UP) + (size_t)(mat - 8) * FF2 * DM;    K = DM; N = FF2; perm = 1; }
            else               { W = args.in[12] + (size_t)(mat - 12) * FF * DM;  WT = (bf16*)(ws + WS_FFN_DOWN) + (size_t)(mat - 12) * DM * FF;  K = FF; N = DM; }
            const int nitems = (K / 64) * (N / 32);
            for (int it = gw; it < nitems; it += ngw) transpose_item(W, K, N, WT, perm, (mat < 2 || mat == 4 || mat == 5 || (mat >= 8 && mat < 12)) ? 1 : 0, scr, it, lane);
        }
        { const float* wsrc = args.in[6]; bf16* wd = (bf16*)(ws + WS_WS);
          for (int i = cu * 512 + tid; i < 2 * GG * GC * GC; i += G * 512) { const int s = i & 127, t = (i >> 7) & 127; const float v = (s <= t) ? wsrc[i] : 0.f; wd[i] = (bf16)(pk2(v, v) & 0xffffu); } }
        for (int m = gw; m < NTOK; m += ngw) {
            const f32x4* xr = (const f32x4*)(x + (size_t)m * DM) + lane; u32x2* o8 = (u32x2*)(HB + (size_t)m * DM) + lane;
#pragma unroll
            for (int j = 0; j < 4; ++j) { const f32x4 v = xr[64 * j]; u32x2 w; w.x = pg8::cvt_pk_f16(v.x, v.y); w.y = pg8::cvt_pk_f16(v.z, v.w); o8[64 * j] = w; }
        }
    }
    grid.sync();

    int dir = 0;
    for (int layer = 0; layer < DEPTH; ++layer) {
        const int j = layer >> 1, mixer = layer & 1;
        for (int step = 0; step < 2; ++step) {
            if (step == 0) {
                pg8::Gemm g; pg8::EpiBf16 E;
                if (mixer == 0) { g = pg8::Gemm{HB, (const bf16*)(ws + WS_ATTN_IN) + (size_t)j * 3072 * DM, NTOK, 3072, DM};
                    E = pg8::EpiBf16{(bf16*)(ws + WS_Q), DM, 0, DM, (size_t)NTOK * DM, 0.125f, nullptr, nullptr}; }
                else { g = pg8::Gemm{HB, (const bf16*)(ws + WS_GMLP_IN) + (size_t)j * 4096 * DM, NTOK, 4096, DM};
                    E = pg8::EpiBf16{(bf16*)(ws + WS_ZZ), 4096, 1, 0, 0, 1.f, (float*)(ws + WS_VST), (LAS float*)(lds + 131072)}; }
                pg8::StaticOrder S; S.rev = dir; dir ^= 1; S.init(g.M, g.N, G, cu);
                for (int rep = 0; rep < (PROBE == 1 ? 2 : 1); ++rep)
                pg8::gemm_phase<pg8::EpiBf16, pg8::StaticOrder, true, true>(lds, g, S, E);
            } else {
                pg8::Gemm g{HB, (const bf16*)(ws + WS_FFN_UP) + (size_t)layer * FF2 * DM, NTOK, FF2, DM};
                pg8::EpiConv E{(bf16*)(ws + WS_G), args.in[10] + (size_t)layer * 3 * FF2, args.in[11] + (size_t)layer * FF2, lds + 131072, FF, FF2, FF, (float*)(ws + WS_HT)};
                pg8::StaticOrder S; S.rev = dir; dir ^= 1; S.init(g.M, g.N, G, cu);
                for (int rep = 0; rep < (PROBE == 4 ? 2 : 1); ++rep)
                pg8::gemm_phase<pg8::EpiConv, pg8::StaticOrder, true, true>(lds, g, S, E);
                GSYNC();
                ffn_fix_phase((const float*)(ws + WS_HT), (bf16*)(ws + WS_G), args.in[10] + (size_t)layer * 3 * FF2, args.in[11] + (size_t)layer * FF2, cu, G, opaque_tid());
            }
            GSYNC();
            if (step == 0) {
                for (int rep = 0; rep < (((PROBE == 2 && mixer == 0) || (PROBE == 3 && mixer == 1)) ? 2 : 1); ++rep)
                if (mixer == 0) attn_phase(lds, (const bf16*)(ws + WS_Q), (const bf16*)(ws + WS_K), (const bf16*)(ws + WS_V), (bf16*)(ws + WS_O), cu, G, dir);
                else spatial_phase(lds, (const bf16*)(ws + WS_ZZ), (bf16*)(ws + WS_GT), (const bf16*)(ws + WS_WS) + (size_t)j * GG * GC * GC, args.in[7] + j * GG * GC, args.in[4] + j * GW, args.in[5] + j * GW, (const float*)(ws + WS_VST), cu, G, dir); dir ^= 1;
                GSYNC();
            }
            const int lnidx = 2 * layer + step;
            {
                pg8::Gemm g;
                if (step == 0 && mixer == 0) g = pg8::Gemm{(const bf16*)(ws + WS_O), (const bf16*)(ws + WS_ATTN_OUT) + (size_t)j * DM * DM, NTOK, DM, DM};
                else if (step == 0) g = pg8::Gemm{(const bf16*)(ws + WS_GT), (const bf16*)(ws + WS_GMLP_OUT) + (size_t)j * DM * GW, NTOK, DM, GW};
                else g = pg8::Gemm{(const bf16*)(ws + WS_G), (const bf16*)(ws + WS_FFN_DOWN) + (size_t)layer * DM * FF, NTOK, DM, FF};
                const int pl = (lnidx - 1) >> 1;
                const float* pgam = lnidx == 0 ? nullptr : (((lnidx - 1) & 1) ? args.in[15] : args.in[13]) + pl * DM;
                const float* pbet = lnidx == 0 ? nullptr : (((lnidx - 1) & 1) ? args.in[16] : args.in[14]) + pl * DM;
                const float* cgam = (step == 0 ? args.in[13] : args.in[15]) + layer * DM;
                const float* cbet = (step == 0 ? args.in[14] : args.in[16]) + layer * DM;
                const bool lastln = lnidx == 2 * DEPTH - 1;
                pg8::EpiResLn E{(const unsigned short*)HB, 0, out, (float*)(ws + WS_ST), cgam, cbet, HB, (unsigned short*)HB,
                                (unsigned*)(ws + WS_CTL + 8192), 128u * (unsigned)lnidx, lastln ? 1 : 0, lds + 131072, dir};
                pg8::StaticOrder S; S.rev = dir; dir ^= 1; S.init(g.M, g.N, G, cu);
                if (PROBE == 9) { pg8::EpiBf16 E0{(bf16*)(ws + WS_R + (step == 1 ? 512 * MiB : 0)), DM, 0, 0, 0, 1.f};
                    pg8::gemm_phase<pg8::EpiBf16, pg8::StaticOrder, true, true>(lds, g, S, E0); }
                pg8::gemm_phase<pg8::EpiResLn, pg8::StaticOrder, true, true>(lds, g, S, E);
            }
            if (lnidx != 2 * DEPTH - 1) GSYNC();
        }
    }
}

extern "C" void kernel_launch(void* const* d_in, const int* in_sizes, int n_in, void* d_out, int out_size, void* d_ws, size_t ws_size, hipStream_t stream) {
    static int grid = 0;
    if (grid == 0) {
        if (n_in != 17 || out_size != NTOK * DM || ws_size < WS_END) { fprintf(stderr, "kernel_launch: unexpected shapes (n_in %d, out %d, ws %zu)\n", n_in, out_size, ws_size); grid = -1; return; }
        int dev = 0, cus = 0, per_cu = 0;
        hipGetDevice(&dev);
        hipDeviceGetAttribute(&cus, hipDeviceAttributeMultiprocessorCount, dev);
        if (hipFuncSetAttribute((const void*)fwd_kernel, hipFuncAttributeMaxDynamicSharedMemorySize, LDS_BYTES) != hipSuccess) { fprintf(stderr, "kernel_launch: hipFuncSetAttribute failed\n"); grid = -1; return; }
        if (hipOccupancyMaxActiveBlocksPerMultiprocessor(&per_cu, (const void*)fwd_kernel, 512, LDS_BYTES) != hipSuccess || per_cu < 1) { fprintf(stderr, "kernel_launch: occupancy query says %d\n", per_cu); per_cu = 1; }
        (void)hipGetLastError();
        grid = cus * per_cu;
        fprintf(stderr, "kernel_launch: grid %d (cus %d x %d)\n", grid, cus, per_cu);
        if (grid != 256) { fprintf(stderr, "kernel_launch: the fused LayerNorm epilogue's group barrier is laid out for a 256-workgroup grid; nothing launched\n"); grid = -1; return; }
    }
    if (grid < 0) return;
    Args a{};
    for (int i = 0; i < 17; ++i) a.in[i] = (const float*)d_in[i];
    a.out = (float*)d_out; a.ws = (unsigned char*)d_ws;
    void* kargs[] = {&a};
    hipError_t e = hipLaunchCooperativeKernel((const void*)fwd_kernel, dim3(grid), dim3(512), kargs, LDS_BYTES, stream);
    if (e != hipSuccess) fprintf(stderr, "cooperative launch failed: %s (grid %d)\n", hipGetErrorString(e), grid);
}
```
